# Optimizing an MI355X kernel written in HIP

```python
import jax
import jax.numpy as jnp
from jax import lax
import numpy as np

D_MODEL = 1024
BATCH = 8
SEQ = 2048
DEPTH = 1

MLA_HEADS = 8
MLA_Q_RANK = 256
MLA_KV_RANK = 128
MLA_NOPE = 64
MLA_ROPE = 32
MLA_V = 64
ROPE_THETA = 10000.0
DSA_HEADS = 8
DSA_KV_HEADS = 2
DSA_HEAD_DIM = 64
IDX_HEADS = 8
IDX_DIM = 32
IDX_TOPK_MAX = 256
N_EXPERTS = 32
TOP_K = 4
D_EXPERT = D_MODEL
SWIGLU_ALPHA = 1.702
SWIGLU_LIMIT = 7.0

NORM_EPS = 1e-6
NEG_INF = -1e30
Q_BLOCK = 128
MOE_BLOCK = 128

MIX_WIDTH = MLA_HEADS * MLA_V + DSA_HEADS * DSA_HEAD_DIM
IN_SPLITS = (MLA_Q_RANK, MLA_KV_RANK, MLA_ROPE,
             DSA_HEADS * DSA_HEAD_DIM, DSA_KV_HEADS * DSA_HEAD_DIM, DSA_KV_HEADS * DSA_HEAD_DIM,
             IDX_HEADS * IDX_DIM, IDX_DIM, IDX_HEADS)
IN_WIDTH = sum(IN_SPLITS)

kernel_name = "hybrid_mla_dsa_moe_block"


def rms_norm(x, g):
    xf = x.astype(jnp.float32)
    y = xf * lax.rsqrt(jnp.mean(xf * xf, axis=-1, keepdims=True) + NORM_EPS)
    return (y * g.astype(jnp.float32)).astype(x.dtype)


def rope(x, pos):
    half = x.shape[-1] // 2
    freqs = ROPE_THETA ** (-jnp.arange(half, dtype=jnp.float32) / half)
    ang = pos.astype(jnp.float32)[..., None] * freqs
    ang = ang.reshape(ang.shape[:2] + (1,) * (x.ndim - 3) + (half,))
    cos, sin = jnp.cos(ang), jnp.sin(ang)
    x1 = x[..., :half].astype(jnp.float32)
    x2 = x[..., half:].astype(jnp.float32)
    return jnp.concatenate([x1 * cos - x2 * sin, x2 * cos + x1 * sin], axis=-1).astype(x.dtype)


def to_blocks(a):
    b, s = a.shape[:2]
    return jnp.moveaxis(a.reshape((b, s // Q_BLOCK, Q_BLOCK) + a.shape[2:]), 1, 0)


def from_blocks(a):
    a = jnp.moveaxis(a, 0, 1)
    return a.reshape((a.shape[0], a.shape[1] * a.shape[2]) + a.shape[3:])


def mla_attention(c_q, c_kv, k_rope_in, pos, g_q_a, g_kv_a, w_q_b, w_kv_b):
    b, s, _ = c_q.shape
    q = (rms_norm(c_q, g_q_a) @ w_q_b).reshape(b, s, MLA_HEADS, MLA_NOPE + MLA_ROPE)
    q_nope = q[..., :MLA_NOPE]
    q_rope = rope(q[..., MLA_NOPE:], pos)
    kv = (rms_norm(c_kv, g_kv_a) @ w_kv_b).reshape(b, s, MLA_HEADS, MLA_NOPE + MLA_V)
    k_nope, v = kv[..., :MLA_NOPE], kv[..., MLA_NOPE:]
    k_rope = rope(k_rope_in, pos)
    scale = (MLA_NOPE + MLA_ROPE) ** -0.5
    key_idx = jnp.arange(s)

    def block(args):
        qn, qr, qi = args
        sc = (jnp.einsum('bqhd,bkhd->bhqk', qn, k_nope)
              + jnp.einsum('bqhd,bkd->bhqk', qr, k_rope)).astype(jnp.float32) * scale
        sc = jnp.where(key_idx[None, None, None, :] <= qi[None, None, :, None], sc, NEG_INF)
        p = jax.nn.softmax(sc, axis=-1).astype(v.dtype)
        return jnp.einsum('bhqk,bkhd->bqhd', p, v)

    q_ids = jnp.arange(s).reshape(-1, Q_BLOCK)
    out = lax.map(block, (to_blocks(q_nope), to_blocks(q_rope), q_ids))
    return from_blocks(out).reshape(b, s, MLA_HEADS * MLA_V)


def dsa_attention(q, k, v, q_i, k_i, w_i, pos):
    b, s, _ = q.shape
    grp = DSA_HEADS // DSA_KV_HEADS
    q = q.reshape(b, s, DSA_KV_HEADS, grp, DSA_HEAD_DIM)
    k = k.reshape(b, s, DSA_KV_HEADS, DSA_HEAD_DIM)
    v = v.reshape(b, s, DSA_KV_HEADS, DSA_HEAD_DIM)
    q_i = q_i.reshape(b, s, IDX_HEADS, IDX_DIM) * (IDX_DIM ** -0.5)
    w_i = w_i * (IDX_HEADS ** -0.5)
    n_sel = min(IDX_TOPK_MAX, s // 4)
    key_idx = jnp.arange(s)
    slopes = jnp.exp2(-8.0 * jnp.arange(1, DSA_HEADS + 1, dtype=jnp.float32) / DSA_HEADS)
    slopes = slopes.reshape(DSA_KV_HEADS, grp)
    gather = jax.vmap(lambda a, i: a[i])

    def block(args):
        qb, qib, wib, posb, ti = args
        rel = jax.nn.relu(jnp.einsum('bqhd,bsd->bqsh', qib, k_i).astype(jnp.float32))
        idx_score = jnp.einsum('bqsh,bqh->bqs', rel, wib.astype(jnp.float32))
        idx_score = jnp.where(key_idx[None, None, :] <= ti[None, :, None], idx_score, NEG_INF)
        _, sel = lax.top_k(idx_score, n_sel)
        k_sel = gather(k, sel)
        v_sel = gather(v, sel)
        pos_sel = gather(pos, sel)
        sc = jnp.einsum('bqhgd,bqnhd->bqhgn', qb, k_sel).astype(jnp.float32) * (DSA_HEAD_DIM ** -0.5)
        dist = jnp.abs(posb[:, :, None] - pos_sel).astype(jnp.float32)
        sc = sc - slopes[None, None, :, :, None] * dist[:, :, None, None, :]
        valid = sel <= ti[None, :, None]
        sc = jnp.where(valid[:, :, None, None, :], sc, NEG_INF)
        p = jax.nn.softmax(sc, axis=-1).astype(v.dtype)
        return jnp.einsum('bqhgn,bqnhd->bqhgd', p, v_sel)

    q_ids = jnp.arange(s).reshape(-1, Q_BLOCK)
    out = lax.map(block, (to_blocks(q), to_blocks(q_i), to_blocks(w_i), to_blocks(pos), q_ids))
    return from_blocks(out).reshape(b, s, DSA_HEADS * DSA_HEAD_DIM)


def moe_ffn(h, w_router, b_router, w_mlp1, b_mlp1, w_mlp2, b_mlp2):
    b, s, d = h.shape
    xf = h.reshape(-1, d)
    n = xf.shape[0]
    logits = (xf @ w_router + b_router).astype(jnp.float32)
    top_val, top_idx = lax.top_k(logits, TOP_K)
    gates = jax.nn.softmax(top_val, axis=-1)
    n_assign = n * TOP_K
    flat_e = top_idx.reshape(-1)
    flat_tok = jnp.arange(n_assign, dtype=jnp.int32) // TOP_K
    flat_gate = gates.reshape(-1)
    order = jnp.argsort(flat_e)
    e_sorted = flat_e[order]
    counts = jnp.bincount(flat_e, length=N_EXPERTS)
    start = jnp.cumsum(counts) - counts
    padded = (counts + MOE_BLOCK - 1) // MOE_BLOCK * MOE_BLOCK
    pad_end = jnp.cumsum(padded)
    pad_start = pad_end - padded
    dest = pad_start[e_sorted] + jnp.arange(n_assign) - start[e_sorted]
    n_slots = (n_assign + MOE_BLOCK - 1) // MOE_BLOCK * MOE_BLOCK + N_EXPERTS * MOE_BLOCK
    n_blocks = n_slots // MOE_BLOCK
    slot_tok = jnp.full((n_slots,), n, jnp.int32).at[dest].set(flat_tok[order])
    slot_gate = jnp.zeros((n_slots,), jnp.float32).at[dest].set(flat_gate[order])
    block_e = jnp.minimum(
        jnp.searchsorted(pad_end, jnp.arange(n_blocks) * MOE_BLOCK, side='right'), N_EXPERTS - 1)
    x_pad = jnp.concatenate([xf, jnp.zeros((1, d), xf.dtype)], axis=0)
    x_slots = x_pad[slot_tok].reshape(n_blocks, MOE_BLOCK, d)

    def expert_block(args):
        xb, e = args
        hid = xb @ w_mlp1[e] + b_mlp1[e]
        glu = jnp.minimum(hid[..., ::2], SWIGLU_LIMIT)
        lin = jnp.clip(hid[..., 1::2], -SWIGLU_LIMIT, SWIGLU_LIMIT)
        act = glu * jax.nn.sigmoid(SWIGLU_ALPHA * glu) * (lin + 1.0)
        return act @ w_mlp2[e] + b_mlp2[e]

    y = lax.map(expert_block, (x_slots, block_e)).reshape(n_slots, d)
    y = y * slot_gate[:, None].astype(y.dtype)
    out = jax.ops.segment_sum(y, slot_tok, num_segments=n + 1)[:n]
    return out.reshape(b, s, d)


def setup_inputs(seed: int = 0) -> dict:
    key = jax.random.key(seed)
    ks = jax.random.split(key, 24)
    f32 = jnp.float32
    L, D, F, E = DEPTH, D_MODEL, D_EXPERT, N_EXPERTS

    def nrm(k, shape, scale):
        return jax.random.normal(k, shape, f32) * scale

    def gain(k, width):
        return 1.0 + nrm(k, (L, width), 0.02)

    x = nrm(ks[0], (BATCH, SEQ, D), 1.0)
    c = nrm(ks[1], (BATCH, D), 1.0)
    offsets = jax.random.randint(ks[2], (BATCH, 1), 0, 4096, dtype=jnp.int32)
    positions = offsets + jnp.arange(SEQ, dtype=jnp.int32)[None, :]
    return {
        "x": x,
        "c": c,
        "positions": positions,
        "w_ada": nrm(ks[3], (L, D, 6 * D), 0.2 * D ** -0.5),
        "b_ada": nrm(ks[4], (L, 6 * D), 0.01),
        "g_pre_mix": gain(ks[5], D),
        "g_post_mix": gain(ks[6], D),
        "g_pre_ffn": gain(ks[7], D),
        "g_post_ffn": gain(ks[8], D),
        "w_in": nrm(ks[9], (L, D, IN_WIDTH), D ** -0.5),
        "g_q_a": gain(ks[10], MLA_Q_RANK),
        "g_kv_a": gain(ks[11], MLA_KV_RANK),
        "w_q_b": nrm(ks[12], (L, MLA_Q_RANK, MLA_HEADS * (MLA_NOPE + MLA_ROPE)), MLA_Q_RANK ** -0.5),
        "w_kv_b": nrm(ks[13], (L, MLA_KV_RANK, MLA_HEADS * (MLA_NOPE + MLA_V)), MLA_KV_RANK ** -0.5),
        "w_o": nrm(ks[14], (L, MIX_WIDTH, D), MIX_WIDTH ** -0.5),
        "w_router": nrm(ks[15], (L, D, E), D ** -0.5),
        "b_router": nrm(ks[16], (L, E), 0.01),
        "w_mlp1": nrm(ks[17], (L, E, D, 2 * F), D ** -0.5),
        "b_mlp1": nrm(ks[18], (L, E, 2 * F), 0.01),
        "w_mlp2": nrm(ks[19], (L, E, F, D), F ** -0.5),
        "b_mlp2": nrm(ks[20], (L, E, D), 0.01),
    }


def reference(x, c, positions, w_ada, b_ada, g_pre_mix, g_post_mix, g_pre_ffn, g_post_ffn,
              w_in, g_q_a, g_kv_a, w_q_b, w_kv_b, w_o, w_router, b_router,
              w_mlp1, b_mlp1, w_mlp2, b_mlp2):
    split_at = np.cumsum(IN_SPLITS)[:-1].tolist()
    cond = jax.nn.silu(c)
    for l in range(DEPTH):
        mod = cond @ w_ada[l] + b_ada[l]
        sh1, sc1, gt1, sh2, sc2, gt2 = [m[:, None, :] for m in jnp.split(mod, 6, axis=-1)]

        h = rms_norm(x, g_pre_mix[l]) * (1.0 + sc1) + sh1
        proj = h @ w_in[l]
        (c_q, c_kv, k_rope, q_d, k_d, v_d, q_idx, k_idx, w_idx) = jnp.split(proj, split_at, axis=-1)
        y_mla = mla_attention(c_q, c_kv, k_rope, positions, g_q_a[l], g_kv_a[l], w_q_b[l], w_kv_b[l])
        y_dsa = dsa_attention(q_d, k_d, v_d, q_idx, k_idx, w_idx, positions)
        mix = jnp.concatenate([y_mla, y_dsa], axis=-1) @ w_o[l]
        x = x + gt1 * rms_norm(mix, g_post_mix[l])

        h2 = rms_norm(x, g_pre_ffn[l]) * (1.0 + sc2) + sh2
        ffn = moe_ffn(h2, w_router[l], b_router[l], w_mlp1[l], b_mlp1[l], w_mlp2[l], b_mlp2[l])
        x = x + gt2 * rms_norm(ffn, g_post_ffn[l])
    return x
```

```cpp
#include <hip/hip_runtime.h>
#include <cstdio>
#include <cstdint>

#ifndef MK_N_LAUNCHES
#define MK_N_LAUNCHES 1
#endif

#define LAS __attribute__((address_space(3)))
typedef unsigned short bf16_t;
typedef short bf16x8 __attribute__((ext_vector_type(8)));
typedef float f32x4 __attribute__((ext_vector_type(4)));
typedef float f32x16 __attribute__((ext_vector_type(16)));
typedef unsigned u32x4 __attribute__((ext_vector_type(4)));
typedef unsigned u32x2 __attribute__((ext_vector_type(2)));
typedef int i32x4 __attribute__((ext_vector_type(4)));
typedef int i32x8 __attribute__((ext_vector_type(8)));

constexpr int NB = 8, SEQ = 2048, DM = 1024, MT = NB * SEQ;
constexpr int NE = 32, FE = 1024;
constexpr int NPROJ = 1536;
constexpr int PC_CQ = 0, PC_CKV = 256, PC_KROPE = 384, PC_KIDX = 416, PC_WIDX = 448, PC_QD = 512, PC_KD = 1024, PC_VD = 1152, PC_QIDX = 1280;
constexpr float EPS = 1e-6f;
constexpr float LOG2E = 1.4426950408889634f;
constexpr int MAXTILES = 288;
constexpr int NSLOT = MAXTILES * 256;

constexpr size_t MiB = 1u << 20;
constexpr size_t WS_CTL = 0, CTL_BYTES = 64 * 1024;
constexpr size_t WS_MODP = 1 * MiB;
constexpr size_t WS_ROPE = 3 * MiB;
constexpr size_t WS_SSQ = 5 * MiB;
constexpr size_t WS_ROUTE = 6 * MiB;
constexpr size_t WS_LIST = 7 * MiB;
constexpr size_t WS_WIN = 9 * MiB;
constexpr size_t WS_WQB = 12 * MiB;
constexpr size_t WS_WKVB = 13 * MiB;
constexpr size_t WS_WO = 14 * MiB;
constexpr size_t WS_BITMAP = 16 * MiB;
constexpr size_t WS_VTM = 20 * MiB;
constexpr size_t WS_VTD = 36 * MiB;
constexpr size_t WS_HB = 40 * MiB;
constexpr size_t WS_PROJ = 72 * MiB;
constexpr size_t WS_QM = 120 * MiB;
constexpr size_t WS_KM = 144 * MiB;
constexpr size_t WS_Y = 168 * MiB;
constexpr size_t WS_MIX = 200 * MiB;
constexpr size_t WS_W1T = 232 * MiB;
constexpr size_t WS_W2T = 360 * MiB;
constexpr size_t WS_ACT = 424 * MiB;
constexpr size_t WS_YB = 568 * MiB;
constexpr size_t WS_END = 712 * MiB;
constexpr int CW_CNT = 64, CNT_STRIDE = 64;
constexpr int CW_BAR = 8192;

constexpr int LDS_BYTES = 163840;
constexpr int LDS_CTRL = 163328;

__device__ __forceinline__ unsigned f2bf(float f) { unsigned u = __builtin_bit_cast(unsigned, f); return (u + 0x7fffu + ((u >> 16) & 1u)) >> 16; }
__device__ __forceinline__ unsigned pk2(float lo, float hi) { return f2bf(lo) | (f2bf(hi) << 16); }
__device__ __forceinline__ float bflo(unsigned u) { return __builtin_bit_cast(float, u << 16); }
__device__ __forceinline__ float bfhi(unsigned u) { return __builtin_bit_cast(float, u & 0xffff0000u); }
__device__ __forceinline__ float wave_sum(float v) {
#pragma unroll
    for (int o = 1; o < 64; o <<= 1) v += __shfl_xor(v, o);
    return v;
}
#define LDS_WAIT() asm volatile("s_waitcnt lgkmcnt(0)" ::: "memory")
__device__ __forceinline__ int fresh_lane() { int l = __builtin_amdgcn_mbcnt_hi(~0u, __builtin_amdgcn_mbcnt_lo(~0u, 0u)); asm volatile("" : "+v"(l)); return l; }

namespace pg8 {
constexpr int BM = 256, BK = 64, HALF = 128, HTB = HALF * BK * 2, STAGE_BYTES = 8 * HTB, NXCD = 8, WGM = 8;
__host__ __device__ __forceinline__ int lds_byte(int r, int c) { const int st = (r >> 4) * 2 + (c >> 5), rr = r & 15, cc = c & 31, ob = rr * 64 + cc * 2; return st * 1024 + (ob ^ (((ob >> 9) & 1) << 5)); }
__host__ __device__ __forceinline__ void stage_rc(int b, int& R, int& C) { const int st = b / 1024, sb = b % 1024, swz = sb ^ (((sb >> 9) & 1) << 5); R = (st >> 1) * 16 + swz / 64; C = (st & 1) * 32 + (swz % 64) / 2; }
__host__ __device__ __forceinline__ int perm32(int rho) { const int n = rho >> 4, i = rho & 15; return 8 * (i >> 2) + 4 * n + (i & 3); }

struct Unit { int pm, pn, e, mt; };

struct StaticOrder {
    static constexpr bool GATHER = false;
    int nM, nN, nwg, G, c; const char* Bt; int ldb;
    __device__ void init(int M, int N, int G_, int c_, const void* Bt_, int ldb_bytes) { nM = M / BM; nN = N / BM; nwg = nM * nN; G = G_; c = c_; Bt = (const char*)Bt_; ldb = ldb_bytes; }
    __device__ bool next(int i, Unit& u, int ehint = 0) const {
        const long L = (long)i * G + c; if (L >= nwg) return false;
        int wgid = (int)L; { const int q = nwg / NXCD, r = nwg % NXCD, xcd = wgid % NXCD, off = wgid / NXCD; wgid = (xcd < r ? xcd * (q + 1) : r * (q + 1) + (xcd - r) * q) + off; }
        const int nig = WGM * nN, gid = wgid / nig, fm = gid * WGM, gsz = (nM - fm) < WGM ? (nM - fm) : WGM;
        u.pm = fm + ((wgid % nig) % gsz); u.pn = (wgid % nig) / gsz; u.e = 0; u.mt = 0; return true;
    }
    __device__ __forceinline__ const char* bptr(const Unit& u) const { return Bt + (size_t)u.pn * BM * ldb; }
    __device__ __forceinline__ int arow(const Unit& u, int r) const { return u.pm * BM + r; }
};

template <bool GATHER_> struct MoeOrder {
    static constexpr bool GATHER = GATHER_;
    const LAS int* ts;
    const LAS int* cnts;
    const int* list;
    const char* Bt; int nrows_b  , ldb  , nN, G, c, nwg;
    __device__ void init(const LAS int* ts_, const LAS int* cnts_, const int* list_, const void* Bt_, int nrows_b_, int ldb_, int nN_, int G_, int c_) {
        ts = ts_; cnts = cnts_; list = list_; Bt = (const char*)Bt_; nrows_b = nrows_b_; ldb = ldb_; nN = nN_; G = G_; c = c_; nwg = __builtin_amdgcn_readfirstlane(ts_[32]) * nN_; }
    __device__ bool next(int i, Unit& u, int ehint = 0) const {
        const long L = (long)i * G + c; if (L >= nwg) return false;
        int wgid = (int)L; { const int q = nwg / NXCD, r = nwg % NXCD, xcd = wgid % NXCD, off = wgid / NXCD; wgid = (xcd < r ? xcd * (q + 1) : r * (q + 1) + (xcd - r) * q) + off; }
        int e = ehint;
        while (e < 31 && __builtin_amdgcn_readfirstlane(ts[e + 1]) * nN <= wgid) ++e;
        const int t0 = __builtin_amdgcn_readfirstlane(ts[e]), T = __builtin_amdgcn_readfirstlane(ts[e + 1]) - t0, local = wgid - t0 * nN;
        u.e = e; u.pn = local / T; u.mt = local % T; u.pm = t0 + u.mt; return true;
    }
    __device__ __forceinline__ const char* bptr(const Unit& u) const { return Bt + ((size_t)u.e * nrows_b + (size_t)u.pn * BM) * ldb; }
    __device__ __forceinline__ int arow(const Unit& u, int r) const {
        if (!GATHER) return u.pm * BM + r;
        const int p = u.mt * BM + r; return (p < cnts[u.e]) ? list[u.e * MT + p] : 0;
    }
};

__device__ __forceinline__ unsigned cvt_pk_bf16(float lo, float hi) { unsigned r; asm volatile("v_cvt_pk_bf16_f32 %0, %1, %2" : "=v"(r) : "v"(lo), "v"(hi)); return r; }
__device__ __forceinline__ u32x4 pack8(const f32x4& a, const f32x4& b) { u32x4 w; w.x = cvt_pk_bf16(a[0], a[1]); w.y = cvt_pk_bf16(a[2], a[3]); w.z = cvt_pk_bf16(b[0], b[1]); w.w = cvt_pk_bf16(b[2], b[3]); return w; }

template <class Epi, class Sched, bool ALIGN_EPI, bool FP8 = false>
__device__ __forceinline__ void gemm_phase(LAS unsigned char* lds, const void* A, int lda, int kbytes, const Sched& S, const Epi& E, int wid) {
    const int lane = fresh_lane(), tid = wid * 64 + lane, wr = wid >> 2, wc = wid & 3, fr = lane & 15, fq = lane >> 4;
    const int nt = kbytes / 128; const int ldb = S.ldb;
    constexpr bool GA = Sched::GATHER;
    unsigned voffB[2], voffA[2]; int RA[2]; unsigned CA[2];
#pragma unroll
    for (int i = 0; i < 2; ++i) { int R, C; stage_rc(tid * 16 + i * 8192, R, C); const int Rb = (R & ~31) + perm32(R & 31);
        RA[i] = R; CA[i] = (unsigned)C * 2u; voffA[i] = (unsigned)(R * lda) + (unsigned)C * 2u; voffB[i] = (unsigned)(Rb * ldb) + (unsigned)C * 2u; }
    const size_t hstepA = (size_t)HALF * lda;
    const size_t kstep = (size_t)(BK * 2);
    const size_t hstepB = (size_t)HALF * ldb;
    const unsigned ldsw = (unsigned)wid * 1024u;
    const int aoff = lds_byte(wr * 64 + fr, fq * 8), boff = lds_byte(wc * 32 + fr, fq * 8);
#define PG8_SA(b, h) (((b) * 2 + (h)) * HTB)
#define PG8_SB(b, h) ((4 + (b) * 2 + (h)) * HTB)
#define PG8_STAGE(bufoff, gbase, voff) do { _Pragma("unroll") for (int _i = 0; _i < 2; ++_i) \
        __builtin_amdgcn_global_load_lds((const unsigned*)((const char*)(gbase) + (voff)[_i]), (LAS unsigned*)(lds + (bufoff) + ldsw + _i * 8192), 16, 0, 0); } while (0)
#define PG8_LDA(dst, b, h) do { _Pragma("unroll") for (int m = 0; m < 4; ++m) _Pragma("unroll") for (int k = 0; k < 2; ++k) dst[m][k] = *(const LAS bf16x8*)(lds + PG8_SA(b, h) + aoff + m * 2048 + k * 1024); } while (0)
#define PG8_LDB(dst, b, h) do { _Pragma("unroll") for (int n = 0; n < 2; ++n) _Pragma("unroll") for (int k = 0; k < 2; ++k) dst[n][k] = *(const LAS bf16x8*)(lds + PG8_SB(b, h) + boff + n * 2048 + k * 1024); } while (0)
#define PG8_MMA(ai, bj, At, Bt) do { __builtin_amdgcn_s_setprio(1); \
        if constexpr (FP8) { _Pragma("unroll") for (int m = 0; m < 4; ++m) _Pragma("unroll") for (int n = 0; n < 2; ++n) { \
            const i32x8 bb_ = __builtin_shufflevector(__builtin_bit_cast(i32x4, Bt[n][0]), __builtin_bit_cast(i32x4, Bt[n][1]), 0, 1, 2, 3, 4, 5, 6, 7); \
            const i32x8 aa_ = __builtin_shufflevector(__builtin_bit_cast(i32x4, At[m][0]), __builtin_bit_cast(i32x4, At[m][1]), 0, 1, 2, 3, 4, 5, 6, 7); \
            asm volatile("v_mfma_scale_f32_16x16x128_f8f6f4 %0, %1, %2, %0, %3, %3 op_sel_hi:[0,0,0]" : "+v"(acc[ai][bj][m][n]) : "v"(bb_), "v"(aa_), "v"(sc1_)); } } \
        else { _Pragma("unroll") for (int m = 0; m < 4; ++m) _Pragma("unroll") for (int n = 0; n < 2; ++n) _Pragma("unroll") for (int k = 0; k < 2; ++k) \
            acc[ai][bj][m][n] = __builtin_amdgcn_mfma_f32_16x16x32_bf16(Bt[n][k], At[m][k], acc[ai][bj][m][n], 0, 0, 0); } \
        __builtin_amdgcn_s_setprio(0); } while (0)
#define PG8_WAIT_V(n) asm volatile("s_waitcnt vmcnt(" #n ")" ::: "memory")
#define PG8_WAIT_L(n) asm volatile("s_waitcnt lgkmcnt(" #n ")" ::: "memory")
#define PG8_BAR __builtin_amdgcn_s_barrier()
#define PG8_SCHED __builtin_amdgcn_sched_barrier(0)
#define PG8_STA(bufoff, nx, h, kb) do { if constexpr (GA) { unsigned _w[2]; _Pragma("unroll") for (int _i = 0; _i < 2; ++_i) _w[_i] = (nx) ? vN[h][_i] : vA[h][_i]; PG8_STAGE(bufoff, Ab + (kb), _w); } \
        else { PG8_STAGE(bufoff, ((nx) ? nA : cA) + (h) * hstepA + (kb), voffA); } } while (0)
#define PG8_AOFF(dst, u) do { _Pragma("unroll") for (int _h = 0; _h < 2; ++_h) _Pragma("unroll") for (int _i = 0; _i < 2; ++_i) \
        dst[_h][_i] = (unsigned)S.arow(u, _h * HALF + RA[_i]) * (unsigned)lda + CA[_i]; } while (0)
#define PG8_AROW(dst, u) do { _Pragma("unroll") for (int _h = 0; _h < 2; ++_h) _Pragma("unroll") for (int _i = 0; _i < 2; ++_i) \
        dst[_h][_i] = (unsigned)S.arow(u, _h * HALF + RA[_i]); } while (0)
    Unit cur, nxt; int ui = 0;
    if (!S.next(0, cur)) return;
    f32x4 acc[2][2][4][2];
#pragma unroll
    for (int a = 0; a < 2; ++a)
#pragma unroll
        for (int b = 0; b < 2; ++b)
#pragma unroll
            for (int m = 0; m < 4; ++m)
#pragma unroll
                for (int n = 0; n < 2; ++n) acc[a][b][m][n] = (f32x4){0.f, 0.f, 0.f, 0.f};
    bf16x8 At[4][2], B0[2][2], B1[2][2];
    int sc1_ = 0x7f7f7f7f; asm volatile("" : "+v"(sc1_));
    unsigned vA[2][2], vN[2][2];
    if constexpr (GA) { PG8_AOFF(vA, cur); }
    const char* Ab = (const char*)A;
    const char* cA = Ab + (size_t)S.arow(cur, 0) * lda; const char* nA = cA;
    const char* cB = S.bptr(cur);
    PG8_STAGE(PG8_SB(0, 0), cB, voffB); PG8_STAGE(PG8_SB(0, 1), cB + hstepB, voffB); PG8_STA(PG8_SA(0, 0), false, 0, 0); PG8_STA(PG8_SA(0, 1), false, 1, 0);
    if (wr == 1) PG8_BAR;
    PG8_WAIT_V(2); PG8_BAR;
    PG8_STAGE(PG8_SB(1, 0), cB + kstep, voffB); PG8_STA(PG8_SA(1, 0), false, 0, kstep); PG8_STAGE(PG8_SB(1, 1), cB + hstepB + kstep, voffB);
    PG8_WAIT_V(6); PG8_BAR;
    for (;;) {
        const bool has_next = S.next(ui + 1, nxt, cur.e);
        if constexpr (GA) { if (has_next) { PG8_AROW(vN, nxt); } else {
#pragma unroll
            for (int _h = 0; _h < 2; ++_h)
#pragma unroll
                for (int _i = 0; _i < 2; ++_i) vN[_h][_i] = vA[_h][_i]; } }
        else { nA = has_next ? Ab + (size_t)S.arow(nxt, 0) * lda : cA; }
        const char* nB = has_next ? S.bptr(nxt) : cB;
#pragma unroll 1
        for (int t = 0; t < nt; t += 2) {
            const bool last = (t == nt - 2);
            if constexpr (GA) { if (last && has_next) {
#pragma unroll
                for (int _h = 0; _h < 2; ++_h)
#pragma unroll
                    for (int _i = 0; _i < 2; ++_i) vN[_h][_i] = vN[_h][_i] * (unsigned)lda + CA[_i]; } }
            const size_t k1 = (size_t)(t + 1) * kstep, k2 = last ? 0 : (size_t)(t + 2) * kstep, k3 = k2 + kstep;
            const char* b2 = last ? nB : cB + (size_t)(t + 2) * kstep; const char* b3 = b2 + kstep;
            PG8_LDB(B0, 0, 0); PG8_LDB(B1, 0, 1); PG8_SCHED; PG8_LDA(At, 0, 0); PG8_STA(PG8_SA(1, 1), false, 1, k1);
            PG8_WAIT_V(8); PG8_WAIT_L(0); PG8_BAR; PG8_MMA(0, 0, At, B0); PG8_MMA(0, 1, At, B1); PG8_BAR; PG8_SCHED;
            PG8_LDA(At, 0, 1); PG8_STAGE(PG8_SB(0, 0), b2, voffB); PG8_STAGE(PG8_SB(0, 1), b2 + hstepB, voffB); PG8_STA(PG8_SA(0, 0), last, 0, k2);
            PG8_WAIT_V(8); PG8_WAIT_L(0); PG8_BAR; PG8_MMA(1, 0, At, B0); PG8_MMA(1, 1, At, B1); PG8_BAR; PG8_SCHED;
            PG8_LDB(B0, 1, 0); PG8_LDB(B1, 1, 1); PG8_SCHED; PG8_LDA(At, 1, 0); PG8_STA(PG8_SA(0, 1), last, 1, k2);
            PG8_WAIT_V(8); PG8_WAIT_L(0); PG8_BAR; PG8_MMA(0, 0, At, B0); PG8_MMA(0, 1, At, B1); PG8_BAR; PG8_SCHED;
            PG8_LDA(At, 1, 1); PG8_STAGE(PG8_SB(1, 0), b3, voffB); PG8_STAGE(PG8_SB(1, 1), b3 + hstepB, voffB); PG8_STA(PG8_SA(1, 0), last, 0, k3);
            PG8_WAIT_V(8); PG8_WAIT_L(0); PG8_BAR; PG8_MMA(1, 0, At, B0); PG8_MMA(1, 1, At, B1); PG8_BAR; PG8_SCHED;
        }
        if constexpr (ALIGN_EPI) { if (wr == 0) PG8_BAR; }
        if constexpr (FP8) asm volatile("s_nop 15\n\ts_nop 7" ::: "memory");
        E(acc, cur, wr, wc, fr, fq);
        if (!has_next) break;
#pragma unroll
        for (int a = 0; a < 2; ++a)
#pragma unroll
            for (int b = 0; b < 2; ++b)
#pragma unroll
                for (int m = 0; m < 4; ++m)
#pragma unroll
                    for (int n = 0; n < 2; ++n) acc[a][b][m][n] = (f32x4){0.f, 0.f, 0.f, 0.f};
        cur = nxt; cB = nB; cA = nA; ++ui;
        if constexpr (GA) {
#pragma unroll
        for (int _h = 0; _h < 2; ++_h)
#pragma unroll
            for (int _i = 0; _i < 2; ++_i) vA[_h][_i] = vN[_h][_i]; }
        if constexpr (ALIGN_EPI) { if (wr == 1) PG8_BAR; }
    }
    PG8_WAIT_V(0);
    if constexpr (!ALIGN_EPI) { if (wr == 0) PG8_BAR; }
    PG8_BAR;
#undef PG8_SA
#undef PG8_SB
#undef PG8_STAGE
#undef PG8_LDA
#undef PG8_LDB
#undef PG8_MMA
#undef PG8_WAIT_V
#undef PG8_WAIT_L
#undef PG8_BAR
#undef PG8_SCHED
#undef PG8_AOFF
#undef PG8_AROW
#undef PG8_STA
}

struct EpiPlain {
    bf16_t* O; int ldc; float scale;
    __device__ __forceinline__ void operator()(const f32x4 (&acc)[2][2][4][2], const Unit& u, int wr, int wc, int fr_, int fq_) const {
        int ln_ = __builtin_amdgcn_mbcnt_hi(~0u, __builtin_amdgcn_mbcnt_lo(~0u, 0u)); asm volatile("" : "+v"(ln_)); const int fr = ln_ & 15, fq = ln_ >> 4;
        const int row0 = u.pm * BM + wr * 64 + fr, col0 = u.pn * BM + wc * 32 + 8 * fq;
#pragma unroll
        for (int ai = 0; ai < 2; ++ai)
#pragma unroll
            for (int m = 0; m < 4; ++m) { bf16_t* rowp = O + (size_t)(row0 + ai * HALF + m * 16) * ldc + col0;
#pragma unroll
                for (int bj = 0; bj < 2; ++bj) *(u32x4*)(rowp + bj * HALF) = pack8(acc[ai][bj][m][0] * scale, acc[ai][bj][m][1] * scale); }
    }
};

struct EpiInProj {
    bf16_t* proj; float* ssq_q; float* ssq_kv; bf16_t* Km; bf16_t* Vtd; const float* rcos; const float* rsin;
    __device__ __forceinline__ void operator()(const f32x4 (&acc)[2][2][4][2], const Unit& u, int wr, int wc, int fr_, int fq_) const {
        int ln_ = __builtin_amdgcn_mbcnt_hi(~0u, __builtin_amdgcn_mbcnt_lo(~0u, 0u)); asm volatile("" : "+v"(ln_)); const int fr = ln_ & 15, fq = ln_ >> 4;
        const int row0 = u.pm * BM + wr * 64 + fr, col0 = u.pn * BM + wc * 32 + 8 * fq;
        const int pn = u.pn;
#pragma unroll
        for (int ai = 0; ai < 2; ++ai)
#pragma unroll
            for (int m = 0; m < 4; ++m) {
                const int row = row0 + ai * HALF + m * 16;
                bf16_t* rowp = proj + (size_t)row * NPROJ + col0;
                float sq = 0.f;
#pragma unroll
                for (int bj = 0; bj < 2; ++bj) {
                    const f32x4 v0 = acc[ai][bj][m][0], v1 = acc[ai][bj][m][1];
                    *(u32x4*)(rowp + bj * HALF) = pack8(v0, v1);
                    if (pn == 0 || (pn == 1 && bj == 0)) sq += (v0[0] * v0[0] + v0[1] * v0[1]) + (v0[2] * v0[2] + v0[3] * v0[3]) + (v1[0] * v1[0] + v1[1] * v1[1]) + (v1[2] * v1[2] + v1[3] * v1[3]);
                    if (pn == 1 && bj == 1 && wc == 0) {
                        const int i0 = 8 * (fq & 1);
                        const f32x4 c0 = *(const f32x4*)(rcos + (size_t)row * 16 + i0), c1 = *(const f32x4*)(rcos + (size_t)row * 16 + i0 + 4);
                        const f32x4 s0 = *(const f32x4*)(rsin + (size_t)row * 16 + i0), s1 = *(const f32x4*)(rsin + (size_t)row * 16 + i0 + 4);
                        f32x4 o0, o1; const float sg = (fq < 2) ? -1.f : 1.f;
#pragma unroll
                        for (int j = 0; j < 4; ++j) { const float p0 = __shfl_xor(v0[j], 32), p1 = __shfl_xor(v1[j], 32);
                            o0[j] = v0[j] * c0[j] + sg * p0 * s0[j]; o1[j] = v1[j] * c1[j] + sg * p1 * s1[j]; }
                        const u32x4 w = pack8(o0, o1);
#pragma unroll
                        for (int h = 0; h < 8; ++h) *(u32x4*)(Km + (size_t)row * 768 + h * 96 + 64 + 8 * fq) = w;
                    }
                    if (pn == 4 && bj == 1) {
                        const int b = row >> 11, s = row & 2047, cv0 = wc * 32 + 8 * fq;
#pragma unroll
                        for (int j = 0; j < 8; ++j) { const int cv = cv0 + j; const float val = (j < 4) ? v0[j & 3] : v1[j & 3];
                            Vtd[((size_t)(b * 2 + (cv >> 6)) * 64 + (cv & 63)) * SEQ + s] = (bf16_t)f2bf(val); }
                    }
                }
                if (pn <= 1) { sq += __shfl_xor(sq, 16); sq += __shfl_xor(sq, 32); if (fq == 0) (pn == 0 ? ssq_q : ssq_kv)[(size_t)row * 4 + wc] = sq; }
            }
    }
};

struct EpiQb {
    bf16_t* Qm; const float* ssq_q; const float* rcos; const float* rsin; float c2;
    __device__ __forceinline__ void operator()(const f32x4 (&acc)[2][2][4][2], const Unit& u, int wr, int wc, int fr_, int fq_) const {
        int ln_ = __builtin_amdgcn_mbcnt_hi(~0u, __builtin_amdgcn_mbcnt_lo(~0u, 0u)); asm volatile("" : "+v"(ln_)); const int fr = ln_ & 15, fq = ln_ >> 4;
        const int row0 = u.pm * BM + wr * 64 + fr, col0 = u.pn * BM + wc * 32 + 8 * fq;
#pragma unroll
        for (int ai = 0; ai < 2; ++ai)
#pragma unroll
            for (int m = 0; m < 4; ++m) {
                const int row = row0 + ai * HALF + m * 16;
                const f32x4 rs = *(const f32x4*)(ssq_q + (size_t)row * 4);
                const float rstd = rsqrtf(((rs[0] + rs[1]) + (rs[2] + rs[3])) * (1.f / 256.f) + EPS) * c2;
#pragma unroll
                for (int bj = 0; bj < 2; ++bj) {
                    f32x4 v0 = acc[ai][bj][m][0] * rstd, v1 = acc[ai][bj][m][1] * rstd;
                    const int G = 8 * u.pn + 4 * bj + wc;
                    if (G % 3 == 2) {
                        const int i0 = 8 * (fq & 1);
                        const f32x4 c0 = *(const f32x4*)(rcos + (size_t)row * 16 + i0), c1 = *(const f32x4*)(rcos + (size_t)row * 16 + i0 + 4);
                        const f32x4 s0 = *(const f32x4*)(rsin + (size_t)row * 16 + i0), s1 = *(const f32x4*)(rsin + (size_t)row * 16 + i0 + 4);
                        f32x4 o0, o1; const float sg = (fq < 2) ? -1.f : 1.f;
#pragma unroll
                        for (int j = 0; j < 4; ++j) { const float p0 = __shfl_xor(v0[j], 32), p1 = __shfl_xor(v1[j], 32);
                            o0[j] = v0[j] * c0[j] + sg * p0 * s0[j]; o1[j] = v1[j] * c1[j] + sg * p1 * s1[j]; }
                        v0 = o0; v1 = o1;
                    }
                    *(u32x4*)(Qm + (size_t)row * 768 + col0 + bj * HALF) = pack8(v0, v1);
                }
                asm volatile("" ::: "memory");
            }
    }
};

struct EpiKvb {
    bf16_t* Km; bf16_t* Vtm; const float* ssq_kv;
    __device__ __forceinline__ void operator()(const f32x4 (&acc)[2][2][4][2], const Unit& u, int wr, int wc, int fr_, int fq_) const {
        int ln_ = __builtin_amdgcn_mbcnt_hi(~0u, __builtin_amdgcn_mbcnt_lo(~0u, 0u)); asm volatile("" : "+v"(ln_)); const int fr = ln_ & 15, fq = ln_ >> 4;
        const int row0 = u.pm * BM + wr * 64 + fr, col0 = u.pn * BM + wc * 32 + 8 * fq;
#pragma unroll
        for (int ai = 0; ai < 2; ++ai)
#pragma unroll
            for (int m = 0; m < 4; ++m) {
                const int row = row0 + ai * HALF + m * 16;
                const f32x4 rs = *(const f32x4*)(ssq_kv + (size_t)row * 4);
                const float rstd = rsqrtf(((rs[0] + rs[1]) + (rs[2] + rs[3])) * (1.f / 128.f) + EPS);
#pragma unroll
                for (int bj = 0; bj < 2; ++bj) {
                    const f32x4 v0 = acc[ai][bj][m][0] * rstd, v1 = acc[ai][bj][m][1] * rstd;
                    const int col = col0 + bj * HALF;
                    if (u.pn < 2) { const int h = col >> 6, d = col & 63; *(u32x4*)(Km + (size_t)row * 768 + h * 96 + d) = pack8(v0, v1); }
                    else { const int cv = col - 512, h = cv >> 6, d0 = cv & 63, b = row >> 11, s = row & 2047;
#pragma unroll
                        for (int j = 0; j < 8; ++j) { const float val = (j < 4) ? v0[j & 3] : v1[j & 3];
                            Vtm[((size_t)(b * 8 + h) * 64 + d0 + j) * SEQ + s] = (bf16_t)f2bf(val); } }
                }
            }
    }
};

constexpr float W8_SCALE = 64.f, W8_INV = 1.f / 64.f;
struct EpiMoe1 {
    unsigned char* act; const float* b1;
    __device__ __forceinline__ void operator()(const f32x4 (&acc)[2][2][4][2], const Unit& u, int wr, int wc, int fr_, int fq_) const {
        int ln_ = __builtin_amdgcn_mbcnt_hi(~0u, __builtin_amdgcn_mbcnt_lo(~0u, 0u)); asm volatile("" : "+v"(ln_)); const int fr = ln_ & 15, fq = ln_ >> 4;
        const int row0 = u.pm * BM + wr * 64 + fr, col0 = u.pn * BM + wc * 32 + 8 * fq;
        f32x4 bv[2][2];
#pragma unroll
        for (int bj = 0; bj < 2; ++bj)
#pragma unroll
            for (int n = 0; n < 2; ++n) bv[bj][n] = *(const f32x4*)(b1 + (size_t)u.e * 2048 + col0 + bj * HALF + 4 * n);
#pragma unroll
        for (int ai = 0; ai < 2; ++ai)
#pragma unroll
            for (int m = 0; m < 4; ++m) {
                unsigned char* rowp = act + (size_t)(row0 + ai * HALF + m * 16) * FE + (col0 >> 1);
#pragma unroll
                for (int bj = 0; bj < 2; ++bj) {
                    const f32x4 v0 = acc[ai][bj][m][0] * W8_INV + bv[bj][0], v1 = acc[ai][bj][m][1] * W8_INV + bv[bj][1];
                    float o[4];
#pragma unroll
                    for (int p = 0; p < 4; ++p) { const float g = fminf((p < 2) ? v0[2 * (p & 1)] : v1[2 * (p & 1)], 7.f);
                        const float l = fminf(fmaxf((p < 2) ? v0[2 * (p & 1) + 1] : v1[2 * (p & 1) + 1], -7.f), 7.f);
                        const float sg = __builtin_amdgcn_rcpf(1.f + __builtin_amdgcn_exp2f(-1.702f * LOG2E * g));
                        o[p] = g * sg * (l + 1.f); }
                    int w = 0; w = __builtin_amdgcn_cvt_pk_fp8_f32(o[0], o[1], w, false); w = __builtin_amdgcn_cvt_pk_fp8_f32(o[2], o[3], w, true);
                    *(int*)(rowp + bj * (HALF / 2)) = w;
                }
            }
    }
};

struct EpiMoe2 {
    bf16_t* yb; const float* b2;
    __device__ __forceinline__ void operator()(const f32x4 (&acc)[2][2][4][2], const Unit& u, int wr, int wc, int fr_, int fq_) const {
        int ln_ = __builtin_amdgcn_mbcnt_hi(~0u, __builtin_amdgcn_mbcnt_lo(~0u, 0u)); asm volatile("" : "+v"(ln_)); const int fr = ln_ & 15, fq = ln_ >> 4;
        const int row0 = u.pm * BM + wr * 64 + fr, col0 = u.pn * BM + wc * 32 + 8 * fq;
        f32x4 bv[2][2];
#pragma unroll
        for (int bj = 0; bj < 2; ++bj)
#pragma unroll
            for (int n = 0; n < 2; ++n) bv[bj][n] = *(const f32x4*)(b2 + (size_t)u.e * 1024 + col0 + bj * HALF + 4 * n);
#pragma unroll
        for (int ai = 0; ai < 2; ++ai)
#pragma unroll
            for (int m = 0; m < 4; ++m) { bf16_t* rowp = yb + (size_t)(row0 + ai * HALF + m * 16) * FE + col0;
#pragma unroll
                for (int bj = 0; bj < 2; ++bj) *(u32x4*)(rowp + bj * HALF) = pack8(acc[ai][bj][m][0] * W8_INV + bv[bj][0], acc[ai][bj][m][1] * W8_INV + bv[bj][1]); }
    }
};
}

struct Args {
    const float* x; const float* c; const int* pos; const float* w_ada; const float* b_ada;
    const float* g_pre_mix; const float* g_post_mix; const float* g_pre_ffn; const float* g_post_ffn;
    const float* w_in; const float* g_q_a; const float* g_kv_a; const float* w_q_b; const float* w_kv_b; const float* w_o;
    const float* w_router; const float* b_router; const float* w_mlp1; const float* b_mlp1; const float* w_mlp2; const float* b_mlp2;
    float* out; unsigned char* ws; int ph_lo, ph_hi;
};

__device__ __forceinline__ unsigned cvt_pk_bf16_(float lo, float hi) { unsigned r; asm volatile("v_cvt_pk_bf16_f32 %0, %1, %2" : "=v"(r) : "v"(lo), "v"(hi)); return r; }
template <bool FP8>
__device__ __forceinline__ void transpose_item(const float* W, int ldw, int srccol0, int nvalid, bool kvalid, const float* kscale, float cscale,
                                               void* WT, int ldk, int dstrow0, int k0, LAS float* scr, int lane) {
    const int kr = lane >> 3, n4 = (lane & 7) * 4;
#pragma unroll
    for (int i = 0; i < 8; ++i) { const int kk = kr + 8 * i;
        f32x4 v = (f32x4){0.f, 0.f, 0.f, 0.f};
        if (kvalid && n4 < nvalid) { v = *(const f32x4*)(W + (size_t)(k0 + kk) * ldw + srccol0 + n4); float sc = cscale; if (kscale) sc *= kscale[k0 + kk]; v = v * sc; }
        *(LAS f32x4*)(scr + kk * 36 + n4) = v; }
    LDS_WAIT(); asm volatile("" ::: "memory");
    const int n = lane & 31, kh = lane >> 5;
    const LAS float* sp = scr + (32 * kh) * 36 + n;
    if constexpr (FP8) {
        int w[8];
#pragma unroll
        for (int q = 0; q < 8; ++q) { float f0 = sp[(4 * q) * 36], f1 = sp[(4 * q + 1) * 36], f2 = sp[(4 * q + 2) * 36], f3 = sp[(4 * q + 3) * 36];
            f0 = fminf(fmaxf(f0, -448.f), 448.f); f1 = fminf(fmaxf(f1, -448.f), 448.f); f2 = fminf(fmaxf(f2, -448.f), 448.f); f3 = fminf(fmaxf(f3, -448.f), 448.f);
            int t = 0; t = __builtin_amdgcn_cvt_pk_fp8_f32(f0, f1, t, false); t = __builtin_amdgcn_cvt_pk_fp8_f32(f2, f3, t, true); w[q] = t; }
        unsigned char* dst = (unsigned char*)WT + (size_t)(dstrow0 + n) * ldk + k0 + 32 * kh;
        *(i32x4*)dst = (i32x4){w[0], w[1], w[2], w[3]}; *(i32x4*)(dst + 16) = (i32x4){w[4], w[5], w[6], w[7]};
    } else {
        unsigned w[16];
#pragma unroll
        for (int q = 0; q < 16; ++q) w[q] = cvt_pk_bf16_(sp[(2 * q) * 36], sp[(2 * q + 1) * 36]);
        bf16_t* dst = (bf16_t*)WT + (size_t)(dstrow0 + n) * ldk + k0 + 32 * kh;
#pragma unroll
        for (int q = 0; q < 4; ++q) *(u32x4*)(dst + 8 * q) = (u32x4){w[4 * q], w[4 * q + 1], w[4 * q + 2], w[4 * q + 3]};
    }
    LDS_WAIT(); asm volatile("" ::: "memory");
}

__device__ __forceinline__ void moe_item_decode(const Args& a, int r, const float*& W, int& ldw, unsigned char*& WT, int& srccol, int& k0) {
    constexpr int I_M1 = 32 * 16 * 64;
    if (r < I_M1) { const int e = r / 1024, q = r % 1024, kb = q / 64, nb = q % 64; W = a.w_mlp1 + (size_t)e * 1024 * 2048; ldw = 2048; WT = a.ws + WS_W1T + (size_t)e * 2048 * 1024; srccol = 32 * nb; k0 = 64 * kb; }
    else { r -= I_M1; const int e = r / 512, q = r % 512, kb = q / 32, nb = q % 32; W = a.w_mlp2 + (size_t)e * 1024 * 1024; ldw = 1024; WT = a.ws + WS_W2T + (size_t)e * 1024 * 1024; srccol = 32 * nb; k0 = 64 * kb; }
}
__device__ __forceinline__ void moe_item_load(const Args& a, int r, f32x4 (&v)[8], int lane) {
    const float* W; int ldw, srccol, k0; unsigned char* WT; moe_item_decode(a, r, W, ldw, WT, srccol, k0);
    const int kr = lane >> 3, n4 = (lane & 7) * 4;
#pragma unroll
    for (int i = 0; i < 8; ++i) v[i] = __builtin_nontemporal_load((const f32x4*)(W + (size_t)(k0 + kr + 8 * i) * ldw + srccol + n4));
}
__device__ __forceinline__ void moe_item_finish(const Args& a, int r, const f32x4 (&v)[8], LAS float* scr, int lane) {
    const float* W; int ldw, srccol, k0; unsigned char* WT; moe_item_decode(a, r, W, ldw, WT, srccol, k0);
    const int kr = lane >> 3, n4 = (lane & 7) * 4;
#pragma unroll
    for (int i = 0; i < 8; ++i) *(LAS f32x4*)(scr + (kr + 8 * i) * 36 + n4) = v[i] * pg8::W8_SCALE;
    LDS_WAIT(); asm volatile("" ::: "memory");
    const int n = lane & 31, kh = lane >> 5;
    const LAS float* sp = scr + (32 * kh) * 36 + n;
    int w[8];
#pragma unroll
    for (int q = 0; q < 8; ++q) { float f0 = sp[(4 * q) * 36], f1 = sp[(4 * q + 1) * 36], f2 = sp[(4 * q + 2) * 36], f3 = sp[(4 * q + 3) * 36];
        f0 = fminf(fmaxf(f0, -448.f), 448.f); f1 = fminf(fmaxf(f1, -448.f), 448.f); f2 = fminf(fmaxf(f2, -448.f), 448.f); f3 = fminf(fmaxf(f3, -448.f), 448.f);
        int t = 0; t = __builtin_amdgcn_cvt_pk_fp8_f32(f0, f1, t, false); t = __builtin_amdgcn_cvt_pk_fp8_f32(f2, f3, t, true); w[q] = t; }
    unsigned char* dst = WT + (size_t)(srccol + n) * 1024 + k0 + 32 * kh;
    *(i32x4*)dst = (i32x4){w[0], w[1], w[2], w[3]}; *(i32x4*)(dst + 16) = (i32x4){w[4], w[5], w[6], w[7]};
    LDS_WAIT(); asm volatile("" ::: "memory");
}

__device__ __forceinline__ void p0_prologue(const Args& a, LAS unsigned char* lds, int tid, int wave, int lane) {
    unsigned char* ws = a.ws;
    LAS float* scr = (LAS float*)(lds + wave * 9216);
    LAS float* cond = (LAS float*)(lds + 8 * 9216);
    for (int i = tid; i < NB * DM; i += 512) { const float v = a.c[i]; cond[i] = v / (1.f + __expf(-v)); }
    __syncthreads();
    const int gw = blockIdx.x * 8 + wave, NGW = gridDim.x * 8;
    constexpr int I_ADA = 8 * 192, I_IN = 16 * 48, I_QB = 4 * 24, I_KVB = 4 * 32, I_O = 16 * 32, I_M1 = 32 * 16 * 64, I_M2 = 32 * 16 * 32;
    constexpr int NITEMS = I_ADA + I_IN + I_QB + I_KVB + I_O;
    float* modp = (float*)(ws + WS_MODP);
    for (int it = gw; it < NITEMS; it += NGW) {
        int r = it;
        if (r < I_ADA) {
            const int kc = r / 192, cc = r % 192, k0 = 128 * kc + (lane >> 3), c0 = 32 * cc + 4 * (lane & 7);
            f32x4 acc[8];
#pragma unroll
            for (int b = 0; b < 8; ++b) acc[b] = (f32x4){0.f, 0.f, 0.f, 0.f};
#pragma unroll 8
            for (int i = 0; i < 16; ++i) { const int k = k0 + 8 * i;
                const f32x4 w = __builtin_nontemporal_load((const f32x4*)(a.w_ada + (size_t)k * 6144 + c0));
#pragma unroll
                for (int b = 0; b < 8; ++b) acc[b] += w * cond[b * DM + k]; }
#pragma unroll
            for (int b = 0; b < 8; ++b) {
#pragma unroll
                for (int j = 0; j < 4; ++j) { float v = acc[b][j]; v += __shfl_xor(v, 8); v += __shfl_xor(v, 16); v += __shfl_xor(v, 32); acc[b][j] = v; }
                if (lane < 8) *(f32x4*)(modp + (size_t)(kc * 8 + b) * 6144 + c0) = acc[b]; }
            continue;
        }
        r -= I_ADA;
        if (r < I_IN) {
            const int kb = r / 48, nb = r % 48, j = 32 * nb; int src, nv = 32; float cs = 1.f;
            if (j < 416) src = j;
            else if (j < 448) src = 1440 + (j - 416);
            else if (j < 480) { src = 1472; nv = 8; cs = 0.35355339059327373f; }
            else if (j < 512) { src = 0; nv = 0; }
            else if (j < 1024) { src = 416 + (j - 512); cs = 0.125f * LOG2E; }
            else if (j < 1152) src = 928 + (j - 1024);
            else if (j < 1280) src = 1056 + (j - 1152);
            else { src = 1184 + (j - 1280); cs = 0.17677669529663687f; }
            transpose_item<false>(a.w_in, 1480, src, nv, true, nullptr, cs, (bf16_t*)(ws + WS_WIN), 1024, j, 64 * kb, scr, lane); continue;
        }
        r -= I_IN;
        if (r < I_QB) { const int kb = r / 24, nb = r % 24;
            transpose_item<false>(a.w_q_b, 768, 32 * nb, 32, true, a.g_q_a, 1.f, (bf16_t*)(ws + WS_WQB), 256, 32 * nb, 64 * kb, scr, lane); continue; }
        r -= I_QB;
        if (r < I_KVB) { const int kb = r / 32, nb = r % 32, j = 32 * nb; int src;
            if (j < 512) src = (j >> 6) * 128 + (j & 63); else { const int jj = j - 512; src = (jj >> 6) * 128 + 64 + (jj & 63); }
            transpose_item<false>(a.w_kv_b, 1024, src, 32, kb < 2, a.g_kv_a, 1.f, (bf16_t*)(ws + WS_WKVB), 256, j, 64 * kb, scr, lane); continue; }
        r -= I_KVB;
        if (r < I_O) { const int kb = r / 32, nb = r % 32;
            transpose_item<true>(a.w_o, 1024, 32 * nb, 32, true, nullptr, pg8::W8_SCALE, ws + WS_WO, 1024, 32 * nb, 64 * kb, scr, lane); continue; }
    }
}

__device__ __forceinline__ void moe_weights_phase(const Args& a, LAS unsigned char* lds, int wave, int lane, int r0, int r1, int gw, int NGW) {
    LAS float* scr = (LAS float*)(lds + wave * 9216);
    constexpr int I_M1 = 32 * 16 * 64, I_M2 = 32 * 16 * 32;
    {
        const int NM = r1;
        f32x4 va[8], vb[8];
        int r = r0 + gw;
        if (r < NM) moe_item_load(a, r, va, lane);
#pragma unroll 1
        while (r < NM) {
            int r2 = r + NGW; if (r2 < NM) moe_item_load(a, r2, vb, lane);
            moe_item_finish(a, r, va, scr, lane);
            r = r2; if (r >= NM) break;
            r2 = r + NGW; if (r2 < NM) moe_item_load(a, r2, va, lane);
            moe_item_finish(a, r, vb, scr, lane);
            r = r2;
        }
    }
}

__device__ __forceinline__ float mod_at(const Args& a, int b, int j) {
    const float* modp = (const float*)(a.ws + WS_MODP);
    float s = a.b_ada[j];
#pragma unroll
    for (int kc = 0; kc < 8; ++kc) s += modp[(size_t)(kc * 8 + b) * 6144 + j];
    return s;
}

__device__ __forceinline__ void p1_rows(const Args& a, LAS unsigned char* lds, int tid, int wave, int lane) {
    LAS float* Amul = (LAS float*)lds; LAS float* Badd = Amul + DM;
    bf16_t* hb = (bf16_t*)(a.ws + WS_HB);
    float* rcos = (float*)(a.ws + WS_ROPE); float* rsin = rcos + (size_t)MT * 16;
    for (int blk = blockIdx.x; blk < MT / 64; blk += gridDim.x) {
        const int b = blk / 32;
        __syncthreads();
        for (int j = tid; j < DM; j += 512) { const float sh = mod_at(a, b, j), sc = mod_at(a, b, 1024 + j); Amul[j] = a.g_pre_mix[j] * (1.f + sc); Badd[j] = sh; }
        __syncthreads();
#pragma unroll 1
        for (int r0 = wave; r0 < 64; r0 += 32) {
            f32x4 v[4][4];
#pragma unroll
            for (int q = 0; q < 4; ++q) { const f32x4* xr = (const f32x4*)(a.x + (size_t)(blk * 64 + r0 + 8 * q) * DM) + lane;
#pragma unroll
                for (int j = 0; j < 4; ++j) v[q][j] = __builtin_nontemporal_load(xr + 64 * j); }
#pragma unroll
            for (int q = 0; q < 4; ++q) {
                const int row = blk * 64 + r0 + 8 * q;
                float ss = 0.f;
#pragma unroll
                for (int j = 0; j < 4; ++j) ss += (v[q][j][0] * v[q][j][0] + v[q][j][1] * v[q][j][1]) + (v[q][j][2] * v[q][j][2] + v[q][j][3] * v[q][j][3]);
                const float rstd = rsqrtf(wave_sum(ss) * (1.f / DM) + EPS);
                unsigned long long* o8 = (unsigned long long*)(hb + (size_t)row * DM) + lane;
#pragma unroll
                for (int j = 0; j < 4; ++j) { const f32x4 am = *(const LAS f32x4*)(Amul + 4 * lane + 256 * j), bd = *(const LAS f32x4*)(Badd + 4 * lane + 256 * j);
                    const f32x4 h = v[q][j] * rstd * am + bd;
                    o8[64 * j] = (unsigned long long)pk2(h[0], h[1]) | ((unsigned long long)pk2(h[2], h[3]) << 32); }
                if (lane < 16) { const float fr = powf(10000.f, -(float)lane / 16.f); const float ang = (float)a.pos[row] * fr; float sn, cs; sincosf(ang, &sn, &cs);
                    rcos[(size_t)row * 16 + lane] = cs; rsin[(size_t)row * 16 + lane] = sn; }
            }
        }
    }
}

__device__ __forceinline__ unsigned sortable(float v) { const unsigned u = __builtin_bit_cast(unsigned, v + 0.0f); return (u & 0x80000000u) ? ~u : (u | 0x80000000u); }

__device__ __forceinline__ unsigned wave_max_u(unsigned v) {
#pragma unroll
    for (int o = 1; o < 64; o <<= 1) { const unsigned w = (unsigned)__shfl_xor((int)v, o); v = v > w ? v : w; }
    return v; }
__device__ __forceinline__ unsigned wave_min_u(unsigned v) {
#pragma unroll
    for (int o = 1; o < 64; o <<= 1) { const unsigned w = (unsigned)__shfl_xor((int)v, o); v = v < w ? v : w; }
    return v; }

__device__ __forceinline__ void idx_item(LAS unsigned char* lds, const bf16_t* proj, unsigned* bitmap, int b, int tg, int wave, int lane) {
    constexpr int SCS = 2052;
    LAS float* sc = (LAS float*)lds;
    LAS unsigned* cbuf = (LAS unsigned*)(lds + 16 * SCS * 4) + wave * 64;
    const int t0 = tg * 16, nkt = tg + 1;
    const int n = lane & 15, kq = lane >> 4;
    const size_t rowq = (size_t)(b * SEQ + t0 + n);
    bf16x8 qf[8];
#pragma unroll
    for (int h = 0; h < 8; ++h) qf[h] = *(const bf16x8*)(proj + rowq * NPROJ + PC_QIDX + h * 32 + 8 * kq);
    const u32x4 wraw = *(const u32x4*)(proj + rowq * NPROJ + PC_WIDX);
    float w[8]; w[0] = bflo(wraw.x); w[1] = bfhi(wraw.x); w[2] = bflo(wraw.y); w[3] = bfhi(wraw.y); w[4] = bflo(wraw.z); w[5] = bfhi(wraw.z); w[6] = bflo(wraw.w); w[7] = bfhi(wraw.w);
#pragma unroll 1
    for (int base = wave; base < nkt; base += 64) {
        bf16x8 kf[8];
#pragma unroll
        for (int i = 0; i < 8; ++i) { const int kt = base + 8 * i; if (kt < nkt) kf[i] = *(const bf16x8*)(proj + (size_t)(b * SEQ + 16 * kt + n) * NPROJ + PC_KIDX + 8 * kq); }
#pragma unroll
        for (int i = 0; i < 8; ++i) { const int kt = base + 8 * i;
            if (kt < nkt) {
                f32x4 s = (f32x4){0.f, 0.f, 0.f, 0.f};
#pragma unroll
                for (int h = 0; h < 8; ++h) { const f32x4 d = __builtin_amdgcn_mfma_f32_16x16x32_bf16(kf[i], qf[h], (f32x4){0.f, 0.f, 0.f, 0.f}, 0, 0, 0);
#pragma unroll
                    for (int j = 0; j < 4; ++j) s[j] = fmaf(w[h], fmaxf(d[j], 0.f), s[j]); }
                *(LAS f32x4*)(sc + n * SCS + 16 * kt + 4 * kq) = s;
            } }
    }
    __syncthreads();
#pragma unroll 1
    for (int qq = 0; qq < 2; ++qq) {
        const int q = 2 * wave + qq, t = t0 + q;
        unsigned key[32];
#pragma unroll
        for (int j = 0; j < 32; ++j) key[j] = __builtin_bit_cast(unsigned, sc[q * SCS + 64 * j + lane]);
        asm volatile("" : "+v"(key[0]), "+v"(key[1]), "+v"(key[2]), "+v"(key[3]), "+v"(key[4]), "+v"(key[5]), "+v"(key[6]), "+v"(key[7]), "+v"(key[8]), "+v"(key[9]), "+v"(key[10]), "+v"(key[11]), "+v"(key[12]), "+v"(key[13]), "+v"(key[14]), "+v"(key[15]));
        asm volatile("" : "+v"(key[16]), "+v"(key[17]), "+v"(key[18]), "+v"(key[19]), "+v"(key[20]), "+v"(key[21]), "+v"(key[22]), "+v"(key[23]), "+v"(key[24]), "+v"(key[25]), "+v"(key[26]), "+v"(key[27]), "+v"(key[28]), "+v"(key[29]), "+v"(key[30]), "+v"(key[31]));
#pragma unroll
        for (int j = 0; j < 32; ++j) key[j] = (64 * j + lane <= t) ? sortable(__builtin_bit_cast(float, key[j])) : 0u;
        unsigned long long mine = 0ull; int lo_ = lane; asm volatile("" : "+v"(lo_));
        const unsigned long long lt = (1ull << lane) - 1ull;
        if (t + 1 > 256) {
            unsigned mx = key[0], mn = key[0] ? key[0] : 0xffffffffu;
#pragma unroll
            for (int j = 1; j < 32; ++j) { mx = mx > key[j] ? mx : key[j]; const unsigned kk = key[j] ? key[j] : 0xffffffffu; mn = mn < kk ? mn : kk; }
            mx = wave_max_u(mx); mn = wave_min_u(mn);
            mx = (unsigned)__builtin_amdgcn_readfirstlane((int)mx); mn = (unsigned)__builtin_amdgcn_readfirstlane((int)mn);
            unsigned T = mx; int hiCnt = 0, ngt = 0, neq = 0; bool have = false;
            const unsigned diff = mx ^ mn;
            if (diff != 0u) {
                int bit = 31 - __builtin_clz(diff);
                T = mx & ~(((2u << bit) - 1u));
                int cntT = t + 1;
#pragma unroll 1
                while (bit >= 0 && cntT - hiCnt > 64) {
                    const unsigned cand = T | (1u << bit); unsigned cl = 0u;
#pragma unroll
                    for (int j = 0; j < 32; ++j) cl += (key[j] >= cand) ? 1u : 0u;
                    int c = 0;
#pragma unroll
                    for (int bb = 0; bb < 6; ++bb) c += __popcll(__ballot((cl >> bb) & 1u)) << bb;
                    if (c >= 256) { T = cand; cntT = c; } else hiCnt = c;
                    --bit;
                }
                if (bit >= 0) {
                    const unsigned span = (2u << bit) - 1u; int run = 0;
#pragma unroll
                    for (int j = 0; j < 32; ++j) { const bool in = (key[j] != 0u) && ((key[j] - T) <= span); const unsigned long long m = __ballot(in);
                        if (in) cbuf[run + __popcll(m & lt)] = key[j]; run += __popcll(m); if ((j & 3) == 3) __builtin_amdgcn_sched_barrier(0); }
                    LDS_WAIT();
                    const unsigned ck = (lane < run) ? cbuf[lane] : 0u;
#pragma unroll 1
                    for (; bit >= 0; --bit) { const unsigned cand = T | (1u << bit); const int c = __popcll(__ballot(ck >= cand)); if (hiCnt + c >= 256) T = cand; }
                    ngt = hiCnt + __popcll(__ballot(ck > T)); neq = __popcll(__ballot(ck == T)); have = true;
                }
            }
            if (!have) {
#pragma unroll
                for (int j = 0; j < 32; ++j) { ngt += __popcll(__ballot(key[j] > T)); neq += __popcll(__ballot(key[j] == T)); if ((j & 3) == 3) __builtin_amdgcn_sched_barrier(0); }
            }
            const int need = 256 - ngt;
            asm volatile("" : "+s"(T));
            if (neq == need) {
#pragma unroll
                for (int j = 0; j < 32; ++j) { const unsigned long long mk = __ballot(key[j] >= T); mine = (lo_ == j) ? mk : mine; if ((j & 3) == 3) __builtin_amdgcn_sched_barrier(0); }
            } else {
                int run = 0;
#pragma unroll
                for (int j = 0; j < 32; ++j) { const bool eq = key[j] == T; const unsigned long long em = __ballot(eq); const int rank = run + __popcll(em & lt);
                    const unsigned long long mk = __ballot(key[j] > T || (eq && rank < need)); mine = (lo_ == j) ? mk : mine; run += __popcll(em); if ((j & 3) == 3) __builtin_amdgcn_sched_barrier(0); }
            }
        } else {
#pragma unroll
            for (int j = 0; j < 4; ++j) { const unsigned long long mk = __ballot(64 * j + lo_ <= t); mine = (lo_ == j) ? mk : mine; }
        }
        if (lane < 32) ((unsigned long long*)bitmap)[(size_t)(b * SEQ + t) * 32 + lane] = mine;
    }
    __syncthreads();
}

__device__ __forceinline__ int crow(int r, int hi) { return (r & 3) + 8 * (r >> 2) + 4 * hi; }
typedef float f32x2_t __attribute__((ext_vector_type(2))); typedef __bf16 bf16x2_t __attribute__((ext_vector_type(2)));
__device__ __forceinline__ unsigned cvtpk(float lo, float hi) { f32x2_t v = {lo, hi}; bf16x2_t b = __builtin_convertvector(v, bf16x2_t); return __builtin_bit_cast(unsigned, b); }

template <int DQK, bool DSA>
__device__ __forceinline__ void attn_unit(LAS unsigned char* lds, int b, int qt,
                                          const bf16_t* Qp, int ldq, const bf16_t* Kp, int ldk, const bf16_t* Vt, unsigned char* Yp,
                                          const unsigned* bitmap, const int* pos, float c1, float aslope, int tid, int wave, int lane) {
    constexpr int KSTR = DQK * 2 + 16, KBYTES = 64 * KSTR, VSTR = 136, VBYTES = 64 * VSTR, BUF = KBYTES + VBYTES + 256, NKS = DQK / 16, CPR = DQK / 8, NCH = 64 * CPR;
    const int hi = lane >> 5, l31 = lane & 31;
    const int NT = 4 * (qt + 1);
    const int qw0 = 256 * qt + 32 * wave, tq = qw0 + l31;
    const size_t rowq = (size_t)(b * SEQ + tq);
    bf16x8 qf[NKS];
#pragma unroll
    for (int ks = 0; ks < NKS; ++ks) qf[ks] = *(const bf16x8*)(Qp + rowq * ldq + 16 * ks + 8 * hi);
    float ptq = 0.f; if (DSA) ptq = (float)pos[b * SEQ + tq];
    constexpr float THR = 4.0f;
    float mref = 0.f, lrun = 0.f; bool seen = false; f32x16 o[2], negm;
#pragma unroll
    for (int r = 0; r < 16; ++r) { o[0][r] = 0.f; o[1][r] = 0.f; negm[r] = 0.f; }
    u32x4 kA0, kA1, vA_, kB0, kB1, vB_; float pA = 0.f, pB = 0.f;
    const int c0 = tid, c1i = tid + 512;
    const int kr0_row = c0 / CPR, kr0_ch = c0 % CPR, kr1_row = c1i / CPR, kr1_ch = c1i % CPR;
    const int vd = tid >> 3, vkc = tid & 7;
#define ATT_LOAD(t, K0, K1, VR, PR) do { const size_t kb_ = (size_t)(b * SEQ + 64 * (t)); \
        K0 = *(const u32x4*)(Kp + (kb_ + kr0_row) * ldk + 8 * kr0_ch); \
        if (c1i < NCH) K1 = *(const u32x4*)(Kp + (kb_ + kr1_row) * ldk + 8 * kr1_ch); \
        VR = *(const u32x4*)(Vt + (size_t)vd * SEQ + 64 * (t) + 8 * vkc); \
        if (DSA && tid < 64) PR = (float)pos[b * SEQ + 64 * (t) + tid]; } while (0)
#define ATT_WRITE(bufi, K0, K1, VR, PR) do { LAS unsigned char* bb_ = lds + (bufi) * BUF; \
        *(LAS u32x4*)(bb_ + kr0_row * KSTR + 16 * kr0_ch) = K0; \
        if (c1i < NCH) *(LAS u32x4*)(bb_ + kr1_row * KSTR + 16 * kr1_ch) = K1; \
        *(LAS u32x2*)(bb_ + KBYTES + vd * VSTR + 16 * vkc) = (u32x2){VR.x, VR.y}; \
        *(LAS u32x2*)(bb_ + KBYTES + vd * VSTR + 16 * vkc + 8) = (u32x2){VR.z, VR.w}; \
        if (DSA && tid < 64) *(LAS float*)(bb_ + KBYTES + VBYTES + 4 * tid) = PR; } while (0)
    u32x2 bwn = (u32x2){0u, 0u}; if (DSA) bwn = *(const u32x2*)(bitmap + rowq * 64);
    ATT_LOAD(0, kA0, kA1, vA_, pA); ATT_LOAD(1, kB0, kB1, vB_, pB);
    ATT_WRITE(0, kA0, kA1, vA_, pA); __syncthreads();
    for (int t = 0; t < NT; ++t) {
        const u32x2 bw = bwn; if (DSA && t + 1 < NT) bwn = *(const u32x2*)(bitmap + rowq * 64 + 2 * (t + 1));
        if (t + 2 < NT) { if (t & 1) ATT_LOAD(t + 2, kB0, kB1, vB_, pB); else ATT_LOAD(t + 2, kA0, kA1, vA_, pA); }
        if (64 * t <= qw0 + 31) {
            const LAS unsigned char* bb = lds + (t & 1) * BUF;
            f32x16 s0 = negm, s1 = negm;
            bf16x8 kfa[NKS], kfb[NKS];
#pragma unroll
            for (int ks = 0; ks < NKS; ++ks) { kfa[ks] = *(const LAS bf16x8*)(bb + l31 * KSTR + 32 * ks + 16 * hi); kfb[ks] = *(const LAS bf16x8*)(bb + (32 + l31) * KSTR + 32 * ks + 16 * hi); }
            __builtin_amdgcn_sched_barrier(0);
#pragma unroll
            for (int ks = 0; ks < NKS; ++ks) {
                s0 = __builtin_amdgcn_mfma_f32_32x32x16_bf16(kfa[ks], qf[ks], s0, 0, 0, 0);
                s1 = __builtin_amdgcn_mfma_f32_32x32x16_bf16(kfb[ks], qf[ks], s1, 0, 0, 0);
            }
            __builtin_amdgcn_sched_barrier(0);
            const LAS unsigned char* vb = bb + KBYTES;
            u32x2 vlo[8], vhi[8];
#pragma unroll
            for (int kk = 0; kk < 2; ++kk)
#pragma unroll
                for (int s = 0; s < 2; ++s)
#pragma unroll
                    for (int db = 0; db < 2; ++db) { const LAS unsigned char* va = vb + (32 * db + l31) * VSTR + (32 * kk + 16 * s + 4 * hi) * 2;
                        vlo[(kk * 2 + s) * 2 + db] = *(const LAS u32x2*)va; vhi[(kk * 2 + s) * 2 + db] = *(const LAS u32x2*)(va + 16); }
            __builtin_amdgcn_sched_barrier(0);
            if (DSA) {
                asm volatile("s_nop 15\n\ts_nop 3" ::: "memory");
                __builtin_amdgcn_sched_barrier(0);
                const unsigned w0 = bw.x >> (4 * hi), w1 = bw.y >> (4 * hi);
                const LAS float* pp = (const LAS float*)(bb + KBYTES + VBYTES);
                const float nega = -aslope; const unsigned ninf = 0xff800000u;
#define DSA_EL(S, PK, W, BIT) do { float t_, v_; unsigned m_, r_; \
                    asm("v_sub_f32 %0, %1, %2" : "=v"(t_) : "v"(ptq), "v"(PK)); \
                    asm("v_fma_f32 %0, %1, |%2|, %3" : "=v"(v_) : "s"(nega), "v"(t_), "v"(S)); \
                    asm("v_bfe_i32 %0, %1, %2, 1" : "=v"(m_) : "v"(W), "n"(BIT)); \
                    asm("v_bfi_b32 %0, %1, %2, %3" : "=v"(r_) : "v"(m_), "v"(v_), "s"(ninf)); \
                    S = __builtin_bit_cast(float, r_); } while (0)
#pragma unroll
                for (int g = 0; g < 4; ++g) {
                    const f32x4 p0 = *(const LAS f32x4*)(pp + 8 * g + 4 * hi), p1 = *(const LAS f32x4*)(pp + 32 + 8 * g + 4 * hi);
                    DSA_EL(s0[4 * g + 0], p0[0], w0, 8 * g + 0); DSA_EL(s0[4 * g + 1], p0[1], w0, 8 * g + 1); DSA_EL(s0[4 * g + 2], p0[2], w0, 8 * g + 2); DSA_EL(s0[4 * g + 3], p0[3], w0, 8 * g + 3);
                    DSA_EL(s1[4 * g + 0], p1[0], w1, 8 * g + 0); DSA_EL(s1[4 * g + 1], p1[1], w1, 8 * g + 1); DSA_EL(s1[4 * g + 2], p1[2], w1, 8 * g + 2); DSA_EL(s1[4 * g + 3], p1[3], w1, 8 * g + 3);
                }
#undef DSA_EL
            } else {
                if (64 * t + 63 > qw0) {
#pragma unroll
                    for (int r = 0; r < 16; ++r) { const int key = 64 * t + crow(r, hi); if (key > tq) s0[r] = -INFINITY; if (key + 32 > tq) s1[r] = -INFINITY; }
                }
            }
            float mx;
            { float m0 = fmaxf(fmaxf(s0[0], s0[1]), s0[2]), m1 = fmaxf(fmaxf(s0[3], s0[4]), s0[5]), m2 = fmaxf(fmaxf(s1[0], s1[1]), s1[2]), m3 = fmaxf(fmaxf(s1[3], s1[4]), s1[5]);
              m0 = fmaxf(fmaxf(m0, s0[6]), s0[7]); m1 = fmaxf(fmaxf(m1, s0[8]), s0[9]); m2 = fmaxf(fmaxf(m2, s1[6]), s1[7]); m3 = fmaxf(fmaxf(m3, s1[8]), s1[9]);
              m0 = fmaxf(fmaxf(m0, s0[10]), s0[11]); m1 = fmaxf(fmaxf(m1, s0[12]), s0[13]); m2 = fmaxf(fmaxf(m2, s1[10]), s1[11]); m3 = fmaxf(fmaxf(m3, s1[12]), s1[13]);
              m0 = fmaxf(fmaxf(m0, s0[14]), s0[15]); m2 = fmaxf(fmaxf(m2, s1[14]), s1[15]);
              mx = fmaxf(fmaxf(m0, m1), fmaxf(m2, m3)); }
            mx = fmaxf(mx, __shfl_xor(mx, 32));
            {
                const bool fin = mx > -INFINITY, first = fin && !seen, upd = first || (mx > THR);
                if (__any(upd)) {
                    const float dl = upd ? mx : 0.f;
                    const float alpha = first ? 1.f : __builtin_amdgcn_exp2f(-dl);
                    mref += dl; lrun *= alpha;
#pragma unroll
                    for (int r = 0; r < 16; ++r) { s0[r] -= dl; s1[r] -= dl; o[0][r] *= alpha; o[1][r] *= alpha; negm[r] = -mref; }
                }
                seen = seen || fin;
            }
            float psum = 0.f;
#pragma unroll
            for (int r = 0; r < 16; ++r) { s0[r] = __builtin_amdgcn_exp2f(s0[r]); s1[r] = __builtin_amdgcn_exp2f(s1[r]); }
            { float q0 = 0.f, q1 = 0.f, q2 = 0.f, q3 = 0.f;
#pragma unroll
              for (int r = 0; r < 16; r += 4) { q0 += s0[r] + s1[r]; q1 += s0[r + 1] + s1[r + 1]; q2 += s0[r + 2] + s1[r + 2]; q3 += s0[r + 3] + s1[r + 3]; }
              psum = (q0 + q1) + (q2 + q3); }
            lrun += psum;
            unsigned pb0[8], pb1[8];
#pragma unroll
            for (int i = 0; i < 8; ++i) { pb0[i] = cvtpk(s0[2 * i], s0[2 * i + 1]); pb1[i] = cvtpk(s1[2 * i], s1[2 * i + 1]); }
            __builtin_amdgcn_sched_barrier(0);
#pragma unroll
            for (int kk = 0; kk < 2; ++kk)
#pragma unroll
                for (int s = 0; s < 2; ++s) {
                    u32x4 pf; if (kk == 0) pf = (u32x4){pb0[4 * s], pb0[4 * s + 1], pb0[4 * s + 2], pb0[4 * s + 3]}; else pf = (u32x4){pb1[4 * s], pb1[4 * s + 1], pb1[4 * s + 2], pb1[4 * s + 3]};
                    const bf16x8 pfr = __builtin_bit_cast(bf16x8, pf);
#pragma unroll
                    for (int db = 0; db < 2; ++db) { const int fi = (kk * 2 + s) * 2 + db;
                        const bf16x8 vf = __builtin_bit_cast(bf16x8, (u32x4){vlo[fi].x, vlo[fi].y, vhi[fi].x, vhi[fi].y});
                        o[db] = __builtin_amdgcn_mfma_f32_32x32x16_bf16(vf, pfr, o[db], 0, 0, 0); }
                }
        }
        if (t + 1 < NT) { if (t & 1) ATT_WRITE(0, kA0, kA1, vA_, pA); else ATT_WRITE(1, kB0, kB1, vB_, pB); }
        __syncthreads();
    }
#undef ATT_LOAD
#undef ATT_WRITE
    const float lt = lrun + __shfl_xor(lrun, 32);
    const float inv = 1.f / lt;
#pragma unroll
    for (int db = 0; db < 2; ++db)
#pragma unroll
        for (int g = 0; g < 4; ++g) { int w = 0; w = __builtin_amdgcn_cvt_pk_fp8_f32(o[db][4 * g] * inv, o[db][4 * g + 1] * inv, w, false); w = __builtin_amdgcn_cvt_pk_fp8_f32(o[db][4 * g + 2] * inv, o[db][4 * g + 3] * inv, w, true);
            *(int*)(Yp + rowq * DM + 32 * db + 8 * g + 4 * hi) = w; }
}

typedef float f32x2v __attribute__((ext_vector_type(2)));
__device__ __forceinline__ void p6_front(const Args& a, const bf16_t* mix, unsigned char* hb8, const LAS float* GT1, const LAS float* A2, const LAS float* B2, int row, int lane, f32x4 (&xv)[4]) {
    const u32x2* mr = (const u32x2*)(mix + (size_t)row * DM) + lane;
    const f32x4* xr = (const f32x4*)(a.x + (size_t)row * DM) + lane;
    f32x4 mv[4]; float ss = 0.f;
#pragma unroll
    for (int j = 0; j < 4; ++j) { const u32x2 q = __builtin_nontemporal_load(mr + 64 * j); mv[j] = (f32x4){bflo(q.x), bfhi(q.x), bflo(q.y), bfhi(q.y)}; xv[j] = __builtin_nontemporal_load(xr + 64 * j);
        ss += (mv[j][0] * mv[j][0] + mv[j][1] * mv[j][1]) + (mv[j][2] * mv[j][2] + mv[j][3] * mv[j][3]); }
    const float rstd1 = rsqrtf(wave_sum(ss) * (1.f / DM) + EPS);
    float ss2 = 0.f;
    f32x4* orow = (f32x4*)(a.out + (size_t)row * DM) + lane;
#pragma unroll
    for (int j = 0; j < 4; ++j) { const f32x4 g1 = *(const LAS f32x4*)(GT1 + 4 * lane + 256 * j);
        xv[j] = xv[j] + g1 * (mv[j] * rstd1); orow[64 * j] = xv[j];
        ss2 += (xv[j][0] * xv[j][0] + xv[j][1] * xv[j][1]) + (xv[j][2] * xv[j][2] + xv[j][3] * xv[j][3]); }
    const float rstd2 = rsqrtf(wave_sum(ss2) * (1.f / DM) + EPS);
    int* o4 = (int*)(hb8 + (size_t)row * DM) + lane;
#pragma unroll
    for (int j = 0; j < 4; ++j) { const f32x4 am = *(const LAS f32x4*)(A2 + 4 * lane + 256 * j), bd = *(const LAS f32x4*)(B2 + 4 * lane + 256 * j);
        xv[j] = xv[j] * rstd2 * am + bd;
        int w = 0; w = __builtin_amdgcn_cvt_pk_fp8_f32(xv[j][0], xv[j][1], w, false); w = __builtin_amdgcn_cvt_pk_fp8_f32(xv[j][2], xv[j][3], w, true);
        o4[64 * j] = w; }
}
__device__ __forceinline__ void p6_route(const Args& a, float (&pe)[32], LAS int* lcnt, LAS int* info, int r, int lane) {
    { const bool b5 = (lane & 32) != 0, b4 = (lane & 16) != 0, b3 = (lane & 8) != 0, b2 = (lane & 4) != 0, b1 = (lane & 2) != 0;
#pragma unroll
      for (int i = 0; i < 16; ++i) { const float keep = b5 ? pe[16 + i] : pe[i], send = b5 ? pe[i] : pe[16 + i]; pe[i] = keep + __shfl_xor(send, 32); }
#pragma unroll
      for (int i = 0; i < 8; ++i) { const float keep = b4 ? pe[8 + i] : pe[i], send = b4 ? pe[i] : pe[8 + i]; pe[i] = keep + __shfl_xor(send, 16); }
#pragma unroll
      for (int i = 0; i < 4; ++i) { const float keep = b3 ? pe[4 + i] : pe[i], send = b3 ? pe[i] : pe[4 + i]; pe[i] = keep + __shfl_xor(send, 8); }
#pragma unroll
      for (int i = 0; i < 2; ++i) { const float keep = b2 ? pe[2 + i] : pe[i], send = b2 ? pe[i] : pe[2 + i]; pe[i] = keep + __shfl_xor(send, 4); }
      { const float keep = b1 ? pe[1] : pe[0], send = b1 ? pe[0] : pe[1]; pe[0] = keep + __shfl_xor(send, 2); }
      pe[0] += __shfl_xor(pe[0], 1); }
    const int myexp = lane >> 1;
    const float mylg = pe[0] + a.b_router[myexp];
    int rank = 0;
#pragma unroll
    for (int j = 0; j < 32; ++j) { const float vj = __builtin_bit_cast(float, __builtin_amdgcn_readlane(__builtin_bit_cast(int, mylg), 2 * j));
        rank += (vj > mylg || (vj == mylg && j < myexp)) ? 1 : 0; }
    float tv[4]; int ti[4];
#pragma unroll
    for (int p = 0; p < 4; ++p) { const unsigned long long bm = __ballot(rank == p && !(lane & 1)); const int bi = __builtin_ctzll(bm);
        ti[p] = bi >> 1; tv[p] = __builtin_bit_cast(float, __builtin_amdgcn_readlane(__builtin_bit_cast(int, mylg), bi)); }
    float ex[4], es = 0.f;
#pragma unroll
    for (int p = 0; p < 4; ++p) { ex[p] = __expf(tv[p] - tv[0]); es += ex[p]; }
    if (lane < 4) {
        const int e = lane == 0 ? ti[0] : lane == 1 ? ti[1] : lane == 2 ? ti[2] : ti[3];
        const float g = (lane == 0 ? ex[0] : lane == 1 ? ex[1] : lane == 2 ? ex[2] : ex[3]) / es;
        const int lr = __hip_atomic_fetch_add(&lcnt[e], 1, __ATOMIC_RELAXED, __HIP_MEMORY_SCOPE_WORKGROUP);
        info[(r * 4 + lane) * 3 + 0] = e; info[(r * 4 + lane) * 3 + 1] = lr; info[(r * 4 + lane) * 3 + 2] = __builtin_bit_cast(int, g);
    }
}

__device__ __forceinline__ void p6_rows(const Args& a, LAS unsigned char* lds, int tid, int wave, int lane) {
    constexpr int WTS = 1028;
    LAS float* WT = (LAS float*)lds;
    LAS float* GT1 = WT + 32 * WTS; LAS float* A2 = GT1 + DM; LAS float* B2 = A2 + DM;
    LAS int* lcnt = (LAS int*)(B2 + DM); LAS int* lbase = lcnt + 32; LAS int* info = lbase + 32;
    unsigned char* ws = a.ws;
    const bf16_t* mix = (const bf16_t*)(ws + WS_MIX); unsigned char* hb8 = ws + WS_HB;
    int* cnt = (int*)(ws + WS_CTL) + CW_CNT; int* list = (int*)(ws + WS_LIST);
    int* route_e = (int*)(ws + WS_ROUTE); int* route_pos = route_e + MT * 4; float* gate = (float*)(route_pos + MT * 4);
    for (int i = tid; i < DM * NE; i += 512) WT[(i & 31) * WTS + (i >> 5)] = a.w_router[i];
    if (tid < 32) lcnt[tid] = 0;
    for (int blk = blockIdx.x; blk < MT / 64; blk += gridDim.x) {
        const int b = blk / 32;
        __syncthreads();
        for (int j = tid; j < DM; j += 512) { GT1[j] = mod_at(a, b, 2048 + j) * a.g_post_mix[j]; A2[j] = a.g_pre_ffn[j] * (1.f + mod_at(a, b, 4096 + j)); B2[j] = mod_at(a, b, 3072 + j); }
        __syncthreads();
#pragma unroll 1
        for (int it = 0; it < 4; ++it) {
            const int rA = wave + 16 * it, rB = rA + 8;
            const int ln = fresh_lane();
            f32x4 xa[4], xb[4];
            p6_front(a, mix, hb8, GT1, A2, B2, blk * 64 + rA, ln, xa);
            p6_front(a, mix, hb8, GT1, A2, B2, blk * 64 + rB, ln, xb);
            float pa[32], pb[32];
#pragma unroll
            for (int e = 0; e < 32; ++e) { f32x2v accA = (f32x2v){0.f, 0.f}, accB = (f32x2v){0.f, 0.f};
#pragma unroll
                for (int j = 0; j < 4; ++j) { const f32x4 wv = *(const LAS f32x4*)(WT + e * WTS + 4 * ln + 256 * j);
                    const f32x2v w01 = (f32x2v){wv[0], wv[1]}, w23 = (f32x2v){wv[2], wv[3]};
                    accA = __builtin_elementwise_fma((f32x2v){xa[j][0], xa[j][1]}, w01, accA); accA = __builtin_elementwise_fma((f32x2v){xa[j][2], xa[j][3]}, w23, accA);
                    accB = __builtin_elementwise_fma((f32x2v){xb[j][0], xb[j][1]}, w01, accB); accB = __builtin_elementwise_fma((f32x2v){xb[j][2], xb[j][3]}, w23, accB); }
                pa[e] = accA.x + accA.y; pb[e] = accB.x + accB.y; if ((e & 3) == 3) __builtin_amdgcn_sched_barrier(0); }
#pragma unroll 1
            for (int rr = 0; rr < 2; ++rr) {
                const int ln2 = fresh_lane();
                p6_route(a, pa, lcnt, info, rr ? rB : rA, ln2);
#pragma unroll
                for (int e = 0; e < 32; ++e) pa[e] = pb[e];
            }
        }
        __syncthreads();
        if (tid < 32) lbase[tid] = atomicAdd(cnt + CNT_STRIDE * tid, lcnt[tid]);
        __syncthreads();
        if (tid < 256) { const int e = info[tid * 3 + 0], p = lbase[e] + info[tid * 3 + 1]; const int row = blk * 64 + (tid >> 2);
            list[e * MT + p] = row; route_e[row * 4 + (tid & 3)] = e; route_pos[row * 4 + (tid & 3)] = p; gate[row * 4 + (tid & 3)] = __builtin_bit_cast(float, info[tid * 3 + 2]); }
        __syncthreads();
        if (tid < 32) lcnt[tid] = 0;
    }
}

__device__ __forceinline__ void p9_rows(const Args& a, LAS unsigned char* lds, const LAS int* ts, int tid, int wave, int lane) {
    LAS float* GT2 = (LAS float*)lds;
    unsigned char* ws = a.ws;
    const bf16_t* yb = (const bf16_t*)(ws + WS_YB);
    const int* route_e = (const int*)(ws + WS_ROUTE); const int* route_pos = route_e + MT * 4; const float* gate = (const float*)(route_pos + MT * 4);
    for (int blk = blockIdx.x; blk < MT / 64; blk += gridDim.x) {
        const int b = blk / 32;
        __syncthreads();
        for (int j = tid; j < DM; j += 512) GT2[j] = mod_at(a, b, 5120 + j) * a.g_post_ffn[j];
        __syncthreads();
#pragma unroll 1
        for (int r0 = wave; r0 < 64; r0 += 16) {
            i32x4 re[2], rp[2]; f32x4 gg[2];
#pragma unroll
            for (int q = 0; q < 2; ++q) { const int row = blk * 64 + r0 + 8 * q; re[q] = *(const i32x4*)(route_e + row * 4); rp[q] = *(const i32x4*)(route_pos + row * 4); gg[q] = *(const f32x4*)(gate + row * 4); }
            u32x2 yv[2][4][4]; f32x4 xo[2][4];
#pragma unroll
            for (int q = 0; q < 2; ++q) { const int row = blk * 64 + r0 + 8 * q;
#pragma unroll
                for (int k = 0; k < 4; ++k) { const int slot = ts[re[q][k]] * 256 + rp[q][k]; const u32x2* yr = (const u32x2*)(yb + (size_t)slot * FE) + lane;
#pragma unroll
                    for (int j = 0; j < 4; ++j) yv[q][k][j] = __builtin_nontemporal_load(yr + 64 * j); }
                const f32x4* orow = (const f32x4*)(a.out + (size_t)row * DM) + lane;
#pragma unroll
                for (int j = 0; j < 4; ++j) xo[q][j] = __builtin_nontemporal_load(orow + 64 * j); }
#pragma unroll
            for (int q = 0; q < 2; ++q) { const int row = blk * 64 + r0 + 8 * q;
                f32x4 f[4];
#pragma unroll
                for (int j = 0; j < 4; ++j) f[j] = (f32x4){0.f, 0.f, 0.f, 0.f};
#pragma unroll
                for (int k = 0; k < 4; ++k) { const float g = gg[q][k];
#pragma unroll
                    for (int j = 0; j < 4; ++j) { const u32x2 w = yv[q][k][j]; f[j] += (f32x4){bflo(w.x), bfhi(w.x), bflo(w.y), bfhi(w.y)} * g; } }
                float ss = 0.f;
#pragma unroll
                for (int j = 0; j < 4; ++j) ss += (f[j][0] * f[j][0] + f[j][1] * f[j][1]) + (f[j][2] * f[j][2] + f[j][3] * f[j][3]);
                const float rstd = rsqrtf(wave_sum(ss) * (1.f / DM) + EPS);
                f32x4* orow = (f32x4*)(a.out + (size_t)row * DM) + lane;
#pragma unroll
                for (int j = 0; j < 4; ++j) { const f32x4 g2 = *(const LAS f32x4*)(GT2 + 4 * lane + 256 * j); __builtin_nontemporal_store(xo[q][j] + g2 * (f[j] * rstd), orow + 64 * j); }
            }
        }
    }
}

#define XB_TMO      128
#define XB_XCNT(j)  (256  + 64 * (j))
#define XB_XSUB(j)  (1280 + 64 * (j))
#define XB_XGEN(j)  (2304 + 64 * (j))
#define XB_TOP      3328
#define XB_TOPGEN   3392
#define XCD_BAR_WORDS 3456
#define XB_SPIN_CAP (1u << 22)
__device__ __forceinline__ unsigned xb_ld(unsigned* p)              { return __hip_atomic_load(p, __ATOMIC_RELAXED, __HIP_MEMORY_SCOPE_AGENT); }
__device__ __forceinline__ unsigned xb_add(unsigned* p, unsigned v) { return __hip_atomic_fetch_add(p, v, __ATOMIC_RELAXED, __HIP_MEMORY_SCOPE_AGENT); }
__device__ __forceinline__ unsigned xb_xcc_id() { return (unsigned)__builtin_amdgcn_s_getreg((3 << 11) | 20) & 0xFu; }
#define XB_SPIN(cond, bar) do { unsigned _sp = 0; while (cond) { __builtin_amdgcn_s_sleep(1); \
    if ((++_sp & 255u) == 0u) { if (xb_ld(&(bar)[XB_TMO])) break; if (_sp > XB_SPIN_CAP) { atomicAdd(&(bar)[XB_TMO], 1u); break; } } } } while (0)
struct XcdBarrier { unsigned* bar; unsigned x; volatile LAS unsigned* st; };
__device__ __forceinline__ void xcd_barrier_complete(unsigned* bar, unsigned x, unsigned& nloc, unsigned& nx) {
    const unsigned G = gridDim.x;
    unsigned sum, cnt, mine, sp = 0u;
    for (;;) {
        sum = 0u; cnt = 0u; mine = 0u;
#pragma unroll
        for (unsigned j = 0; j < 16; ++j) { const unsigned c = xb_ld(&bar[XB_XCNT(j)]); sum += c; cnt += (c > 0u) ? 1u : 0u; mine = (j == x) ? c : mine; }
        if (sum == G) break;
        __builtin_amdgcn_s_sleep(1);
        if ((++sp & 255u) == 0u) { if (xb_ld(&bar[XB_TMO])) break; if (sp > XB_SPIN_CAP) { atomicAdd(&bar[XB_TMO], 1u); break; } }
    }
    nloc = mine > 0u ? mine : 1u; nx = cnt > 0u ? cnt : 1u;
}
__device__ __forceinline__ void xcd_barrier(const XcdBarrier& b, bool leader_thread) {
    asm volatile("s_waitcnt vmcnt(0)" ::: "memory");
    __syncthreads();
    if (leader_thread) {
        unsigned* bar = b.bar;
        __builtin_amdgcn_s_waitcnt(0);
        unsigned nloc = b.st[0], nx = b.st[1];
        if (nloc == 0u) { xcd_barrier_complete(bar, b.x, nloc, nx); b.st[0] = nloc; b.st[1] = nx; }
        const unsigned old = xb_add(&bar[XB_XSUB(b.x)], 1u);
        const unsigned gen = old / nloc;
        if (old + 1u == (gen + 1u) * nloc) {
            __builtin_amdgcn_fence(__ATOMIC_RELEASE, "agent");
            asm volatile("s_waitcnt vmcnt(0)" ::: "memory");
            const unsigned og = xb_add(&bar[XB_TOP], 1u);
            const unsigned tg = og / nx;
            if (og + 1u == (tg + 1u) * nx) xb_add(&bar[XB_TOPGEN], 1u);
            else XB_SPIN(xb_ld(&bar[XB_TOPGEN]) == tg, bar);
            __builtin_amdgcn_fence(__ATOMIC_ACQUIRE, "agent");
            xb_add(&bar[XB_XGEN(b.x)], 1u);
            asm volatile("s_waitcnt vmcnt(0)" ::: "memory");
        } else {
            XB_SPIN(xb_ld(&bar[XB_XGEN(b.x)]) == gen, bar);
            __builtin_amdgcn_fence(__ATOMIC_ACQUIRE, "agent");
            asm volatile("s_waitcnt vmcnt(0)" ::: "memory");
        }
    }
    __syncthreads();
}

constexpr int N_PHASES = 10;
constexpr int CONV_EARLY = 5376;
__global__ void __launch_bounds__(512, 2) mk_fwd(Args a) {
    extern __shared__ __attribute__((aligned(16))) unsigned char lds_raw[];
    LAS unsigned char* lds = (LAS unsigned char*)lds_raw;
    const int wave = __builtin_amdgcn_readfirstlane(threadIdx.x >> 6);
    int lane, tid;
#define FRESH() do { lane = fresh_lane(); tid = wave * 64 + lane; } while (0)
    unsigned char* ws = a.ws;
    LAS int* ts = (LAS int*)(lds + LDS_CTRL);
    LAS int* cnts = ts + 40;
    const int lo = a.ph_lo, hi = a.ph_hi;
#ifndef PHASE_MASK
#define PHASE_MASK 0xFFFF
#endif
#define IN(k) (((PHASE_MASK >> (k)) & 1) && lo <= (k) && (k) < hi)
#define SEAM(k) do { if (IN(k) && IN((k) + 1)) { FRESH(); xcd_barrier(xb, tid == 0); } } while (0)
    XcdBarrier xb; xb.bar = (unsigned*)(ws + WS_CTL) + CW_BAR; xb.x = xb_xcc_id(); xb.st = (volatile LAS unsigned*)(lds + LDS_CTRL + 320);
    if (hi - lo > 1) {
        if (threadIdx.x == 0) { xb.st[0] = 0u; xb.st[1] = 0u; (void)xb_add(&xb.bar[XB_XCNT(xb.x)], 1u); }
        __syncthreads();
    }

    if (IN(0)) { FRESH(); p0_prologue(a, lds, tid, wave, lane); }
    SEAM(0);
    if (IN(1)) { FRESH(); p1_rows(a, lds, tid, wave, lane); }
    SEAM(1);
    if (IN(2)) {
        pg8::StaticOrder S; S.init(MT, NPROJ, gridDim.x, blockIdx.x, ws + WS_WIN, 2048);
        float* rcos = (float*)(ws + WS_ROPE);
        pg8::EpiInProj E{(bf16_t*)(ws + WS_PROJ), (float*)(ws + WS_SSQ), (float*)(ws + WS_SSQ) + MT * 4, (bf16_t*)(ws + WS_KM), (bf16_t*)(ws + WS_VTD), rcos, rcos + (size_t)MT * 16};
        __syncthreads();
        pg8::gemm_phase<pg8::EpiInProj, pg8::StaticOrder, true>(lds, ws + WS_HB, 2048, 2048, S, E, wave);
        if (gridDim.x == 256 && blockIdx.x >= 128) { __syncthreads(); FRESH(); moe_weights_phase(a, lds, wave, lane, 0, CONV_EARLY, (blockIdx.x - 128) * 8 + wave, 128 * 8); }
        else if (gridDim.x != 256 && blockIdx.x == 0) { __syncthreads(); FRESH(); moe_weights_phase(a, lds, wave, lane, 0, CONV_EARLY, wave, 8); }
    }
    SEAM(2);
    if (IN(3)) {
        float* rcos = (float*)(ws + WS_ROPE);
        __syncthreads();
#ifndef SUB3
#define SUB3 7
#endif
        if (SUB3 & 1) { pg8::StaticOrder S; S.init(MT, 768, gridDim.x, blockIdx.x, ws + WS_WQB, 512);
          pg8::EpiQb E{(bf16_t*)(ws + WS_QM), (const float*)(ws + WS_SSQ), rcos, rcos + (size_t)MT * 16, 0.10206207261596575f * LOG2E};
          pg8::gemm_phase<pg8::EpiQb, pg8::StaticOrder, true>(lds, (const bf16_t*)(ws + WS_PROJ) + PC_CQ, NPROJ * 2, 512, S, E, wave); }
        __syncthreads();
        if (SUB3 & 2) { pg8::StaticOrder S; S.init(MT, 1024, gridDim.x, blockIdx.x, ws + WS_WKVB, 512);
          pg8::EpiKvb E{(bf16_t*)(ws + WS_KM), (bf16_t*)(ws + WS_VTM), (const float*)(ws + WS_SSQ) + MT * 4};
          pg8::gemm_phase<pg8::EpiKvb, pg8::StaticOrder, true>(lds, (const bf16_t*)(ws + WS_PROJ) + PC_CKV, NPROJ * 2, 512, S, E, wave); }
        __syncthreads();
        FRESH();
        if (SUB3 & 4) for (int v = blockIdx.x; v < 256; v += gridDim.x) {
            const int b = v & 7, aa = v >> 3;
#pragma unroll 1
            for (int i = 0; i < 4; ++i) { const int tg = (i & 1) ? (32 * i + 31 - aa) : (32 * i + aa);
                idx_item(lds, (const bf16_t*)(ws + WS_PROJ), (unsigned*)(ws + WS_BITMAP), b, tg, wave, lane); }
        }
    }
    SEAM(3);
    if (IN(4)) {
        __syncthreads(); FRESH();
        for (int v0_ = blockIdx.x; v0_ < 256; v0_ += gridDim.x) {
            const int v = (gridDim.x == 256) ? ((v0_ & 7) * 32 + (v0_ >> 3)) : v0_;
            const int bh = v >> 2, b = bh >> 3, h = bh & 7, s = v & 3;
#pragma unroll 1
            for (int i = 0; i < 2; ++i) { const int qt = i ? 7 - s : s; FRESH();
                attn_unit<96, false>(lds, b, qt, (const bf16_t*)(ws + WS_QM) + h * 96, 768, (const bf16_t*)(ws + WS_KM) + h * 96, 768,
                                     (const bf16_t*)(ws + WS_VTM) + (size_t)(b * 8 + h) * 64 * SEQ, (unsigned char*)(ws + WS_Y) + h * 64, nullptr, nullptr, 0.f, 0.f, tid, wave, lane); }
#pragma unroll 1
            for (int i = 0; i < 2; ++i) { const int qt = i ? 7 - s : s; const int kvh = h >> 2; FRESH();
                attn_unit<64, true>(lds, b, qt, (const bf16_t*)(ws + WS_PROJ) + PC_QD + h * 64, NPROJ, (const bf16_t*)(ws + WS_PROJ) + PC_KD + kvh * 64, NPROJ,
                                    (const bf16_t*)(ws + WS_VTD) + (size_t)(b * 2 + kvh) * 64 * SEQ, (unsigned char*)(ws + WS_Y) + 512 + h * 64, (const unsigned*)(ws + WS_BITMAP), a.pos,
                                    0.125f * LOG2E, exp2f(-(float)(h + 1)) * LOG2E, tid, wave, lane); }
        }
    }
    SEAM(4);
    if (IN(5)) {
        pg8::StaticOrder S; S.init(MT, DM, gridDim.x, blockIdx.x, ws + WS_WO, 1024);
        pg8::EpiPlain E{(bf16_t*)(ws + WS_MIX), DM, 1.f / 64.f};
        __syncthreads();
        pg8::gemm_phase<pg8::EpiPlain, pg8::StaticOrder, true, true>(lds, ws + WS_Y, 1024, 1024, S, E, wave);
    }
    SEAM(5);
    if (IN(6)) { __syncthreads(); FRESH(); p6_rows(a, lds, tid, wave, lane); __syncthreads(); FRESH(); moe_weights_phase(a, lds, wave, lane, CONV_EARLY, 32 * 16 * 96, blockIdx.x * 8 + wave, gridDim.x * 8); }
    SEAM(6);
    if (IN(7) || IN(8) || IN(9)) {
        __syncthreads(); FRESH();
        if (tid == 0) { const int* cnt = (const int*)(ws + WS_CTL) + CW_CNT; int acc = 0;
            for (int e = 0; e < 32; ++e) { const int c = cnt[CNT_STRIDE * e]; ts[e] = acc; cnts[e] = c; acc += (c + 255) >> 8; }
            ts[32] = acc; }
        __syncthreads();
    }
    if (IN(7)) {
        pg8::MoeOrder<true> S; S.init(ts, cnts, (const int*)(ws + WS_LIST), ws + WS_W1T, 2048, 1024, 8, gridDim.x, blockIdx.x);
        pg8::EpiMoe1 E{ws + WS_ACT, a.b_mlp1};
        pg8::gemm_phase<pg8::EpiMoe1, pg8::MoeOrder<true>, true, true>(lds, ws + WS_HB, 1024, 1024, S, E, wave);
    }
    SEAM(7);
    if (IN(8)) {
        pg8::MoeOrder<false> S; S.init(ts, cnts, (const int*)(ws + WS_LIST), ws + WS_W2T, 1024, 1024, 4, gridDim.x, blockIdx.x);
        pg8::EpiMoe2 E{(bf16_t*)(ws + WS_YB), a.b_mlp2};
        __syncthreads();
        pg8::gemm_phase<pg8::EpiMoe2, pg8::MoeOrder<false>, true, true>(lds, ws + WS_ACT, 1024, 1024, S, E, wave);
    }
    SEAM(8);
    if (IN(9)) { __syncthreads(); FRESH(); p9_rows(a, lds, ts, tid, wave, lane); }
#undef IN
#undef SEAM
}

extern "C" void kernel_launch(void* const* d_in, const int* in_sizes, int n_in, void* d_out, int out_size, void* d_ws, size_t ws_size, hipStream_t stream) {
    static int grid = 0;
    if (grid == 0) {
        if (n_in != 21 || out_size != MT * DM || ws_size < WS_END) { fprintf(stderr, "kernel_launch: unexpected shapes (n_in %d out %d ws %zu)\n", n_in, out_size, ws_size); grid = -1; return; }
        int dev = 0, cus = 0, per_cu = 0;
        hipGetDevice(&dev); hipDeviceGetAttribute(&cus, hipDeviceAttributeMultiprocessorCount, dev);
        if (hipFuncSetAttribute((const void*)mk_fwd, hipFuncAttributeMaxDynamicSharedMemorySize, LDS_BYTES) != hipSuccess) { fprintf(stderr, "kernel_launch: hipFuncSetAttribute failed\n"); grid = -1; return; }
        if (hipOccupancyMaxActiveBlocksPerMultiprocessor(&per_cu, (const void*)mk_fwd, 512, LDS_BYTES) != hipSuccess || per_cu < 1) { fprintf(stderr, "kernel_launch: occupancy query says %d\n", per_cu); per_cu = 1; }
        (void)hipGetLastError();
        grid = cus;
    }
    if (grid < 0) return;
    hipMemsetAsync((char*)d_ws + WS_CTL, 0, CTL_BYTES, stream);
    Args a{};
    a.x = (const float*)d_in[0]; a.c = (const float*)d_in[1]; a.pos = (const int*)d_in[2]; a.w_ada = (const float*)d_in[3]; a.b_ada = (const float*)d_in[4];
    a.g_pre_mix = (const float*)d_in[5]; a.g_post_mix = (const float*)d_in[6]; a.g_pre_ffn = (const float*)d_in[7]; a.g_post_ffn = (const float*)d_in[8];
    a.w_in = (const float*)d_in[9]; a.g_q_a = (const float*)d_in[10]; a.g_kv_a = (const float*)d_in[11]; a.w_q_b = (const float*)d_in[12]; a.w_kv_b = (const float*)d_in[13]; a.w_o = (const float*)d_in[14];
    a.w_router = (const float*)d_in[15]; a.b_router = (const float*)d_in[16]; a.w_mlp1 = (const float*)d_in[17]; a.b_mlp1 = (const float*)d_in[18]; a.w_mlp2 = (const float*)d_in[19]; a.b_mlp2 = (const float*)d_in[20];
    a.out = (float*)d_out; a.ws = (unsigned char*)d_ws;
#if MK_N_LAUNCHES == 1
    a.ph_lo = 0; a.ph_hi = N_PHASES;
    hipLaunchKernelGGL(mk_fwd, dim3(grid), dim3(512), LDS_BYTES, stream, a);
#else
    for (int p = 0; p < N_PHASES; ++p) { a.ph_lo = p; a.ph_hi = p + 1; hipLaunchKernelGGL(mk_fwd, dim3(grid), dim3(512), LDS_BYTES, stream, a); }
#endif
}
```

```cpp
#include <hip/hip_runtime.h>
#include <cstdio>
#include <cstdint>

#ifndef MK_N_LAUNCHES
#define MK_N_LAUNCHES 1
#endif

#define LAS __attribute__((address_space(3)))
typedef unsigned short bf16_t;
typedef short bf16x8 __attribute__((ext_vector_type(8)));
typedef float f32x4 __attribute__((ext_vector_type(4)));
typedef float f32x16 __attribute__((ext_vector_type(16)));
typedef unsigned u32x4 __attribute__((ext_vector_type(4)));
typedef unsigned u32x2 __attribute__((ext_vector_type(2)));
typedef int i32x4 __attribute__((ext_vector_type(4)));
typedef int i32x8 __attribute__((ext_vector_type(8)));

constexpr int NB = 8, SEQ = 2048, DM = 1024, MT = NB * SEQ;
constexpr int NE = 32, FE = 1024;
constexpr int NPROJ = 1536;
constexpr int PC_CQ = 0, PC_CKV = 256, PC_KROPE = 384, PC_KIDX = 416, PC_WIDX = 448, PC_QD = 512, PC_KD = 1024, PC_VD = 1152, PC_QIDX = 1280;
constexpr float EPS = 1e-6f;
constexpr float LOG2E = 1.4426950408889634f;
constexpr int MAXTILES = 288;
constexpr int NSLOT = MAXTILES * 256;

constexpr size_t MiB = 1u << 20;
constexpr size_t WS_CTL = 0, CTL_BYTES = 64 * 1024;
constexpr size_t WS_MODP = 1 * MiB;
constexpr size_t WS_ROPE = 3 * MiB;
constexpr size_t WS_SSQ = 5 * MiB;
constexpr size_t WS_ROUTE = 6 * MiB;
constexpr size_t WS_LIST = 7 * MiB;
constexpr size_t WS_WIN = 9 * MiB;
constexpr size_t WS_WQB = 12 * MiB;
constexpr size_t WS_WKVB = 13 * MiB;
constexpr size_t WS_WO = 14 * MiB;
constexpr size_t WS_BITMAP = 16 * MiB;
constexpr size_t WS_VTM = 20 * MiB;
constexpr size_t WS_VTD = 36 * MiB;
constexpr size_t WS_HB = 40 * MiB;
constexpr size_t WS_PROJ = 72 * MiB;
constexpr size_t WS_QM = 120 * MiB;
constexpr size_t WS_KM = 144 * MiB;
constexpr size_t WS_Y = 168 * MiB;
constexpr size_t WS_MIX = 200 * MiB;
constexpr size_t WS_W1T = 232 * MiB;
constexpr size_t WS_W2T = 360 * MiB;
constexpr size_t WS_ACT = 424 * MiB;
constexpr size_t WS_YB = 568 * MiB;
constexpr size_t WS_END = 712 * MiB;
constexpr int CW_CNT = 64, CNT_STRIDE = 64;
constexpr int CW_BAR = 8192;

constexpr int LDS_BYTES = 163840;
constexpr int LDS_CTRL = 163328;

__device__ __forceinline__ unsigned f2bf(float f) { unsigned u = __builtin_bit_cast(unsigned, f); return (u + 0x7fffu + ((u >> 16) & 1u)) >> 16; }
__device__ __forceinline__ unsigned pk2(float lo, float hi) { return f2bf(lo) | (f2bf(hi) << 16); }
__device__ __forceinline__ float bflo(unsigned u) { return __builtin_bit_cast(float, u << 16); }
__device__ __forceinline__ float bfhi(unsigned u) { return __builtin_bit_cast(float, u & 0xffff0000u); }
__device__ __forceinline__ float wave_sum(float v) {
#pragma unroll
    for (int o = 1; o < 64; o <<= 1) v += __shfl_xor(v, o);
    return v;
}
#define LDS_WAIT() asm volatile("s_waitcnt lgkmcnt(0)" ::: "memory")
__device__ __forceinline__ int fresh_lane() { int l = __builtin_amdgcn_mbcnt_hi(~0u, __builtin_amdgcn_mbcnt_lo(~0u, 0u)); asm volatile("" : "+v"(l)); return l; }

namespace pg8 {
constexpr int BM = 256, BK = 64, HALF = 128, HTB = HALF * BK * 2, STAGE_BYTES = 8 * HTB, NXCD = 8, WGM = 8;
__host__ __device__ __forceinline__ int lds_byte(int r, int c) { const int st = (r >> 4) * 2 + (c >> 5), rr = r & 15, cc = c & 31, ob = rr * 64 + cc * 2; return st * 1024 + (ob ^ (((ob >> 9) & 1) << 5)); }
__host__ __device__ __forceinline__ void stage_rc(int b, int& R, int& C) { const int st = b / 1024, sb = b % 1024, swz = sb ^ (((sb >> 9) & 1) << 5); R = (st >> 1) * 16 + swz / 64; C = (st & 1) * 32 + (swz % 64) / 2; }
__host__ __device__ __forceinline__ int perm32(int rho) { const int n = rho >> 4, i = rho & 15; return 8 * (i >> 2) + 4 * n + (i & 3); }

struct Unit { int pm, pn, e, mt; };

struct StaticOrder {
    static constexpr bool GATHER = false;
    int nM, nN, nwg, G, c; const char* Bt; int ldb;
    __device__ void init(int M, int N, int G_, int c_, const void* Bt_, int ldb_bytes) { nM = M / BM; nN = N / BM; nwg = nM * nN; G = G_; c = c_; Bt = (const char*)Bt_; ldb = ldb_bytes; }
    __device__ bool next(int i, Unit& u, int ehint = 0) const {
        const long L = (long)i * G + c; if (L >= nwg) return false;
        int wgid = (int)L; { const int q = nwg / NXCD, r = nwg % NXCD, xcd = wgid % NXCD, off = wgid / NXCD; wgid = (xcd < r ? xcd * (q + 1) : r * (q + 1) + (xcd - r) * q) + off; }
        const int nig = WGM * nN, gid = wgid / nig, fm = gid * WGM, gsz = (nM - fm) < WGM ? (nM - fm) : WGM;
        u.pm = fm + ((wgid % nig) % gsz); u.pn = (wgid % nig) / gsz; u.e = 0; u.mt = 0; return true;
    }
    __device__ __forceinline__ const char* bptr(const Unit& u) const { return Bt + (size_t)u.pn * BM * ldb; }
    __device__ __forceinline__ int arow(const Unit& u, int r) const { return u.pm * BM + r; }
};

template <bool GATHER_> struct MoeOrder {
    static constexpr bool GATHER = GATHER_;
    const LAS int* ts;
    const LAS int* cnts;
    const int* list;
    const char* Bt; int nrows_b  , ldb  , nN, G, c, nwg;
    __device__ void init(const LAS int* ts_, const LAS int* cnts_, const int* list_, const void* Bt_, int nrows_b_, int ldb_, int nN_, int G_, int c_) {
        ts = ts_; cnts = cnts_; list = list_; Bt = (const char*)Bt_; nrows_b = nrows_b_; ldb = ldb_; nN = nN_; G = G_; c = c_; nwg = __builtin_amdgcn_readfirstlane(ts_[32]) * nN_; }
    __device__ bool next(int i, Unit& u, int ehint = 0) const {
        const long L = (long)i * G + c; if (L >= nwg) return false;
        int wgid = (int)L; { const int q = nwg / NXCD, r = nwg % NXCD, xcd = wgid % NXCD, off = wgid / NXCD; wgid = (xcd < r ? xcd * (q + 1) : r * (q + 1) + (xcd - r) * q) + off; }
        int e = ehint;
        while (e < 31 && __builtin_amdgcn_readfirstlane(ts[e + 1]) * nN <= wgid) ++e;
        const int t0 = __builtin_amdgcn_readfirstlane(ts[e]), T = __builtin_amdgcn_readfirstlane(ts[e + 1]) - t0, local = wgid - t0 * nN;
        u.e = e; u.pn = local / T; u.mt = local % T; u.pm = t0 + u.mt; return true;
    }
    __device__ __forceinline__ const char* bptr(const Unit& u) const { return Bt + ((size_t)u.e * nrows_b + (size_t)u.pn * BM) * ldb; }
    __device__ __forceinline__ int arow(const Unit& u, int r) const {
        if (!GATHER) return u.pm * BM + r;
        const int p = u.mt * BM + r; return (p < cnts[u.e]) ? list[u.e * MT + p] : 0;
    }
};

__device__ __forceinline__ unsigned cvt_pk_bf16(float lo, float hi) { unsigned r; asm volatile("v_cvt_pk_bf16_f32 %0, %1, %2" : "=v"(r) : "v"(lo), "v"(hi)); return r; }
__device__ __forceinline__ u32x4 pack8(const f32x4& a, const f32x4& b) { u32x4 w; w.x = cvt_pk_bf16(a[0], a[1]); w.y = cvt_pk_bf16(a[2], a[3]); w.z = cvt_pk_bf16(b[0], b[1]); w.w = cvt_pk_bf16(b[2], b[3]); return w; }

template <class Epi, class Sched, bool ALIGN_EPI, bool FP8 = false>
__device__ __forceinline__ void gemm_phase(LAS unsigned char* lds, const void* A, int lda, int kbytes, const Sched& S, const Epi& E, int wid) {
    const int lane = fresh_lane(), tid = wid * 64 + lane, wr = wid >> 2, wc = wid & 3, fr = lane & 15, fq = lane >> 4;
    const int nt = kbytes / 128; const int ldb = S.ldb;
    constexpr bool GA = Sched::GATHER;
    unsigned voffB[2], voffA[2]; int RA[2]; unsigned CA[2];
#pragma unroll
    for (int i = 0; i < 2; ++i) { int R, C; stage_rc(tid * 16 + i * 8192, R, C); const int Rb = (R & ~31) + perm32(R & 31);
        RA[i] = R; CA[i] = (unsigned)C * 2u; voffA[i] = (unsigned)(R * lda) + (unsigned)C * 2u; voffB[i] = (unsigned)(Rb * ldb) + (unsigned)C * 2u; }
    const size_t hstepA = (size_t)HALF * lda;
    const size_t kstep = (size_t)(BK * 2);
    const size_t hstepB = (size_t)HALF * ldb;
    const unsigned ldsw = (unsigned)wid * 1024u;
    const int aoff = lds_byte(wr * 64 + fr, fq * 8), boff = lds_byte(wc * 32 + fr, fq * 8);
#define PG8_SA(b, h) (((b) * 2 + (h)) * HTB)
#define PG8_SB(b, h) ((4 + (b) * 2 + (h)) * HTB)
#define PG8_STAGE(bufoff, gbase, voff) do { _Pragma("unroll") for (int _i = 0; _i < 2; ++_i) \
        __builtin_amdgcn_global_load_lds((const unsigned*)((const char*)(gbase) + (voff)[_i]), (LAS unsigned*)(lds + (bufoff) + ldsw + _i * 8192), 16, 0, 0); } while (0)
#define PG8_LDA(dst, b, h) do { _Pragma("unroll") for (int m = 0; m < 4; ++m) _Pragma("unroll") for (int k = 0; k < 2; ++k) dst[m][k] = *(const LAS bf16x8*)(lds + PG8_SA(b, h) + aoff + m * 2048 + k * 1024); } while (0)
#define PG8_LDB(dst, b, h) do { _Pragma("unroll") for (int n = 0; n < 2; ++n) _Pragma("unroll") for (int k = 0; k < 2; ++k) dst[n][k] = *(const LAS bf16x8*)(lds + PG8_SB(b, h) + boff + n * 2048 + k * 1024); } while (0)
#define PG8_MMA(ai, bj, At, Bt) do { __builtin_amdgcn_s_setprio(1); \
        if constexpr (FP8) { _Pragma("unroll") for (int m = 0; m < 4; ++m) _Pragma("unroll") for (int n = 0; n < 2; ++n) { \
            const i32x8 bb_ = __builtin_shufflevector(__builtin_bit_cast(i32x4, Bt[n][0]), __builtin_bit_cast(i32x4, Bt[n][1]), 0, 1, 2, 3, 4, 5, 6, 7); \
            const i32x8 aa_ = __builtin_shufflevector(__builtin_bit_cast(i32x4, At[m][0]), __builtin_bit_cast(i32x4, At[m][1]), 0, 1, 2, 3, 4, 5, 6, 7); \
            asm volatile("v_mfma_scale_f32_16x16x128_f8f6f4 %0, %1, %2, %0, %3, %3 op_sel_hi:[0,0,0]" : "+v"(acc[ai][bj][m][n]) : "v"(bb_), "v"(aa_), "v"(sc1_)); } } \
        else { _Pragma("unroll") for (int m = 0; m < 4; ++m) _Pragma("unroll") for (int n = 0; n < 2; ++n) _Pragma("unroll") for (int k = 0; k < 2; ++k) \
            acc[ai][bj][m][n] = __builtin_amdgcn_mfma_f32_16x16x32_bf16(Bt[n][k], At[m][k], acc[ai][bj][m][n], 0, 0, 0); } \
        __builtin_amdgcn_s_setprio(0); } while (0)
#define PG8_WAIT_V(n) asm volatile("s_waitcnt vmcnt(" #n ")" ::: "memory")
#define PG8_WAIT_L(n) asm volatile("s_waitcnt lgkmcnt(" #n ")" ::: "memory")
#define PG8_BAR __builtin_amdgcn_s_barrier()
#define PG8_SCHED __builtin_amdgcn_sched_barrier(0)
#define PG8_STA(bufoff, nx, h, kb) do { if constexpr (GA) { unsigned _w[2]; _Pragma("unroll") for (int _i = 0; _i < 2; ++_i) _w[_i] = (nx) ? vN[h][_i] : vA[h][_i]; PG8_STAGE(bufoff, Ab + (kb), _w); } \
        else { PG8_STAGE(bufoff, ((nx) ? nA : cA) + (h) * hstepA + (kb), voffA); } } while (0)
#define PG8_AOFF(dst, u) do { _Pragma("unroll") for (int _h = 0; _h < 2; ++_h) _Pragma("unroll") for (int _i = 0; _i < 2; ++_i) \
        dst[_h][_i] = (unsigned)S.arow(u, _h * HALF + RA[_i]) * (unsigned)lda + CA[_i]; } while (0)
#define PG8_AROW(dst, u) do { _Pragma("unroll") for (int _h = 0; _h < 2; ++_h) _Pragma("unroll") for (int _i = 0; _i < 2; ++_i) \
        dst[_h][_i] = (unsigned)S.arow(u, _h * HALF + RA[_i]); } while (0)
    Unit cur, nxt; int ui = 0;
    if (!S.next(0, cur)) return;
    f32x4 acc[2][2][4][2];
#pragma unroll
    for (int a = 0; a < 2; ++a)
#pragma unroll
        for (int b = 0; b < 2; ++b)
#pragma unroll
            for (int m = 0; m < 4; ++m)
#pragma unroll
                for (int n = 0; n < 2; ++n) acc[a][b][m][n] = (f32x4){0.f, 0.f, 0.f, 0.f};
    bf16x8 At[4][2], B0[2][2], B1[2][2];
    int sc1_ = 0x7f7f7f7f; asm volatile("" : "+v"(sc1_));
    unsigned vA[2][2], vN[2][2];
    if constexpr (GA) { PG8_AOFF(vA, cur); }
    const char* Ab = (const char*)A;
    const char* cA = Ab + (size_t)S.arow(cur, 0) * lda; const char* nA = cA;
    const char* cB = S.bptr(cur);
    PG8_STAGE(PG8_SB(0, 0), cB, voffB); PG8_STAGE(PG8_SB(0, 1), cB + hstepB, voffB); PG8_STA(PG8_SA(0, 0), false, 0, 0); PG8_STA(PG8_SA(0, 1), false, 1, 0);
    if (wr == 1) PG8_BAR;
    PG8_WAIT_V(2); PG8_BAR;
    PG8_STAGE(PG8_SB(1, 0), cB + kstep, voffB); PG8_STA(PG8_SA(1, 0), false, 0, kstep); PG8_STAGE(PG8_SB(1, 1), cB + hstepB + kstep, voffB);
    PG8_WAIT_V(6); PG8_BAR;
    for (;;) {
        const bool has_next = S.next(ui + 1, nxt, cur.e);
        if constexpr (GA) { if (has_next) { PG8_AROW(vN, nxt); } else {
#pragma unroll
            for (int _h = 0; _h < 2; ++_h)
#pragma unroll
                for (int _i = 0; _i < 2; ++_i) vN[_h][_i] = vA[_h][_i]; } }
        else { nA = has_next ? Ab + (size_t)S.arow(nxt, 0) * lda : cA; }
        const char* nB = has_next ? S.bptr(nxt) : cB;
#pragma unroll 1
        for (int t = 0; t < nt; t += 2) {
            const bool last = (t == nt - 2);
            if constexpr (GA) { if (last && has_next) {
#pragma unroll
                for (int _h = 0; _h < 2; ++_h)
#pragma unroll
                    for (int _i = 0; _i < 2; ++_i) vN[_h][_i] = vN[_h][_i] * (unsigned)lda + CA[_i]; } }
            const size_t k1 = (size_t)(t + 1) * kstep, k2 = last ? 0 : (size_t)(t + 2) * kstep, k3 = k2 + kstep;
            const char* b2 = last ? nB : cB + (size_t)(t + 2) * kstep; const char* b3 = b2 + kstep;
            PG8_LDB(B0, 0, 0); PG8_LDB(B1, 0, 1); PG8_SCHED; PG8_LDA(At, 0, 0); PG8_STA(PG8_SA(1, 1), false, 1, k1);
            PG8_WAIT_V(8); PG8_WAIT_L(0); PG8_BAR; PG8_MMA(0, 0, At, B0); PG8_MMA(0, 1, At, B1); PG8_BAR; PG8_SCHED;
            PG8_LDA(At, 0, 1); PG8_STAGE(PG8_SB(0, 0), b2, voffB); PG8_STAGE(PG8_SB(0, 1), b2 + hstepB, voffB); PG8_STA(PG8_SA(0, 0), last, 0, k2);
            PG8_WAIT_V(8); PG8_WAIT_L(0); PG8_BAR; PG8_MMA(1, 0, At, B0); PG8_MMA(1, 1, At, B1); PG8_BAR; PG8_SCHED;
            PG8_LDB(B0, 1, 0); PG8_LDB(B1, 1, 1); PG8_SCHED; PG8_LDA(At, 1, 0); PG8_STA(PG8_SA(0, 1), last, 1, k2);
            PG8_WAIT_V(8); PG8_WAIT_L(0); PG8_BAR; PG8_MMA(0, 0, At, B0); PG8_MMA(0, 1, At, B1); PG8_BAR; PG8_SCHED;
            PG8_LDA(At, 1, 1); PG8_STAGE(PG8_SB(1, 0), b3, voffB); PG8_STAGE(PG8_SB(1, 1), b3 + hstepB, voffB); PG8_STA(PG8_SA(1, 0), last, 0, k3);
            PG8_WAIT_V(8); PG8_WAIT_L(0); PG8_BAR; PG8_MMA(1, 0, At, B0); PG8_MMA(1, 1, At, B1); PG8_BAR; PG8_SCHED;
        }
        if constexpr (ALIGN_EPI) { if (wr == 0) PG8_BAR; }
        if constexpr (FP8) asm volatile("s_nop 15\n\ts_nop 7" ::: "memory");
        E(acc, cur, wr, wc, fr, fq);
        if (!has_next) break;
#pragma unroll
        for (int a = 0; a < 2; ++a)
#pragma unroll
            for (int b = 0; b < 2; ++b)
#pragma unroll
                for (int m = 0; m < 4; ++m)
#pragma unroll
                    for (int n = 0; n < 2; ++n) acc[a][b][m][n] = (f32x4){0.f, 0.f, 0.f, 0.f};
        cur = nxt; cB = nB; cA = nA; ++ui;
        if constexpr (GA) {
#pragma unroll
        for (int _h = 0; _h < 2; ++_h)
#pragma unroll
            for (int _i = 0; _i < 2; ++_i) vA[_h][_i] = vN[_h][_i]; }
        if constexpr (ALIGN_EPI) { if (wr == 1) PG8_BAR; }
    }
    PG8_WAIT_V(0);
    if constexpr (!ALIGN_EPI) { if (wr == 0) PG8_BAR; }
    PG8_BAR;
#undef PG8_SA
#undef PG8_SB
#undef PG8_STAGE
#undef PG8_LDA
#undef PG8_LDB
#undef PG8_MMA
#undef PG8_WAIT_V
#undef PG8_WAIT_L
#undef PG8_BAR
#undef PG8_SCHED
#undef PG8_AOFF
#undef PG8_AROW
#undef PG8_STA
}

struct EpiPlain {
    bf16_t* O; int ldc; float scale;
    __device__ __forceinline__ void operator()(const f32x4 (&acc)[2][2][4][2], const Unit& u, int wr, int wc, int fr_, int fq_) const {
        int ln_ = __builtin_amdgcn_mbcnt_hi(~0u, __builtin_amdgcn_mbcnt_lo(~0u, 0u)); asm volatile("" : "+v"(ln_)); const int fr = ln_ & 15, fq = ln_ >> 4;
        const int row0 = u.pm * BM + wr * 64 + fr, col0 = u.pn * BM + wc * 32 + 8 * fq;
#pragma unroll
        for (int ai = 0; ai < 2; ++ai)
#pragma unroll
            for (int m = 0; m < 4; ++m) { bf16_t* rowp = O + (size_t)(row0 + ai * HALF + m * 16) * ldc + col0;
#pragma unroll
                for (int bj = 0; bj < 2; ++bj) *(u32x4*)(rowp + bj * HALF) = pack8(acc[ai][bj][m][0] * scale, acc[ai][bj][m][1] * scale); }
    }
};

struct EpiInProj {
    bf16_t* proj; float* ssq_q; float* ssq_kv; bf16_t* Km; bf16_t* Vtd; const float* rcos; const float* rsin;
    __device__ __forceinline__ void operator()(const f32x4 (&acc)[2][2][4][2], const Unit& u, int wr, int wc, int fr_, int fq_) const {
        int ln_ = __builtin_amdgcn_mbcnt_hi(~0u, __builtin_amdgcn_mbcnt_lo(~0u, 0u)); asm volatile("" : "+v"(ln_)); const int fr = ln_ & 15, fq = ln_ >> 4;
        const int row0 = u.pm * BM + wr * 64 + fr, col0 = u.pn * BM + wc * 32 + 8 * fq;
        const int pn = u.pn;
#pragma unroll
        for (int ai = 0; ai < 2; ++ai)
#pragma unroll
            for (int m = 0; m < 4; ++m) {
                const int row = row0 + ai * HALF + m * 16;
                bf16_t* rowp = proj + (size_t)row * NPROJ + col0;
                float sq = 0.f;
#pragma unroll
                for (int bj = 0; bj < 2; ++bj) {
                    const f32x4 v0 = acc[ai][bj][m][0], v1 = acc[ai][bj][m][1];
                    *(u32x4*)(rowp + bj * HALF) = pack8(v0, v1);
                    if (pn == 0 || (pn == 1 && bj == 0)) sq += (v0[0] * v0[0] + v0[1] * v0[1]) + (v0[2] * v0[2] + v0[3] * v0[3]) + (v1[0] * v1[0] + v1[1] * v1[1]) + (v1[2] * v1[2] + v1[3] * v1[3]);
                    if (pn == 1 && bj == 1 && wc == 0) {
                        const int i0 = 8 * (fq & 1);
                        const f32x4 c0 = *(const f32x4*)(rcos + (size_t)row * 16 + i0), c1 = *(const f32x4*)(rcos + (size_t)row * 16 + i0 + 4);
                        const f32x4 s0 = *(const f32x4*)(rsin + (size_t)row * 16 + i0), s1 = *(const f32x4*)(rsin + (size_t)row * 16 + i0 + 4);
                        f32x4 o0, o1; const float sg = (fq < 2) ? -1.f : 1.f;
#pragma unroll
                        for (int j = 0; j < 4; ++j) { const float p0 = __shfl_xor(v0[j], 32), p1 = __shfl_xor(v1[j], 32);
                            o0[j] = v0[j] * c0[j] + sg * p0 * s0[j]; o1[j] = v1[j] * c1[j] + sg * p1 * s1[j]; }
                        const u32x4 w = pack8(o0, o1);
#pragma unroll
                        for (int h = 0; h < 8; ++h) *(u32x4*)(Km + (size_t)row * 768 + h * 96 + 64 + 8 * fq) = w;
                    }
                    if (pn == 4 && bj == 1) {
                        const int b = row >> 11, s = row & 2047, cv0 = wc * 32 + 8 * fq;
#pragma unroll
                        for (int j = 0; j < 8; ++j) { const int cv = cv0 + j; const float val = (j < 4) ? v0[j & 3] : v1[j & 3];
                            Vtd[((size_t)(b * 2 + (cv >> 6)) * 64 + (cv & 63)) * SEQ + s] = (bf16_t)f2bf(val); }
                    }
                }
                if (pn <= 1) { sq += __shfl_xor(sq, 16); sq += __shfl_xor(sq, 32); if (fq == 0) (pn == 0 ? ssq_q : ssq_kv)[(size_t)row * 4 + wc] = sq; }
            }
    }
};

struct EpiQb {
    bf16_t* Qm; const float* ssq_q; const float* rcos; const float* rsin; float c2;
    __device__ __forceinline__ void operator()(const f32x4 (&acc)[2][2][4][2], const Unit& u, int wr, int wc, int fr_, int fq_) const {
        int ln_ = __builtin_amdgcn_mbcnt_hi(~0u, __builtin_amdgcn_mbcnt_lo(~0u, 0u)); asm volatile("" : "+v"(ln_)); const int fr = ln_ & 15, fq = ln_ >> 4;
        const int row0 = u.pm * BM + wr * 64 + fr, col0 = u.pn * BM + wc * 32 + 8 * fq;
#pragma unroll
        for (int ai = 0; ai < 2; ++ai)
#pragma unroll
            for (int m = 0; m < 4; ++m) {
                const int row = row0 + ai * HALF + m * 16;
                const f32x4 rs = *(const f32x4*)(ssq_q + (size_t)row * 4);
                const float rstd = rsqrtf(((rs[0] + rs[1]) + (rs[2] + rs[3])) * (1.f / 256.f) + EPS) * c2;
#pragma unroll
                for (int bj = 0; bj < 2; ++bj) {
                    f32x4 v0 = acc[ai][bj][m][0] * rstd, v1 = acc[ai][bj][m][1] * rstd;
                    const int G = 8 * u.pn + 4 * bj + wc;
                    if (G % 3 == 2) {
                        const int i0 = 8 * (fq & 1);
                        const f32x4 c0 = *(const f32x4*)(rcos + (size_t)row * 16 + i0), c1 = *(const f32x4*)(rcos + (size_t)row * 16 + i0 + 4);
                        const f32x4 s0 = *(const f32x4*)(rsin + (size_t)row * 16 + i0), s1 = *(const f32x4*)(rsin + (size_t)row * 16 + i0 + 4);
                        f32x4 o0, o1; const float sg = (fq < 2) ? -1.f : 1.f;
#pragma unroll
                        for (int j = 0; j < 4; ++j) { const float p0 = __shfl_xor(v0[j], 32), p1 = __shfl_xor(v1[j], 32);
                            o0[j] = v0[j] * c0[j] + sg * p0 * s0[j]; o1[j] = v1[j] * c1[j] + sg * p1 * s1[j]; }
                        v0 = o0; v1 = o1;
                    }
                    *(u32x4*)(Qm + (size_t)row * 768 + col0 + bj * HALF) = pack8(v0, v1);
                }
                asm volatile("" ::: "memory");
            }
    }
};

struct EpiKvb {
    bf16_t* Km; bf16_t* Vtm; const float* ssq_kv;
    __device__ __forceinline__ void operator()(const f32x4 (&acc)[2][2][4][2], const Unit& u, int wr, int wc, int fr_, int fq_) const {
        int ln_ = __builtin_amdgcn_mbcnt_hi(~0u, __builtin_amdgcn_mbcnt_lo(~0u, 0u)); asm volatile("" : "+v"(ln_)); const int fr = ln_ & 15, fq = ln_ >> 4;
        const int row0 = u.pm * BM + wr * 64 + fr, col0 = u.pn * BM + wc * 32 + 8 * fq;
#pragma unroll
        for (int ai = 0; ai < 2; ++ai)
#pragma unroll
            for (int m = 0; m < 4; ++m) {
                const int row = row0 + ai * HALF + m * 16;
                const f32x4 rs = *(const f32x4*)(ssq_kv + (size_t)row * 4);
                const float rstd = rsqrtf(((rs[0] + rs[1]) + (rs[2] + rs[3])) * (1.f / 128.f) + EPS);
#pragma unroll
                for (int bj = 0; bj < 2; ++bj) {
                    const f32x4 v0 = acc[ai][bj][m][0] * rstd, v1 = acc[ai][bj][m][1] * rstd;
                    const int col = col0 + bj * HALF;
                    if (u.pn < 2) { const int h = col >> 6, d = col & 63; *(u32x4*)(Km + (size_t)row * 768 + h * 96 + d) = pack8(v0, v1); }
                    else { const int cv = col - 512, h = cv >> 6, d0 = cv & 63, b = row >> 11, s = row & 2047;
#pragma unroll
                        for (int j = 0; j < 8; ++j) { const float val = (j < 4) ? v0[j & 3] : v1[j & 3];
                            Vtm[((size_t)(b * 8 + h) * 64 + d0 + j) * SEQ + s] = (bf16_t)f2bf(val); } }
                }
            }
    }
};

constexpr float W8_SCALE = 64.f, W8_INV = 1.f / 64.f;
struct EpiMoe1 {
    unsigned char* act; const float* b1;
    __device__ __forceinline__ void operator()(const f32x4 (&acc)[2][2][4][2], const Unit& u, int wr, int wc, int fr_, int fq_) const {
        int ln_ = __builtin_amdgcn_mbcnt_hi(~0u, __builtin_amdgcn_mbcnt_lo(~0u, 0u)); asm volatile("" : "+v"(ln_)); const int fr = ln_ & 15, fq = ln_ >> 4;
        const int row0 = u.pm * BM + wr * 64 + fr, col0 = u.pn * BM + wc * 32 + 8 * fq;
        f32x4 bv[2][2];
#pragma unroll
        for (int bj = 0; bj < 2; ++bj)
#pragma unroll
            for (int n = 0; n < 2; ++n) bv[bj][n] = *(const f32x4*)(b1 + (size_t)u.e * 2048 + col0 + bj * HALF + 4 * n);
#pragma unroll
        for (int ai = 0; ai < 2; ++ai)
#pragma unroll
            for (int m = 0; m < 4; ++m) {
                unsigned char* rowp = act + (size_t)(row0 + ai * HALF + m * 16) * FE + (col0 >> 1);
#pragma unroll
                for (int bj = 0; bj < 2; ++bj) {
                    const f32x4 v0 = acc[ai][bj][m][0] * W8_INV + bv[bj][0], v1 = acc[ai][bj][m][1] * W8_INV + bv[bj][1];
                    float o[4];
#pragma unroll
                    for (int p = 0; p < 4; ++p) { const float g = fminf((p < 2) ? v0[2 * (p & 1)] : v1[2 * (p & 1)], 7.f);
                        const float l = fminf(fmaxf((p < 2) ? v0[2 * (p & 1) + 1] : v1[2 * (p & 1) + 1], -7.f), 7.f);
                        const float sg = __builtin_amdgcn_rcpf(1.f + __builtin_amdgcn_exp2f(-1.702f * LOG2E * g));
                        o[p] = g * sg * (l + 1.f); }
                    int w = 0; w = __builtin_amdgcn_cvt_pk_fp8_f32(o[0], o[1], w, false); w = __builtin_amdgcn_cvt_pk_fp8_f32(o[2], o[3], w, true);
                    *(int*)(rowp + bj * (HALF / 2)) = w;
                }
            }
    }
};

struct EpiMoe2 {
    unsigned char* yb; const float* b2;
    __device__ __forceinline__ void operator()(const f32x4 (&acc)[2][2][4][2], const Unit& u, int wr, int wc, int fr_, int fq_) const {
        int ln_ = __builtin_amdgcn_mbcnt_hi(~0u, __builtin_amdgcn_mbcnt_lo(~0u, 0u)); asm volatile("" : "+v"(ln_)); const int fr = ln_ & 15, fq = ln_ >> 4;
        const int row0 = u.pm * BM + wr * 64 + fr, col0 = u.pn * BM + wc * 32 + 8 * fq;
        f32x4 bv[2][2];
#pragma unroll
        for (int bj = 0; bj < 2; ++bj)
#pragma unroll
            for (int n = 0; n < 2; ++n) bv[bj][n] = *(const f32x4*)(b2 + (size_t)u.e * 1024 + col0 + bj * HALF + 4 * n);
#pragma unroll
        for (int ai = 0; ai < 2; ++ai)
#pragma unroll
            for (int m = 0; m < 4; ++m) { unsigned char* rowp = yb + (size_t)(row0 + ai * HALF + m * 16) * FE + col0;
#pragma unroll
                for (int bj = 0; bj < 2; ++bj) { const f32x4 v0 = acc[ai][bj][m][0] * W8_INV + bv[bj][0], v1 = acc[ai][bj][m][1] * W8_INV + bv[bj][1];
                    int w0 = 0, w1 = 0; w0 = __builtin_amdgcn_cvt_pk_fp8_f32(v0[0], v0[1], w0, false); w0 = __builtin_amdgcn_cvt_pk_fp8_f32(v0[2], v0[3], w0, true);
                    w1 = __builtin_amdgcn_cvt_pk_fp8_f32(v1[0], v1[1], w1, false); w1 = __builtin_amdgcn_cvt_pk_fp8_f32(v1[2], v1[3], w1, true);
                    *(u32x2*)(rowp + bj * HALF) = (u32x2){(unsigned)w0, (unsigned)w1}; } }
    }
};
}

struct Args {
    const float* x; const float* c; const int* pos; const float* w_ada; const float* b_ada;
    const float* g_pre_mix; const float* g_post_mix; const float* g_pre_ffn; const float* g_post_ffn;
    const float* w_in; const float* g_q_a; const float* g_kv_a; const float* w_q_b; const float* w_kv_b; const float* w_o;
    const float* w_router; const float* b_router; const float* w_mlp1; const float* b_mlp1; const float* w_mlp2; const float* b_mlp2;
    float* out; unsigned char* ws; int ph_lo, ph_hi;
};

__device__ __forceinline__ unsigned cvt_pk_bf16_(float lo, float hi) { unsigned r; asm volatile("v_cvt_pk_bf16_f32 %0, %1, %2" : "=v"(r) : "v"(lo), "v"(hi)); return r; }
template <bool FP8>
__device__ __forceinline__ void transpose_item(const float* W, int ldw, int srccol0, int nvalid, bool kvalid, const float* kscale, float cscale,
                                               void* WT, int ldk, int dstrow0, int k0, LAS float* scr, int lane) {
    const int kr = lane >> 3, n4 = (lane & 7) * 4;
#pragma unroll
    for (int i = 0; i < 8; ++i) { const int kk = kr + 8 * i;
        f32x4 v = (f32x4){0.f, 0.f, 0.f, 0.f};
        if (kvalid && n4 < nvalid) { v = *(const f32x4*)(W + (size_t)(k0 + kk) * ldw + srccol0 + n4); float sc = cscale; if (kscale) sc *= kscale[k0 + kk]; v = v * sc; }
        *(LAS f32x4*)(scr + kk * 36 + n4) = v; }
    LDS_WAIT(); asm volatile("" ::: "memory");
    const int n = lane & 31, kh = lane >> 5;
    const LAS float* sp = scr + (32 * kh) * 36 + n;
    if constexpr (FP8) {
        int w[8];
#pragma unroll
        for (int q = 0; q < 8; ++q) { float f0 = sp[(4 * q) * 36], f1 = sp[(4 * q + 1) * 36], f2 = sp[(4 * q + 2) * 36], f3 = sp[(4 * q + 3) * 36];
            f0 = fminf(fmaxf(f0, -448.f), 448.f); f1 = fminf(fmaxf(f1, -448.f), 448.f); f2 = fminf(fmaxf(f2, -448.f), 448.f); f3 = fminf(fmaxf(f3, -448.f), 448.f);
            int t = 0; t = __builtin_amdgcn_cvt_pk_fp8_f32(f0, f1, t, false); t = __builtin_amdgcn_cvt_pk_fp8_f32(f2, f3, t, true); w[q] = t; }
        unsigned char* dst = (unsigned char*)WT + (size_t)(dstrow0 + n) * ldk + k0 + 32 * kh;
        *(i32x4*)dst = (i32x4){w[0], w[1], w[2], w[3]}; *(i32x4*)(dst + 16) = (i32x4){w[4], w[5], w[6], w[7]};
    } else {
        unsigned w[16];
#pragma unroll
        for (int q = 0; q < 16; ++q) w[q] = cvt_pk_bf16_(sp[(2 * q) * 36], sp[(2 * q + 1) * 36]);
        bf16_t* dst = (bf16_t*)WT + (size_t)(dstrow0 + n) * ldk + k0 + 32 * kh;
#pragma unroll
        for (int q = 0; q < 4; ++q) *(u32x4*)(dst + 8 * q) = (u32x4){w[4 * q], w[4 * q + 1], w[4 * q + 2], w[4 * q + 3]};
    }
    LDS_WAIT(); asm volatile("" ::: "memory");
}

__device__ __forceinline__ void moe_item_decode(const Args& a, int r, const float*& W, int& ldw, unsigned char*& WT, int& srccol, int& k0) {
    constexpr int I_M1 = 32 * 16 * 64;
    if (r < I_M1) { const int e = r / 1024, q = r % 1024, kb = q / 64, nb = q % 64; W = a.w_mlp1 + (size_t)e * 1024 * 2048; ldw = 2048; WT = a.ws + WS_W1T + (size_t)e * 2048 * 1024; srccol = 32 * nb; k0 = 64 * kb; }
    else { r -= I_M1; const int e = r / 512, q = r % 512, kb = q / 32, nb = q % 32; W = a.w_mlp2 + (size_t)e * 1024 * 1024; ldw = 1024; WT = a.ws + WS_W2T + (size_t)e * 1024 * 1024; srccol = 32 * nb; k0 = 64 * kb; }
}
__device__ __forceinline__ void moe_item_load(const Args& a, int r, f32x4 (&v)[8], int lane) {
    const float* W; int ldw, srccol, k0; unsigned char* WT; moe_item_decode(a, r, W, ldw, WT, srccol, k0);
    const int kr = lane >> 3, n4 = (lane & 7) * 4;
#pragma unroll
    for (int i = 0; i < 8; ++i) v[i] = __builtin_nontemporal_load((const f32x4*)(W + (size_t)(k0 + kr + 8 * i) * ldw + srccol + n4));
}
__device__ __forceinline__ void moe_item_finish(const Args& a, int r, const f32x4 (&v)[8], LAS float* scr, int lane) {
    const float* W; int ldw, srccol, k0; unsigned char* WT; moe_item_decode(a, r, W, ldw, WT, srccol, k0);
    const int kr = lane >> 3, n4 = (lane & 7) * 4;
#pragma unroll
    for (int i = 0; i < 8; ++i) *(LAS f32x4*)(scr + (kr + 8 * i) * 36 + n4) = v[i] * pg8::W8_SCALE;
    LDS_WAIT(); asm volatile("" ::: "memory");
    const int n = lane & 31, kh = lane >> 5;
    const LAS float* sp = scr + (32 * kh) * 36 + n;
    int w[8];
#pragma unroll
    for (int q = 0; q < 8; ++q) { float f0 = sp[(4 * q) * 36], f1 = sp[(4 * q + 1) * 36], f2 = sp[(4 * q + 2) * 36], f3 = sp[(4 * q + 3) * 36];
        f0 = fminf(fmaxf(f0, -448.f), 448.f); f1 = fminf(fmaxf(f1, -448.f), 448.f); f2 = fminf(fmaxf(f2, -448.f), 448.f); f3 = fminf(fmaxf(f3, -448.f), 448.f);
        int t = 0; t = __builtin_amdgcn_cvt_pk_fp8_f32(f0, f1, t, false); t = __builtin_amdgcn_cvt_pk_fp8_f32(f2, f3, t, true); w[q] = t; }
    unsigned char* dst = WT + (size_t)(srccol + n) * 1024 + k0 + 32 * kh;
    *(i32x4*)dst = (i32x4){w[0], w[1], w[2], w[3]}; *(i32x4*)(dst + 16) = (i32x4){w[4], w[5], w[6], w[7]};
    LDS_WAIT(); asm volatile("" ::: "memory");
}

__device__ __forceinline__ void p0_prologue(const Args& a, LAS unsigned char* lds, int tid, int wave, int lane) {
    unsigned char* ws = a.ws;
    LAS float* scr = (LAS float*)(lds + wave * 9216);
    LAS float* cond = (LAS float*)(lds + 8 * 9216);
    for (int i = tid; i < NB * DM; i += 512) { const float v = a.c[i]; cond[i] = v / (1.f + __expf(-v)); }
    __syncthreads();
    const int gw = blockIdx.x * 8 + wave, NGW = gridDim.x * 8;
    constexpr int I_ADA = 8 * 192, I_IN = 16 * 48, I_QB = 4 * 24, I_KVB = 4 * 32, I_O = 16 * 32, I_M1 = 32 * 16 * 64, I_M2 = 32 * 16 * 32;
    constexpr int NITEMS = I_ADA + I_IN + I_QB + I_KVB + I_O;
    float* modp = (float*)(ws + WS_MODP);
    for (int it = gw; it < NITEMS; it += NGW) {
        int r = it;
        if (r < I_ADA) {
            const int kc = r / 192, cc = r % 192, k0 = 128 * kc + (lane >> 3), c0 = 32 * cc + 4 * (lane & 7);
            f32x4 acc[8];
#pragma unroll
            for (int b = 0; b < 8; ++b) acc[b] = (f32x4){0.f, 0.f, 0.f, 0.f};
#pragma unroll 8
            for (int i = 0; i < 16; ++i) { const int k = k0 + 8 * i;
                const f32x4 w = __builtin_nontemporal_load((const f32x4*)(a.w_ada + (size_t)k * 6144 + c0));
#pragma unroll
                for (int b = 0; b < 8; ++b) acc[b] += w * cond[b * DM + k]; }
#pragma unroll
            for (int b = 0; b < 8; ++b) {
#pragma unroll
                for (int j = 0; j < 4; ++j) { float v = acc[b][j]; v += __shfl_xor(v, 8); v += __shfl_xor(v, 16); v += __shfl_xor(v, 32); acc[b][j] = v; }
                if (lane < 8) *(f32x4*)(modp + (size_t)(kc * 8 + b) * 6144 + c0) = acc[b]; }
            continue;
        }
        r -= I_ADA;
        if (r < I_IN) {
            const int kb = r / 48, nb = r % 48, j = 32 * nb; int src, nv = 32; float cs = 1.f;
            if (j < 416) src = j;
            else if (j < 448) src = 1440 + (j - 416);
            else if (j < 480) { src = 1472; nv = 8; cs = 0.35355339059327373f; }
            else if (j < 512) { src = 0; nv = 0; }
            else if (j < 1024) { src = 416 + (j - 512); cs = 0.125f * LOG2E; }
            else if (j < 1152) src = 928 + (j - 1024);
            else if (j < 1280) src = 1056 + (j - 1152);
            else { src = 1184 + (j - 1280); cs = 0.17677669529663687f; }
            transpose_item<false>(a.w_in, 1480, src, nv, true, nullptr, cs, (bf16_t*)(ws + WS_WIN), 1024, j, 64 * kb, scr, lane); continue;
        }
        r -= I_IN;
        if (r < I_QB) { const int kb = r / 24, nb = r % 24;
            transpose_item<false>(a.w_q_b, 768, 32 * nb, 32, true, a.g_q_a, 1.f, (bf16_t*)(ws + WS_WQB), 256, 32 * nb, 64 * kb, scr, lane); continue; }
        r -= I_QB;
        if (r < I_KVB) { const int kb = r / 32, nb = r % 32, j = 32 * nb; int src;
            if (j < 512) src = (j >> 6) * 128 + (j & 63); else { const int jj = j - 512; src = (jj >> 6) * 128 + 64 + (jj & 63); }
            transpose_item<false>(a.w_kv_b, 1024, src, 32, kb < 2, a.g_kv_a, 1.f, (bf16_t*)(ws + WS_WKVB), 256, j, 64 * kb, scr, lane); continue; }
        r -= I_KVB;
        if (r < I_O) { const int kb = r / 32, nb = r % 32;
            transpose_item<true>(a.w_o, 1024, 32 * nb, 32, true, nullptr, pg8::W8_SCALE, ws + WS_WO, 1024, 32 * nb, 64 * kb, scr, lane); continue; }
    }
}

__device__ __forceinline__ void moe_weights_phase(const Args& a, LAS unsigned char* lds, int wave, int lane, int r0, int r1, int gw, int NGW) {
    LAS float* scr = (LAS float*)(lds + wave * 9216);
    constexpr int I_M1 = 32 * 16 * 64, I_M2 = 32 * 16 * 32;
    {
        const int NM = r1;
        f32x4 va[8], vb[8];
        int r = r0 + gw;
        if (r < NM) moe_item_load(a, r, va, lane);
#pragma unroll 1
        while (r < NM) {
            int r2 = r + NGW; if (r2 < NM) moe_item_load(a, r2, vb, lane);
            moe_item_finish(a, r, va, scr, lane);
            r = r2; if (r >= NM) break;
            r2 = r + NGW; if (r2 < NM) moe_item_load(a, r2, va, lane);
            moe_item_finish(a, r, vb, scr, lane);
            r = r2;
        }
    }
}

__device__ __forceinline__ float mod_at(const Args& a, int b, int j) {
    const float* modp = (const float*)(a.ws + WS_MODP);
    float s = a.b_ada[j];
#pragma unroll
    for (int kc = 0; kc < 8; ++kc) s += modp[(size_t)(kc * 8 + b) * 6144 + j];
    return s;
}

__device__ __forceinline__ void p1_rows(const Args& a, LAS unsigned char* lds, int tid, int wave, int lane) {
    LAS float* Amul = (LAS float*)lds; LAS float* Badd = Amul + DM;
    bf16_t* hb = (bf16_t*)(a.ws + WS_HB);
    float* rcos = (float*)(a.ws + WS_ROPE); float* rsin = rcos + (size_t)MT * 16;
    for (int blk = blockIdx.x; blk < MT / 64; blk += gridDim.x) {
        const int b = blk / 32;
        __syncthreads();
        for (int j = tid; j < DM; j += 512) { const float sh = mod_at(a, b, j), sc = mod_at(a, b, 1024 + j); Amul[j] = a.g_pre_mix[j] * (1.f + sc); Badd[j] = sh; }
        __syncthreads();
#pragma unroll 1
        for (int r0 = wave; r0 < 64; r0 += 32) {
            f32x4 v[4][4];
#pragma unroll
            for (int q = 0; q < 4; ++q) { const f32x4* xr = (const f32x4*)(a.x + (size_t)(blk * 64 + r0 + 8 * q) * DM) + lane;
#pragma unroll
                for (int j = 0; j < 4; ++j) v[q][j] = __builtin_nontemporal_load(xr + 64 * j); }
#pragma unroll
            for (int q = 0; q < 4; ++q) {
                const int row = blk * 64 + r0 + 8 * q;
                float ss = 0.f;
#pragma unroll
                for (int j = 0; j < 4; ++j) ss += (v[q][j][0] * v[q][j][0] + v[q][j][1] * v[q][j][1]) + (v[q][j][2] * v[q][j][2] + v[q][j][3] * v[q][j][3]);
                const float rstd = rsqrtf(wave_sum(ss) * (1.f / DM) + EPS);
                unsigned long long* o8 = (unsigned long long*)(hb + (size_t)row * DM) + lane;
#pragma unroll
                for (int j = 0; j < 4; ++j) { const f32x4 am = *(const LAS f32x4*)(Amul + 4 * lane + 256 * j), bd = *(const LAS f32x4*)(Badd + 4 * lane + 256 * j);
                    const f32x4 h = v[q][j] * rstd * am + bd;
                    o8[64 * j] = (unsigned long long)pk2(h[0], h[1]) | ((unsigned long long)pk2(h[2], h[3]) << 32); }
                if (lane < 16) { const float fr = powf(10000.f, -(float)lane / 16.f); const float ang = (float)a.pos[row] * fr; float sn, cs; sincosf(ang, &sn, &cs);
                    rcos[(size_t)row * 16 + lane] = cs; rsin[(size_t)row * 16 + lane] = sn; }
            }
        }
    }
}

__device__ __forceinline__ unsigned sortable(float v) { const unsigned u = __builtin_bit_cast(unsigned, v + 0.0f); return (u & 0x80000000u) ? ~u : (u | 0x80000000u); }

__device__ __forceinline__ unsigned wave_max_u(unsigned v) {
#pragma unroll
    for (int o = 1; o < 64; o <<= 1) { const unsigned w = (unsigned)__shfl_xor((int)v, o); v = v > w ? v : w; }
    return v; }
__device__ __forceinline__ unsigned wave_min_u(unsigned v) {
#pragma unroll
    for (int o = 1; o < 64; o <<= 1) { const unsigned w = (unsigned)__shfl_xor((int)v, o); v = v < w ? v : w; }
    return v; }

__device__ __forceinline__ void idx_item(LAS unsigned char* lds, const bf16_t* proj, unsigned* bitmap, int b, int tg, int wave, int lane) {
    constexpr int SCS = 2052;
    LAS float* sc = (LAS float*)lds;
    LAS unsigned* cbuf = (LAS unsigned*)(lds + 16 * SCS * 4) + wave * 64;
    const int t0 = tg * 16, nkt = tg + 1;
    const int n = lane & 15, kq = lane >> 4;
    const size_t rowq = (size_t)(b * SEQ + t0 + n);
    bf16x8 qf[8];
#pragma unroll
    for (int h = 0; h < 8; ++h) qf[h] = *(const bf16x8*)(proj + rowq * NPROJ + PC_QIDX + h * 32 + 8 * kq);
    const u32x4 wraw = *(const u32x4*)(proj + rowq * NPROJ + PC_WIDX);
    float w[8]; w[0] = bflo(wraw.x); w[1] = bfhi(wraw.x); w[2] = bflo(wraw.y); w[3] = bfhi(wraw.y); w[4] = bflo(wraw.z); w[5] = bfhi(wraw.z); w[6] = bflo(wraw.w); w[7] = bfhi(wraw.w);
#pragma unroll 1
    for (int base = wave; base < nkt; base += 64) {
        bf16x8 kf[8];
#pragma unroll
        for (int i = 0; i < 8; ++i) { const int kt = base + 8 * i; if (kt < nkt) kf[i] = *(const bf16x8*)(proj + (size_t)(b * SEQ + 16 * kt + n) * NPROJ + PC_KIDX + 8 * kq); }
#pragma unroll
        for (int i = 0; i < 8; ++i) { const int kt = base + 8 * i;
            if (kt < nkt) {
                f32x4 s = (f32x4){0.f, 0.f, 0.f, 0.f};
#pragma unroll
                for (int h = 0; h < 8; ++h) { const f32x4 d = __builtin_amdgcn_mfma_f32_16x16x32_bf16(kf[i], qf[h], (f32x4){0.f, 0.f, 0.f, 0.f}, 0, 0, 0);
#pragma unroll
                    for (int j = 0; j < 4; ++j) s[j] = fmaf(w[h], fmaxf(d[j], 0.f), s[j]); }
                *(LAS f32x4*)(sc + n * SCS + 16 * kt + 4 * kq) = s;
            } }
    }
    __syncthreads();
#pragma unroll 1
    for (int qq = 0; qq < 2; ++qq) {
        const int q = 2 * wave + qq, t = t0 + q;
        unsigned key[32];
#pragma unroll
        for (int j = 0; j < 32; ++j) key[j] = __builtin_bit_cast(unsigned, sc[q * SCS + 64 * j + lane]);
        asm volatile("" : "+v"(key[0]), "+v"(key[1]), "+v"(key[2]), "+v"(key[3]), "+v"(key[4]), "+v"(key[5]), "+v"(key[6]), "+v"(key[7]), "+v"(key[8]), "+v"(key[9]), "+v"(key[10]), "+v"(key[11]), "+v"(key[12]), "+v"(key[13]), "+v"(key[14]), "+v"(key[15]));
        asm volatile("" : "+v"(key[16]), "+v"(key[17]), "+v"(key[18]), "+v"(key[19]), "+v"(key[20]), "+v"(key[21]), "+v"(key[22]), "+v"(key[23]), "+v"(key[24]), "+v"(key[25]), "+v"(key[26]), "+v"(key[27]), "+v"(key[28]), "+v"(key[29]), "+v"(key[30]), "+v"(key[31]));
#pragma unroll
        for (int j = 0; j < 32; ++j) key[j] = (64 * j + lane <= t) ? sortable(__builtin_bit_cast(float, key[j])) : 0u;
        unsigned long long mine = 0ull; int lo_ = lane; asm volatile("" : "+v"(lo_));
        const unsigned long long lt = (1ull << lane) - 1ull;
        if (t + 1 > 256) {
            unsigned mx = key[0], mn = key[0] ? key[0] : 0xffffffffu;
#pragma unroll
            for (int j = 1; j < 32; ++j) { mx = mx > key[j] ? mx : key[j]; const unsigned kk = key[j] ? key[j] : 0xffffffffu; mn = mn < kk ? mn : kk; }
            mx = wave_max_u(mx); mn = wave_min_u(mn);
            mx = (unsigned)__builtin_amdgcn_readfirstlane((int)mx); mn = (unsigned)__builtin_amdgcn_readfirstlane((int)mn);
            unsigned T = mx; int hiCnt = 0, ngt = 0, neq = 0; bool have = false;
            const unsigned diff = mx ^ mn;
            if (diff != 0u) {
                int bit = 31 - __builtin_clz(diff);
                T = mx & ~(((2u << bit) - 1u));
                int cntT = t + 1;
#pragma unroll 1
                while (bit >= 0 && cntT - hiCnt > 64) {
                    const unsigned cand = T | (1u << bit); unsigned cl = 0u;
#pragma unroll
                    for (int j = 0; j < 32; ++j) cl += (key[j] >= cand) ? 1u : 0u;
                    int c = 0;
#pragma unroll
                    for (int bb = 0; bb < 6; ++bb) c += __popcll(__ballot((cl >> bb) & 1u)) << bb;
                    if (c >= 256) { T = cand; cntT = c; } else hiCnt = c;
                    --bit;
                }
                if (bit >= 0) {
                    const unsigned span = (2u << bit) - 1u; int run = 0;
#pragma unroll
                    for (int j = 0; j < 32; ++j) { const bool in = (key[j] != 0u) && ((key[j] - T) <= span); const unsigned long long m = __ballot(in);
                        if (in) cbuf[run + __popcll(m & lt)] = key[j]; run += __popcll(m); if ((j & 3) == 3) __builtin_amdgcn_sched_barrier(0); }
                    LDS_WAIT();
                    const unsigned ck = (lane < run) ? cbuf[lane] : 0u;
#pragma unroll 1
                    for (; bit >= 0; --bit) { const unsigned cand = T | (1u << bit); const int c = __popcll(__ballot(ck >= cand)); if (hiCnt + c >= 256) T = cand; }
                    ngt = hiCnt + __popcll(__ballot(ck > T)); neq = __popcll(__ballot(ck == T)); have = true;
                }
            }
            if (!have) {
#pragma unroll
                for (int j = 0; j < 32; ++j) { ngt += __popcll(__ballot(key[j] > T)); neq += __popcll(__ballot(key[j] == T)); if ((j & 3) == 3) __builtin_amdgcn_sched_barrier(0); }
            }
            const int need = 256 - ngt;
            asm volatile("" : "+s"(T));
            if (neq == need) {
#pragma unroll
                for (int j = 0; j < 32; ++j) { const unsigned long long mk = __ballot(key[j] >= T); mine = (lo_ == j) ? mk : mine; if ((j & 3) == 3) __builtin_amdgcn_sched_barrier(0); }
            } else {
                int run = 0;
#pragma unroll
                for (int j = 0; j < 32; ++j) { const bool eq = key[j] == T; const unsigned long long em = __ballot(eq); const int rank = run + __popcll(em & lt);
                    const unsigned long long mk = __ballot(key[j] > T || (eq && rank < need)); mine = (lo_ == j) ? mk : mine; run += __popcll(em); if ((j & 3) == 3) __builtin_amdgcn_sched_barrier(0); }
            }
        } else {
#pragma unroll
            for (int j = 0; j < 4; ++j) { const unsigned long long mk = __ballot(64 * j + lo_ <= t); mine = (lo_ == j) ? mk : mine; }
        }
        if (lane < 32) ((unsigned long long*)bitmap)[(size_t)(b * SEQ + t) * 32 + lane] = mine;
    }
    __syncthreads();
}

__device__ __forceinline__ int crow(int r, int hi) { return (r & 3) + 8 * (r >> 2) + 4 * hi; }
typedef float f32x2_t __attribute__((ext_vector_type(2))); typedef __bf16 bf16x2_t __attribute__((ext_vector_type(2)));
__device__ __forceinline__ unsigned cvtpk(float lo, float hi) { f32x2_t v = {lo, hi}; bf16x2_t b = __builtin_convertvector(v, bf16x2_t); return __builtin_bit_cast(unsigned, b); }

template <int DQK, bool DSA>
__device__ __forceinline__ void attn_unit(LAS unsigned char* lds, int b, int qt,
                                          const bf16_t* Qp, int ldq, const bf16_t* Kp, int ldk, const bf16_t* Vt, unsigned char* Yp,
                                          const unsigned* bitmap, const int* pos, float c1, float aslope, int tid, int wave, int lane) {
    constexpr int KSTR = DQK * 2 + 16, KBYTES = 64 * KSTR, VSTR = 136, VBYTES = 64 * VSTR, BUF = KBYTES + VBYTES + 256, NKS = DQK / 16, CPR = DQK / 8, NCH = 64 * CPR;
    const int hi = lane >> 5, l31 = lane & 31;
    const int NT = 4 * (qt + 1);
    const int qw0 = 256 * qt + 32 * wave, tq = qw0 + l31;
    const size_t rowq = (size_t)(b * SEQ + tq);
    bf16x8 qf[NKS];
#pragma unroll
    for (int ks = 0; ks < NKS; ++ks) qf[ks] = *(const bf16x8*)(Qp + rowq * ldq + 16 * ks + 8 * hi);
    float ptq = 0.f; if (DSA) ptq = (float)pos[b * SEQ + tq];
    constexpr float THR = 4.0f;
    float mref = 0.f, lrun = 0.f; bool seen = false; f32x16 o[2], negm;
#pragma unroll
    for (int r = 0; r < 16; ++r) { o[0][r] = 0.f; o[1][r] = 0.f; negm[r] = 0.f; }
    u32x4 kA0, kA1, vA_, kB0, kB1, vB_; float pA = 0.f, pB = 0.f;
    const int c0 = tid, c1i = tid + 512;
    const int kr0_row = c0 / CPR, kr0_ch = c0 % CPR, kr1_row = c1i / CPR, kr1_ch = c1i % CPR;
    const int vd = tid >> 3, vkc = tid & 7;
#define ATT_LOAD(t, K0, K1, VR, PR) do { const size_t kb_ = (size_t)(b * SEQ + 64 * (t)); \
        K0 = *(const u32x4*)(Kp + (kb_ + kr0_row) * ldk + 8 * kr0_ch); \
        if (c1i < NCH) K1 = *(const u32x4*)(Kp + (kb_ + kr1_row) * ldk + 8 * kr1_ch); \
        VR = *(const u32x4*)(Vt + (size_t)vd * SEQ + 64 * (t) + 8 * vkc); \
        if (DSA && tid < 64) PR = (float)pos[b * SEQ + 64 * (t) + tid]; } while (0)
#define ATT_WRITE(bufi, K0, K1, VR, PR) do { LAS unsigned char* bb_ = lds + (bufi) * BUF; \
        *(LAS u32x4*)(bb_ + kr0_row * KSTR + 16 * kr0_ch) = K0; \
        if (c1i < NCH) *(LAS u32x4*)(bb_ + kr1_row * KSTR + 16 * kr1_ch) = K1; \
        *(LAS u32x2*)(bb_ + KBYTES + vd * VSTR + 16 * vkc) = (u32x2){VR.x, VR.y}; \
        *(LAS u32x2*)(bb_ + KBYTES + vd * VSTR + 16 * vkc + 8) = (u32x2){VR.z, VR.w}; \
        if (DSA && tid < 64) *(LAS float*)(bb_ + KBYTES + VBYTES + 4 * tid) = PR; } while (0)
    u32x2 bwn = (u32x2){0u, 0u}; if (DSA) bwn = *(const u32x2*)(bitmap + rowq * 64);
    ATT_LOAD(0, kA0, kA1, vA_, pA); ATT_LOAD(1, kB0, kB1, vB_, pB);
    ATT_WRITE(0, kA0, kA1, vA_, pA); __syncthreads();
    for (int t = 0; t < NT; ++t) {
        const u32x2 bw = bwn; if (DSA && t + 1 < NT) bwn = *(const u32x2*)(bitmap + rowq * 64 + 2 * (t + 1));
        if (t + 2 < NT) { if (t & 1) ATT_LOAD(t + 2, kB0, kB1, vB_, pB); else ATT_LOAD(t + 2, kA0, kA1, vA_, pA); }
        if (64 * t <= qw0 + 31) {
            const LAS unsigned char* bb = lds + (t & 1) * BUF;
            f32x16 s0 = negm, s1 = negm;
            bf16x8 kfa[NKS], kfb[NKS];
#pragma unroll
            for (int ks = 0; ks < NKS; ++ks) { kfa[ks] = *(const LAS bf16x8*)(bb + l31 * KSTR + 32 * ks + 16 * hi); kfb[ks] = *(const LAS bf16x8*)(bb + (32 + l31) * KSTR + 32 * ks + 16 * hi); }
            __builtin_amdgcn_sched_barrier(0);
#pragma unroll
            for (int ks = 0; ks < NKS; ++ks) {
                s0 = __builtin_amdgcn_mfma_f32_32x32x16_bf16(kfa[ks], qf[ks], s0, 0, 0, 0);
                s1 = __builtin_amdgcn_mfma_f32_32x32x16_bf16(kfb[ks], qf[ks], s1, 0, 0, 0);
            }
            __builtin_amdgcn_sched_barrier(0);
            const LAS unsigned char* vb = bb + KBYTES;
            u32x2 vlo[8], vhi[8];
#pragma unroll
            for (int kk = 0; kk < 2; ++kk)
#pragma unroll
                for (int s = 0; s < 2; ++s)
#pragma unroll
                    for (int db = 0; db < 2; ++db) { const LAS unsigned char* va = vb + (32 * db + l31) * VSTR + (32 * kk + 16 * s + 4 * hi) * 2;
                        vlo[(kk * 2 + s) * 2 + db] = *(const LAS u32x2*)va; vhi[(kk * 2 + s) * 2 + db] = *(const LAS u32x2*)(va + 16); }
            __builtin_amdgcn_sched_barrier(0);
            if (DSA) {
                asm volatile("s_nop 15\n\ts_nop 3" ::: "memory");
                __builtin_amdgcn_sched_barrier(0);
                const unsigned w0 = bw.x >> (4 * hi), w1 = bw.y >> (4 * hi);
                const LAS float* pp = (const LAS float*)(bb + KBYTES + VBYTES);
                const float nega = -aslope; const unsigned ninf = 0xff800000u;
#define DSA_EL(S, PK, W, BIT) do { float t_, v_; unsigned m_, r_; \
                    asm("v_sub_f32 %0, %1, %2" : "=v"(t_) : "v"(ptq), "v"(PK)); \
                    asm("v_fma_f32 %0, %1, |%2|, %3" : "=v"(v_) : "s"(nega), "v"(t_), "v"(S)); \
                    asm("v_bfe_i32 %0, %1, %2, 1" : "=v"(m_) : "v"(W), "n"(BIT)); \
                    asm("v_bfi_b32 %0, %1, %2, %3" : "=v"(r_) : "v"(m_), "v"(v_), "s"(ninf)); \
                    S = __builtin_bit_cast(float, r_); } while (0)
#pragma unroll
                for (int g = 0; g < 4; ++g) {
                    const f32x4 p0 = *(const LAS f32x4*)(pp + 8 * g + 4 * hi), p1 = *(const LAS f32x4*)(pp + 32 + 8 * g + 4 * hi);
                    DSA_EL(s0[4 * g + 0], p0[0], w0, 8 * g + 0); DSA_EL(s0[4 * g + 1], p0[1], w0, 8 * g + 1); DSA_EL(s0[4 * g + 2], p0[2], w0, 8 * g + 2); DSA_EL(s0[4 * g + 3], p0[3], w0, 8 * g + 3);
                    DSA_EL(s1[4 * g + 0], p1[0], w1, 8 * g + 0); DSA_EL(s1[4 * g + 1], p1[1], w1, 8 * g + 1); DSA_EL(s1[4 * g + 2], p1[2], w1, 8 * g + 2); DSA_EL(s1[4 * g + 3], p1[3], w1, 8 * g + 3);
                }
#undef DSA_EL
            } else {
                if (64 * t + 63 > qw0) {
#pragma unroll
                    for (int r = 0; r < 16; ++r) { const int key = 64 * t + crow(r, hi); if (key > tq) s0[r] = -INFINITY; if (key + 32 > tq) s1[r] = -INFINITY; }
                }
            }
            float mx;
            { float m0 = fmaxf(fmaxf(s0[0], s0[1]), s0[2]), m1 = fmaxf(fmaxf(s0[3], s0[4]), s0[5]), m2 = fmaxf(fmaxf(s1[0], s1[1]), s1[2]), m3 = fmaxf(fmaxf(s1[3], s1[4]), s1[5]);
              m0 = fmaxf(fmaxf(m0, s0[6]), s0[7]); m1 = fmaxf(fmaxf(m1, s0[8]), s0[9]); m2 = fmaxf(fmaxf(m2, s1[6]), s1[7]); m3 = fmaxf(fmaxf(m3, s1[8]), s1[9]);
              m0 = fmaxf(fmaxf(m0, s0[10]), s0[11]); m1 = fmaxf(fmaxf(m1, s0[12]), s0[13]); m2 = fmaxf(fmaxf(m2, s1[10]), s1[11]); m3 = fmaxf(fmaxf(m3, s1[12]), s1[13]);
              m0 = fmaxf(fmaxf(m0, s0[14]), s0[15]); m2 = fmaxf(fmaxf(m2, s1[14]), s1[15]);
              mx = fmaxf(fmaxf(m0, m1), fmaxf(m2, m3)); }
            mx = fmaxf(mx, __shfl_xor(mx, 32));
            {
                const bool fin = mx > -INFINITY, first = fin && !seen, upd = first || (mx > THR);
                if (__any(upd)) {
                    const float dl = upd ? mx : 0.f;
                    const float alpha = first ? 1.f : __builtin_amdgcn_exp2f(-dl);
                    mref += dl; lrun *= alpha;
#pragma unroll
                    for (int r = 0; r < 16; ++r) { s0[r] -= dl; s1[r] -= dl; o[0][r] *= alpha; o[1][r] *= alpha; negm[r] = -mref; }
                }
                seen = seen || fin;
            }
            float psum = 0.f;
#pragma unroll
            for (int r = 0; r < 16; ++r) { s0[r] = __builtin_amdgcn_exp2f(s0[r]); s1[r] = __builtin_amdgcn_exp2f(s1[r]); }
            { float q0 = 0.f, q1 = 0.f, q2 = 0.f, q3 = 0.f;
#pragma unroll
              for (int r = 0; r < 16; r += 4) { q0 += s0[r] + s1[r]; q1 += s0[r + 1] + s1[r + 1]; q2 += s0[r + 2] + s1[r + 2]; q3 += s0[r + 3] + s1[r + 3]; }
              psum = (q0 + q1) + (q2 + q3); }
            lrun += psum;
            unsigned pb0[8], pb1[8];
#pragma unroll
            for (int i = 0; i < 8; ++i) { pb0[i] = cvtpk(s0[2 * i], s0[2 * i + 1]); pb1[i] = cvtpk(s1[2 * i], s1[2 * i + 1]); }
            __builtin_amdgcn_sched_barrier(0);
#pragma unroll
            for (int kk = 0; kk < 2; ++kk)
#pragma unroll
                for (int s = 0; s < 2; ++s) {
                    u32x4 pf; if (kk == 0) pf = (u32x4){pb0[4 * s], pb0[4 * s + 1], pb0[4 * s + 2], pb0[4 * s + 3]}; else pf = (u32x4){pb1[4 * s], pb1[4 * s + 1], pb1[4 * s + 2], pb1[4 * s + 3]};
                    const bf16x8 pfr = __builtin_bit_cast(bf16x8, pf);
#pragma unroll
                    for (int db = 0; db < 2; ++db) { const int fi = (kk * 2 + s) * 2 + db;
                        const bf16x8 vf = __builtin_bit_cast(bf16x8, (u32x4){vlo[fi].x, vlo[fi].y, vhi[fi].x, vhi[fi].y});
                        o[db] = __builtin_amdgcn_mfma_f32_32x32x16_bf16(vf, pfr, o[db], 0, 0, 0); }
                }
        }
        if (t + 1 < NT) { if (t & 1) ATT_WRITE(0, kA0, kA1, vA_, pA); else ATT_WRITE(1, kB0, kB1, vB_, pB); }
        __syncthreads();
    }
#undef ATT_LOAD
#undef ATT_WRITE
    const float lt = lrun + __shfl_xor(lrun, 32);
    const float inv = 1.f / lt;
#pragma unroll
    for (int db = 0; db < 2; ++db)
#pragma unroll
        for (int g = 0; g < 4; ++g) { int w = 0; w = __builtin_amdgcn_cvt_pk_fp8_f32(o[db][4 * g] * inv, o[db][4 * g + 1] * inv, w, false); w = __builtin_amdgcn_cvt_pk_fp8_f32(o[db][4 * g + 2] * inv, o[db][4 * g + 3] * inv, w, true);
            *(int*)(Yp + rowq * DM + 32 * db + 8 * g + 4 * hi) = w; }
}

typedef float f32x2v __attribute__((ext_vector_type(2)));
__device__ __forceinline__ void p6_front(const Args& a, const bf16_t* mix, unsigned char* hb8, const LAS float* GT1, const LAS float* A2, const LAS float* B2, int row, int lane, f32x4 (&xv)[4]) {
    const u32x2* mr = (const u32x2*)(mix + (size_t)row * DM) + lane;
    const f32x4* xr = (const f32x4*)(a.x + (size_t)row * DM) + lane;
    f32x4 mv[4]; float ss = 0.f;
#pragma unroll
    for (int j = 0; j < 4; ++j) { const u32x2 q = __builtin_nontemporal_load(mr + 64 * j); mv[j] = (f32x4){bflo(q.x), bfhi(q.x), bflo(q.y), bfhi(q.y)}; xv[j] = __builtin_nontemporal_load(xr + 64 * j);
        ss += (mv[j][0] * mv[j][0] + mv[j][1] * mv[j][1]) + (mv[j][2] * mv[j][2] + mv[j][3] * mv[j][3]); }
    const float rstd1 = rsqrtf(wave_sum(ss) * (1.f / DM) + EPS);
    float ss2 = 0.f;
    f32x4* orow = (f32x4*)(a.out + (size_t)row * DM) + lane;
#pragma unroll
    for (int j = 0; j < 4; ++j) { const f32x4 g1 = *(const LAS f32x4*)(GT1 + 4 * lane + 256 * j);
        xv[j] = xv[j] + g1 * (mv[j] * rstd1); orow[64 * j] = xv[j];
        ss2 += (xv[j][0] * xv[j][0] + xv[j][1] * xv[j][1]) + (xv[j][2] * xv[j][2] + xv[j][3] * xv[j][3]); }
    const float rstd2 = rsqrtf(wave_sum(ss2) * (1.f / DM) + EPS);
    int* o4 = (int*)(hb8 + (size_t)row * DM) + lane;
#pragma unroll
    for (int j = 0; j < 4; ++j) { const f32x4 am = *(const LAS f32x4*)(A2 + 4 * lane + 256 * j), bd = *(const LAS f32x4*)(B2 + 4 * lane + 256 * j);
        xv[j] = xv[j] * rstd2 * am + bd;
        int w = 0; w = __builtin_amdgcn_cvt_pk_fp8_f32(xv[j][0], xv[j][1], w, false); w = __builtin_amdgcn_cvt_pk_fp8_f32(xv[j][2], xv[j][3], w, true);
        o4[64 * j] = w; }
}
__device__ __forceinline__ void p6_route(const Args& a, float (&pe)[32], LAS int* lcnt, LAS int* info, int r, int lane) {
    { const bool b5 = (lane & 32) != 0, b4 = (lane & 16) != 0, b3 = (lane & 8) != 0, b2 = (lane & 4) != 0, b1 = (lane & 2) != 0;
#pragma unroll
      for (int i = 0; i < 16; ++i) { const float keep = b5 ? pe[16 + i] : pe[i], send = b5 ? pe[i] : pe[16 + i]; pe[i] = keep + __shfl_xor(send, 32); }
#pragma unroll
      for (int i = 0; i < 8; ++i) { const float keep = b4 ? pe[8 + i] : pe[i], send = b4 ? pe[i] : pe[8 + i]; pe[i] = keep + __shfl_xor(send, 16); }
#pragma unroll
      for (int i = 0; i < 4; ++i) { const float keep = b3 ? pe[4 + i] : pe[i], send = b3 ? pe[i] : pe[4 + i]; pe[i] = keep + __shfl_xor(send, 8); }
#pragma unroll
      for (int i = 0; i < 2; ++i) { const float keep = b2 ? pe[2 + i] : pe[i], send = b2 ? pe[i] : pe[2 + i]; pe[i] = keep + __shfl_xor(send, 4); }
      { const float keep = b1 ? pe[1] : pe[0], send = b1 ? pe[0] : pe[1]; pe[0] = keep + __shfl_xor(send, 2); }
      pe[0] += __shfl_xor(pe[0], 1); }
    const int myexp = lane >> 1;
    const float mylg = pe[0] + a.b_router[myexp];
    int rank = 0;
#pragma unroll
    for (int j = 0; j < 32; ++j) { const float vj = __builtin_bit_cast(float, __builtin_amdgcn_readlane(__builtin_bit_cast(int, mylg), 2 * j));
        rank += (vj > mylg || (vj == mylg && j < myexp)) ? 1 : 0; }
    float tv[4]; int ti[4];
#pragma unroll
    for (int p = 0; p < 4; ++p) { const unsigned long long bm = __ballot(rank == p && !(lane & 1)); const int bi = __builtin_ctzll(bm);
        ti[p] = bi >> 1; tv[p] = __builtin_bit_cast(float, __builtin_amdgcn_readlane(__builtin_bit_cast(int, mylg), bi)); }
    float ex[4], es = 0.f;
#pragma unroll
    for (int p = 0; p < 4; ++p) { ex[p] = __expf(tv[p] - tv[0]); es += ex[p]; }
    if (lane < 4) {
        const int e = lane == 0 ? ti[0] : lane == 1 ? ti[1] : lane == 2 ? ti[2] : ti[3];
        const float g = (lane == 0 ? ex[0] : lane == 1 ? ex[1] : lane == 2 ? ex[2] : ex[3]) / es;
        const int lr = __hip_atomic_fetch_add(&lcnt[e], 1, __ATOMIC_RELAXED, __HIP_MEMORY_SCOPE_WORKGROUP);
        info[(r * 4 + lane) * 3 + 0] = e; info[(r * 4 + lane) * 3 + 1] = lr; info[(r * 4 + lane) * 3 + 2] = __builtin_bit_cast(int, g);
    }
}

__device__ __forceinline__ void p6_rows(const Args& a, LAS unsigned char* lds, int tid, int wave, int lane) {
    constexpr int WTS = 1028;
    LAS float* WT = (LAS float*)lds;
    LAS float* GT1 = WT + 32 * WTS; LAS float* A2 = GT1 + DM; LAS float* B2 = A2 + DM;
    LAS int* lcnt = (LAS int*)(B2 + DM); LAS int* lbase = lcnt + 32; LAS int* info = lbase + 32;
    unsigned char* ws = a.ws;
    const bf16_t* mix = (const bf16_t*)(ws + WS_MIX); unsigned char* hb8 = ws + WS_HB;
    int* cnt = (int*)(ws + WS_CTL) + CW_CNT; int* list = (int*)(ws + WS_LIST);
    int* route_e = (int*)(ws + WS_ROUTE); int* route_pos = route_e + MT * 4; float* gate = (float*)(route_pos + MT * 4);
    for (int i = tid; i < DM * NE; i += 512) WT[(i & 31) * WTS + (i >> 5)] = a.w_router[i];
    if (tid < 32) lcnt[tid] = 0;
    for (int blk = blockIdx.x; blk < MT / 64; blk += gridDim.x) {
        const int b = blk / 32;
        __syncthreads();
        for (int j = tid; j < DM; j += 512) { GT1[j] = mod_at(a, b, 2048 + j) * a.g_post_mix[j]; A2[j] = a.g_pre_ffn[j] * (1.f + mod_at(a, b, 4096 + j)); B2[j] = mod_at(a, b, 3072 + j); }
        __syncthreads();
#pragma unroll 1
        for (int it = 0; it < 4; ++it) {
            const int rA = wave + 16 * it, rB = rA + 8;
            const int ln = fresh_lane();
            f32x4 xa[4], xb[4];
            p6_front(a, mix, hb8, GT1, A2, B2, blk * 64 + rA, ln, xa);
            p6_front(a, mix, hb8, GT1, A2, B2, blk * 64 + rB, ln, xb);
            float pa[32], pb[32];
#pragma unroll
            for (int e = 0; e < 32; ++e) { f32x2v accA = (f32x2v){0.f, 0.f}, accB = (f32x2v){0.f, 0.f};
#pragma unroll
                for (int j = 0; j < 4; ++j) { const f32x4 wv = *(const LAS f32x4*)(WT + e * WTS + 4 * ln + 256 * j);
                    const f32x2v w01 = (f32x2v){wv[0], wv[1]}, w23 = (f32x2v){wv[2], wv[3]};
                    accA = __builtin_elementwise_fma((f32x2v){xa[j][0], xa[j][1]}, w01, accA); accA = __builtin_elementwise_fma((f32x2v){xa[j][2], xa[j][3]}, w23, accA);
                    accB = __builtin_elementwise_fma((f32x2v){xb[j][0], xb[j][1]}, w01, accB); accB = __builtin_elementwise_fma((f32x2v){xb[j][2], xb[j][3]}, w23, accB); }
                pa[e] = accA.x + accA.y; pb[e] = accB.x + accB.y; if ((e & 3) == 3) __builtin_amdgcn_sched_barrier(0); }
#pragma unroll 1
            for (int rr = 0; rr < 2; ++rr) {
                const int ln2 = fresh_lane();
                p6_route(a, pa, lcnt, info, rr ? rB : rA, ln2);
#pragma unroll
                for (int e = 0; e < 32; ++e) pa[e] = pb[e];
            }
        }
        __syncthreads();
        if (tid < 32) lbase[tid] = atomicAdd(cnt + CNT_STRIDE * tid, lcnt[tid]);
        __syncthreads();
        if (tid < 256) { const int e = info[tid * 3 + 0], p = lbase[e] + info[tid * 3 + 1]; const int row = blk * 64 + (tid >> 2);
            list[e * MT + p] = row; route_e[row * 4 + (tid & 3)] = e; route_pos[row * 4 + (tid & 3)] = p; gate[row * 4 + (tid & 3)] = __builtin_bit_cast(float, info[tid * 3 + 2]); }
        __syncthreads();
        if (tid < 32) lcnt[tid] = 0;
    }
}

__device__ __forceinline__ void p9_rows(const Args& a, LAS unsigned char* lds, const LAS int* ts, int tid, int wave, int lane) {
    LAS float* GT2 = (LAS float*)lds;
    unsigned char* ws = a.ws;
    const unsigned char* yb = ws + WS_YB;
    const int* route_e = (const int*)(ws + WS_ROUTE); const int* route_pos = route_e + MT * 4; const float* gate = (const float*)(route_pos + MT * 4);
    for (int blk = blockIdx.x; blk < MT / 64; blk += gridDim.x) {
        const int b = blk / 32;
        __syncthreads();
        for (int j = tid; j < DM; j += 512) GT2[j] = mod_at(a, b, 5120 + j) * a.g_post_ffn[j];
        __syncthreads();
#pragma unroll 1
        for (int r0 = wave; r0 < 64; r0 += 16) {
            i32x4 re[2], rp[2]; f32x4 gg[2];
#pragma unroll
            for (int q = 0; q < 2; ++q) { const int row = blk * 64 + r0 + 8 * q; re[q] = *(const i32x4*)(route_e + row * 4); rp[q] = *(const i32x4*)(route_pos + row * 4); gg[q] = *(const f32x4*)(gate + row * 4); }
            int yv[2][4][4]; f32x4 xo[2][4];
#pragma unroll
            for (int q = 0; q < 2; ++q) { const int row = blk * 64 + r0 + 8 * q;
#pragma unroll
                for (int k = 0; k < 4; ++k) { const int slot = ts[re[q][k]] * 256 + rp[q][k]; const int* yr = (const int*)(yb + (size_t)slot * FE) + lane;
#pragma unroll
                    for (int j = 0; j < 4; ++j) yv[q][k][j] = __builtin_nontemporal_load(yr + 64 * j); }
                const f32x4* orow = (const f32x4*)(a.out + (size_t)row * DM) + lane;
#pragma unroll
                for (int j = 0; j < 4; ++j) xo[q][j] = __builtin_nontemporal_load(orow + 64 * j); }
#pragma unroll
            for (int q = 0; q < 2; ++q) { const int row = blk * 64 + r0 + 8 * q;
                f32x4 f[4];
#pragma unroll
                for (int j = 0; j < 4; ++j) f[j] = (f32x4){0.f, 0.f, 0.f, 0.f};
#pragma unroll
                for (int k = 0; k < 4; ++k) { const float g = gg[q][k];
#pragma unroll
                    for (int j = 0; j < 4; ++j) { const int w = yv[q][k][j]; const f32x2v lo = __builtin_amdgcn_cvt_pk_f32_fp8(w, false), hi2 = __builtin_amdgcn_cvt_pk_f32_fp8(w, true); f[j] += (f32x4){lo.x, lo.y, hi2.x, hi2.y} * g; } }
                float ss = 0.f;
#pragma unroll
                for (int j = 0; j < 4; ++j) ss += (f[j][0] * f[j][0] + f[j][1] * f[j][1]) + (f[j][2] * f[j][2] + f[j][3] * f[j][3]);
                const float rstd = rsqrtf(wave_sum(ss) * (1.f / DM) + EPS);
                f32x4* orow = (f32x4*)(a.out + (size_t)row * DM) + lane;
#pragma unroll
                for (int j = 0; j < 4; ++j) { const f32x4 g2 = *(const LAS f32x4*)(GT2 + 4 * lane + 256 * j); __builtin_nontemporal_store(xo[q][j] + g2 * (f[j] * rstd), orow + 64 * j); }
            }
        }
    }
}

#define XB_TMO      128
#define XB_XCNT(j)  (256  + 64 * (j))
#define XB_XSUB(j)  (1280 + 64 * (j))
#define XB_XGEN(j)  (2304 + 64 * (j))
#define XB_TOP      3328
#define XB_TOPGEN   3392
#define XCD_BAR_WORDS 3456
#define XB_SPIN_CAP (1u << 22)
__device__ __forceinline__ unsigned xb_ld(unsigned* p)              { return __hip_atomic_load(p, __ATOMIC_RELAXED, __HIP_MEMORY_SCOPE_AGENT); }
__device__ __forceinline__ unsigned xb_add(unsigned* p, unsigned v) { return __hip_atomic_fetch_add(p, v, __ATOMIC_RELAXED, __HIP_MEMORY_SCOPE_AGENT); }
__device__ __forceinline__ unsigned xb_xcc_id() { return (unsigned)__builtin_amdgcn_s_getreg((3 << 11) | 20) & 0xFu; }
#define XB_SPIN(cond, bar) do { unsigned _sp = 0; while (cond) { __builtin_amdgcn_s_sleep(1); \
    if ((++_sp & 255u) == 0u) { if (xb_ld(&(bar)[XB_TMO])) break; if (_sp > XB_SPIN_CAP) { atomicAdd(&(bar)[XB_TMO], 1u); break; } } } } while (0)
struct XcdBarrier { unsigned* bar; unsigned x; volatile LAS unsigned* st; };
__device__ __forceinline__ void xcd_barrier_complete(unsigned* bar, unsigned x, unsigned& nloc, unsigned& nx) {
    const unsigned G = gridDim.x;
    unsigned sum, cnt, mine, sp = 0u;
    for (;;) {
        sum = 0u; cnt = 0u; mine = 0u;
#pragma unroll
        for (unsigned j = 0; j < 16; ++j) { const unsigned c = xb_ld(&bar[XB_XCNT(j)]); sum += c; cnt += (c > 0u) ? 1u : 0u; mine = (j == x) ? c : mine; }
        if (sum == G) break;
        __builtin_amdgcn_s_sleep(1);
        if ((++sp & 255u) == 0u) { if (xb_ld(&bar[XB_TMO])) break; if (sp > XB_SPIN_CAP) { atomicAdd(&bar[XB_TMO], 1u); break; } }
    }
    nloc = mine > 0u ? mine : 1u; nx = cnt > 0u ? cnt : 1u;
}
__device__ __forceinline__ void xcd_barrier(const XcdBarrier& b, bool leader_thread) {
    asm volatile("s_waitcnt vmcnt(0)" ::: "memory");
    __syncthreads();
    if (leader_thread) {
        unsigned* bar = b.bar;
        __builtin_amdgcn_s_waitcnt(0);
        unsigned nloc = b.st[0], nx = b.st[1];
        if (nloc == 0u) { xcd_barrier_complete(bar, b.x, nloc, nx); b.st[0] = nloc; b.st[1] = nx; }
        const unsigned old = xb_add(&bar[XB_XSUB(b.x)], 1u);
        const unsigned gen = old / nloc;
        if (old + 1u == (gen + 1u) * nloc) {
            __builtin_amdgcn_fence(__ATOMIC_RELEASE, "agent");
            asm volatile("s_waitcnt vmcnt(0)" ::: "memory");
            const unsigned og = xb_add(&bar[XB_TOP], 1u);
            const unsigned tg = og / nx;
            if (og + 1u == (tg + 1u) * nx) xb_add(&bar[XB_TOPGEN], 1u);
            else XB_SPIN(xb_ld(&bar[XB_TOPGEN]) == tg, bar);
            __builtin_amdgcn_fence(__ATOMIC_ACQUIRE, "agent");
            xb_add(&bar[XB_XGEN(b.x)], 1u);
            asm volatile("s_waitcnt vmcnt(0)" ::: "memory");
        } else {
            XB_SPIN(xb_ld(&bar[XB_XGEN(b.x)]) == gen, bar);
            __builtin_amdgcn_fence(__ATOMIC_ACQUIRE, "agent");
            asm volatile("s_waitcnt vmcnt(0)" ::: "memory");
        }
    }
    __syncthreads();
}

constexpr int N_PHASES = 10;
constexpr int CONV_EARLY = 5376;
__global__ void __launch_bounds__(512, 2) mk_fwd(Args a) {
    extern __shared__ __attribute__((aligned(16))) unsigned char lds_raw[];
    LAS unsigned char* lds = (LAS unsigned char*)lds_raw;
    const int wave = __builtin_amdgcn_readfirstlane(threadIdx.x >> 6);
    int lane, tid;
#define FRESH() do { lane = fresh_lane(); tid = wave * 64 + lane; } while (0)
    unsigned char* ws = a.ws;
    LAS int* ts = (LAS int*)(lds + LDS_CTRL);
    LAS int* cnts = ts + 40;
    const int lo = a.ph_lo, hi = a.ph_hi;
#ifndef PHASE_MASK
#define PHASE_MASK 0xFFFF
#endif
#define IN(k) (((PHASE_MASK >> (k)) & 1) && lo <= (k) && (k) < hi)
#define SEAM(k) do { if (IN(k) && IN((k) + 1)) { FRESH(); xcd_barrier(xb, tid == 0); } } while (0)
    XcdBarrier xb; xb.bar = (unsigned*)(ws + WS_CTL) + CW_BAR; xb.x = xb_xcc_id(); xb.st = (volatile LAS unsigned*)(lds + LDS_CTRL + 320);
    if (hi - lo > 1) {
        if (threadIdx.x == 0) { xb.st[0] = 0u; xb.st[1] = 0u; (void)xb_add(&xb.bar[XB_XCNT(xb.x)], 1u); }
        __syncthreads();
    }

    if (IN(0)) { FRESH(); p0_prologue(a, lds, tid, wave, lane); }
    SEAM(0);
    if (IN(1)) { FRESH(); p1_rows(a, lds, tid, wave, lane); }
    SEAM(1);
    if (IN(2)) {
        pg8::StaticOrder S; S.init(MT, NPROJ, gridDim.x, blockIdx.x, ws + WS_WIN, 2048);
        float* rcos = (float*)(ws + WS_ROPE);
        pg8::EpiInProj E{(bf16_t*)(ws + WS_PROJ), (float*)(ws + WS_SSQ), (float*)(ws + WS_SSQ) + MT * 4, (bf16_t*)(ws + WS_KM), (bf16_t*)(ws + WS_VTD), rcos, rcos + (size_t)MT * 16};
        __syncthreads();
        pg8::gemm_phase<pg8::EpiInProj, pg8::StaticOrder, true>(lds, ws + WS_HB, 2048, 2048, S, E, wave);
        if (gridDim.x == 256 && blockIdx.x >= 128) { __syncthreads(); FRESH(); moe_weights_phase(a, lds, wave, lane, 0, CONV_EARLY, (blockIdx.x - 128) * 8 + wave, 128 * 8); }
        else if (gridDim.x != 256 && blockIdx.x == 0) { __syncthreads(); FRESH(); moe_weights_phase(a, lds, wave, lane, 0, CONV_EARLY, wave, 8); }
    }
    SEAM(2);
    if (IN(3)) {
        float* rcos = (float*)(ws + WS_ROPE);
        __syncthreads();
#ifndef SUB3
#define SUB3 7
#endif
        if (SUB3 & 1) { pg8::StaticOrder S; S.init(MT, 768, gridDim.x, blockIdx.x, ws + WS_WQB, 512);
          pg8::EpiQb E{(bf16_t*)(ws + WS_QM), (const float*)(ws + WS_SSQ), rcos, rcos + (size_t)MT * 16, 0.10206207261596575f * LOG2E};
          pg8::gemm_phase<pg8::EpiQb, pg8::StaticOrder, true>(lds, (const bf16_t*)(ws + WS_PROJ) + PC_CQ, NPROJ * 2, 512, S, E, wave); }
        __syncthreads();
        if (SUB3 & 2) { pg8::StaticOrder S; S.init(MT, 1024, gridDim.x, blockIdx.x, ws + WS_WKVB, 512);
          pg8::EpiKvb E{(bf16_t*)(ws + WS_KM), (bf16_t*)(ws + WS_VTM), (const float*)(ws + WS_SSQ) + MT * 4};
          pg8::gemm_phase<pg8::EpiKvb, pg8::StaticOrder, true>(lds, (const bf16_t*)(ws + WS_PROJ) + PC_CKV, NPROJ * 2, 512, S, E, wave); }
        __syncthreads();
        FRESH();
        if (SUB3 & 4) for (int v = blockIdx.x; v < 256; v += gridDim.x) {
            const int b = v & 7, aa = v >> 3;
#pragma unroll 1
            for (int i = 0; i < 4; ++i) { const int tg = (i & 1) ? (32 * i + 31 - aa) : (32 * i + aa);
                idx_item(lds, (const bf16_t*)(ws + WS_PROJ), (unsigned*)(ws + WS_BITMAP), b, tg, wave, lane); }
        }
    }
    SEAM(3);
    if (IN(4)) {
        __syncthreads(); FRESH();
        for (int v0_ = blockIdx.x; v0_ < 256; v0_ += gridDim.x) {
            const int v = (gridDim.x == 256) ? ((v0_ & 7) * 32 + (v0_ >> 3)) : v0_;
            const int bh = v >> 2, b = bh >> 3, h = bh & 7, s = v & 3;
#pragma unroll 1
            for (int i = 0; i < 2; ++i) { const int qt = i ? 7 - s : s; FRESH();
                attn_unit<96, false>(lds, b, qt, (const bf16_t*)(ws + WS_QM) + h * 96, 768, (const bf16_t*)(ws + WS_KM) + h * 96, 768,
                                     (const bf16_t*)(ws + WS_VTM) + (size_t)(b * 8 + h) * 64 * SEQ, (unsigned char*)(ws + WS_Y) + h * 64, nullptr, nullptr, 0.f, 0.f, tid, wave, lane); }
#pragma unroll 1
            for (int i = 0; i < 2; ++i) { const int qt = i ? 7 - s : s; const int kvh = h >> 2; FRESH();
                attn_unit<64, true>(lds, b, qt, (const bf16_t*)(ws + WS_PROJ) + PC_QD + h * 64, NPROJ, (const bf16_t*)(ws + WS_PROJ) + PC_KD + kvh * 64, NPROJ,
                                    (const bf16_t*)(ws + WS_VTD) + (size_t)(b * 2 + kvh) * 64 * SEQ, (unsigned char*)(ws + WS_Y) + 512 + h * 64, (const unsigned*)(ws + WS_BITMAP), a.pos,
                                    0.125f * LOG2E, exp2f(-(float)(h + 1)) * LOG2E, tid, wave, lane); }
        }
    }
    SEAM(4);
    if (IN(5)) {
        pg8::StaticOrder S; S.init(MT, DM, gridDim.x, blockIdx.x, ws + WS_WO, 1024);
        pg8::EpiPlain E{(bf16_t*)(ws + WS_MIX), DM, 1.f / 64.f};
        __syncthreads();
        pg8::gemm_phase<pg8::EpiPlain, pg8::StaticOrder, true, true>(lds, ws + WS_Y, 1024, 1024, S, E, wave);
    }
    SEAM(5);
    if (IN(6)) { __syncthreads(); FRESH(); p6_rows(a, lds, tid, wave, lane); __syncthreads(); FRESH(); moe_weights_phase(a, lds, wave, lane, CONV_EARLY, 32 * 16 * 96, blockIdx.x * 8 + wave, gridDim.x * 8); }
    SEAM(6);
    if (IN(7) || IN(8) || IN(9)) {
        __syncthreads(); FRESH();
        if (tid == 0) { const int* cnt = (const int*)(ws + WS_CTL) + CW_CNT; int acc = 0;
            for (int e = 0; e < 32; ++e) { const int c = cnt[CNT_STRIDE * e]; ts[e] = acc; cnts[e] = c; acc += (c + 255) >> 8; }
            ts[32] = acc; }
        __syncthreads();
    }
    if (IN(7)) {
        pg8::MoeOrder<true> S; S.init(ts, cnts, (const int*)(ws + WS_LIST), ws + WS_W1T, 2048, 1024, 8, gridDim.x, blockIdx.x);
        pg8::EpiMoe1 E{ws + WS_ACT, a.b_mlp1};
        pg8::gemm_phase<pg8::EpiMoe1, pg8::MoeOrder<true>, true, true>(lds, ws + WS_HB, 1024, 1024, S, E, wave);
    }
    SEAM(7);
    if (IN(8)) {
        pg8::MoeOrder<false> S; S.init(ts, cnts, (const int*)(ws + WS_LIST), ws + WS_W2T, 1024, 1024, 4, gridDim.x, blockIdx.x);
        pg8::EpiMoe2 E{ws + WS_YB, a.b_mlp2};
        __syncthreads();
        pg8::gemm_phase<pg8::EpiMoe2, pg8::MoeOrder<false>, true, true>(lds, ws + WS_ACT, 1024, 1024, S, E, wave);
    }
    SEAM(8);
    if (IN(9)) { __syncthreads(); FRESH(); p9_rows(a, lds, ts, tid, wave, lane); }
#undef IN
#undef SEAM
}

extern "C" void kernel_launch(void* const* d_in, const int* in_sizes, int n_in, void* d_out, int out_size, void* d_ws, size_t ws_size, hipStream_t stream) {
    static int grid = 0;
    if (grid == 0) {
        if (n_in != 21 || out_size != MT * DM || ws_size < WS_END) { fprintf(stderr, "kernel_launch: unexpected shapes (n_in %d out %d ws %zu)\n", n_in, out_size, ws_size); grid = -1; return; }
        int dev = 0, cus = 0, per_cu = 0;
        hipGetDevice(&dev); hipDeviceGetAttribute(&cus, hipDeviceAttributeMultiprocessorCount, dev);
        if (hipFuncSetAttribute((const void*)mk_fwd, hipFuncAttributeMaxDynamicSharedMemorySize, LDS_BYTES) != hipSuccess) { fprintf(stderr, "kernel_launch: hipFuncSetAttribute failed\n"); grid = -1; return; }
        if (hipOccupancyMaxActiveBlocksPerMultiprocessor(&per_cu, (const void*)mk_fwd, 512, LDS_BYTES) != hipSuccess || per_cu < 1) { fprintf(stderr, "kernel_launch: occupancy query says %d\n", per_cu); per_cu = 1; }
        (void)hipGetLastError();
        grid = cus;
    }
    if (grid < 0) return;
    hipMemsetAsync((char*)d_ws + WS_CTL, 0, CTL_BYTES, stream);
    Args a{};
    a.x = (const float*)d_in[0]; a.c = (const float*)d_in[1]; a.pos = (const int*)d_in[2]; a.w_ada = (const float*)d_in[3]; a.b_ada = (const float*)d_in[4];
    a.g_pre_mix = (const float*)d_in[5]; a.g_post_mix = (const float*)d_in[6]; a.g_pre_ffn = (const float*)d_in[7]; a.g_post_ffn = (const float*)d_in[8];
    a.w_in = (const float*)d_in[9]; a.g_q_a = (const float*)d_in[10]; a.g_kv_a = (const float*)d_in[11]; a.w_q_b = (const float*)d_in[12]; a.w_kv_b = (const float*)d_in[13]; a.w_o = (const float*)d_in[14];
    a.w_router = (const float*)d_in[15]; a.b_router = (const float*)d_in[16]; a.w_mlp1 = (const float*)d_in[17]; a.b_mlp1 = (const float*)d_in[18]; a.w_mlp2 = (const float*)d_in[19]; a.b_mlp2 = (const float*)d_in[20];
    a.out = (float*)d_out; a.ws = (unsigned char*)d_ws;
#if MK_N_LAUNCHES == 1
    a.ph_lo = 0; a.ph_hi = N_PHASES;
    hipLaunchKernelGGL(mk_fwd, dim3(grid), dim3(512), LDS_BYTES, stream, a);
#else
    for (int p = 0; p < N_PHASES; ++p) { a.ph_lo = p; a.ph_hi = p + 1; hipLaunchKernelGGL(mk_fwd, dim3(grid), dim3(512), LDS_BYTES, stream, a); }
#endif
}
```

```cpp
#include <hip/hip_runtime.h>
#include <cstdio>
#include <cstdint>

#ifndef MK_N_LAUNCHES
#define MK_N_LAUNCHES 1
#endif

#define LAS __attribute__((address_space(3)))
typedef unsigned short bf16_t;
typedef short bf16x8 __attribute__((ext_vector_type(8)));
typedef float f32x4 __attribute__((ext_vector_type(4)));
typedef float f32x16 __attribute__((ext_vector_type(16)));
typedef unsigned u32x4 __attribute__((ext_vector_type(4)));
typedef unsigned u32x2 __attribute__((ext_vector_type(2)));
typedef int i32x4 __attribute__((ext_vector_type(4)));
typedef int i32x8 __attribute__((ext_vector_type(8)));

constexpr int NB = 8, SEQ = 2048, DM = 1024, MT = NB * SEQ;
constexpr int NE = 32, FE = 1024;
constexpr int NPROJ = 1536;
constexpr int PC_CQ = 0, PC_CKV = 256, PC_KROPE = 384, PC_KIDX = 416, PC_WIDX = 448, PC_QD = 512, PC_KD = 1024, PC_VD = 1152, PC_QIDX = 1280;
constexpr float EPS = 1e-6f;
constexpr float LOG2E = 1.4426950408889634f;
constexpr int MAXTILES = 288;
constexpr int NSLOT = MAXTILES * 256;

constexpr size_t MiB = 1u << 20;
constexpr size_t WS_CTL = 0, CTL_BYTES = 64 * 1024;
constexpr size_t WS_MODP = 1 * MiB;
constexpr size_t WS_ROPE = 3 * MiB;
constexpr size_t WS_SSQ = 5 * MiB;
constexpr size_t WS_ROUTE = 6 * MiB;
constexpr size_t WS_LIST = 7 * MiB;
constexpr size_t WS_WIN = 9 * MiB;
constexpr size_t WS_WQB = 12 * MiB;
constexpr size_t WS_WKVB = 13 * MiB;
constexpr size_t WS_WO = 14 * MiB;
constexpr size_t WS_BITMAP = 16 * MiB;
constexpr size_t WS_VTM = 20 * MiB;
constexpr size_t WS_VTD = 36 * MiB;
constexpr size_t WS_HB = 40 * MiB;
constexpr size_t WS_PROJ = 72 * MiB;
constexpr size_t WS_QM = 120 * MiB;
constexpr size_t WS_KM = 144 * MiB;
constexpr size_t WS_Y = 168 * MiB;
constexpr size_t WS_MIX = 200 * MiB;
constexpr size_t WS_W1T = 232 * MiB;
constexpr size_t WS_W2T = 360 * MiB;
constexpr size_t WS_ACT = 424 * MiB;
constexpr size_t WS_YB = 568 * MiB;
constexpr size_t WS_END = 712 * MiB;
constexpr int CW_CNT = 64, CNT_STRIDE = 64;
constexpr int CW_BAR = 8192;

constexpr int LDS_BYTES = 163840;
constexpr int LDS_CTRL = 163328;

__device__ __forceinline__ unsigned f2bf(float f) { unsigned u = __builtin_bit_cast(unsigned, f); return (u + 0x7fffu + ((u >> 16) & 1u)) >> 16; }
__device__ __forceinline__ unsigned pk2(float lo, float hi) { return f2bf(lo) | (f2bf(hi) << 16); }
__device__ __forceinline__ float bflo(unsigned u) { return __builtin_bit_cast(float, u << 16); }
__device__ __forceinline__ float bfhi(unsigned u) { return __builtin_bit_cast(float, u & 0xffff0000u); }
__device__ __forceinline__ float wave_sum(float v) {
#pragma unroll
    for (int o = 1; o < 64; o <<= 1) v += __shfl_xor(v, o);
    return v;
}
#define LDS_WAIT() asm volatile("s_waitcnt lgkmcnt(0)" ::: "memory")
__device__ __forceinline__ int fresh_lane() { int l = __builtin_amdgcn_mbcnt_hi(~0u, __builtin_amdgcn_mbcnt_lo(~0u, 0u)); asm volatile("" : "+v"(l)); return l; }

namespace pg8 {
constexpr int BM = 256, BK = 64, HALF = 128, HTB = HALF * BK * 2, STAGE_BYTES = 8 * HTB, NXCD = 8, WGM = 8;
__host__ __device__ __forceinline__ int lds_byte(int r, int c) { const int st = (r >> 4) * 2 + (c >> 5), rr = r & 15, cc = c & 31, ob = rr * 64 + cc * 2; return st * 1024 + (ob ^ (((ob >> 9) & 1) << 5)); }
__host__ __device__ __forceinline__ void stage_rc(int b, int& R, int& C) { const int st = b / 1024, sb = b % 1024, swz = sb ^ (((sb >> 9) & 1) << 5); R = (st >> 1) * 16 + swz / 64; C = (st & 1) * 32 + (swz % 64) / 2; }
__host__ __device__ __forceinline__ int perm32(int rho) { const int n = rho >> 4, i = rho & 15; return 8 * (i >> 2) + 4 * n + (i & 3); }

struct Unit { int pm, pn, e, mt; };

struct StaticOrder {
    static constexpr bool GATHER = false;
    int nM, nN, nwg, G, c; const char* Bt; int ldb;
    __device__ void init(int M, int N, int G_, int c_, const void* Bt_, int ldb_bytes) { nM = M / BM; nN = N / BM; nwg = nM * nN; G = G_; c = c_; Bt = (const char*)Bt_; ldb = ldb_bytes; }
    __device__ bool next(int i, Unit& u, int ehint = 0) const {
        const long L = (long)i * G + c; if (L >= nwg) return false;
        int wgid = (int)L; { const int q = nwg / NXCD, r = nwg % NXCD, xcd = wgid % NXCD, off = wgid / NXCD; wgid = (xcd < r ? xcd * (q + 1) : r * (q + 1) + (xcd - r) * q) + off; }
        const int nig = WGM * nN, gid = wgid / nig, fm = gid * WGM, gsz = (nM - fm) < WGM ? (nM - fm) : WGM;
        u.pm = fm + ((wgid % nig) % gsz); u.pn = (wgid % nig) / gsz; u.e = 0; u.mt = 0; return true;
    }
    __device__ __forceinline__ const char* bptr(const Unit& u) const { return Bt + (size_t)u.pn * BM * ldb; }
    __device__ __forceinline__ int arow(const Unit& u, int r) const { return u.pm * BM + r; }
};

template <bool GATHER_> struct MoeOrder {
    static constexpr bool GATHER = GATHER_;
    const LAS int* ts;
    const LAS int* cnts;
    const int* list;
    const char* Bt; int nrows_b  , ldb  , nN, G, c, nwg;
    __device__ void init(const LAS int* ts_, const LAS int* cnts_, const int* list_, const void* Bt_, int nrows_b_, int ldb_, int nN_, int G_, int c_) {
        ts = ts_; cnts = cnts_; list = list_; Bt = (const char*)Bt_; nrows_b = nrows_b_; ldb = ldb_; nN = nN_; G = G_; c = c_; nwg = __builtin_amdgcn_readfirstlane(ts_[32]) * nN_; }
    __device__ bool next(int i, Unit& u, int ehint = 0) const {
        const long L = (long)i * G + c; if (L >= nwg) return false;
        int wgid = (int)L; { const int q = nwg / NXCD, r = nwg % NXCD, xcd = wgid % NXCD, off = wgid / NXCD; wgid = (xcd < r ? xcd * (q + 1) : r * (q + 1) + (xcd - r) * q) + off; }
        int e = ehint;
        while (e < 31 && __builtin_amdgcn_readfirstlane(ts[e + 1]) * nN <= wgid) ++e;
        const int t0 = __builtin_amdgcn_readfirstlane(ts[e]), T = __builtin_amdgcn_readfirstlane(ts[e + 1]) - t0, local = wgid - t0 * nN;
        u.e = e; u.pn = local / T; u.mt = local % T; u.pm = t0 + u.mt; return true;
    }
    __device__ __forceinline__ const char* bptr(const Unit& u) const { return Bt + ((size_t)u.e * nrows_b + (size_t)u.pn * BM) * ldb; }
    __device__ __forceinline__ int arow(const Unit& u, int r) const {
        if (!GATHER) return u.pm * BM + r;
        const int p = u.mt * BM + r; return (p < cnts[u.e]) ? list[u.e * MT + p] : 0;
    }
};

__device__ __forceinline__ unsigned cvt_pk_bf16(float lo, float hi) { unsigned r; asm volatile("v_cvt_pk_bf16_f32 %0, %1, %2" : "=v"(r) : "v"(lo), "v"(hi)); return r; }
__device__ __forceinline__ u32x4 pack8(const f32x4& a, const f32x4& b) { u32x4 w; w.x = cvt_pk_bf16(a[0], a[1]); w.y = cvt_pk_bf16(a[2], a[3]); w.z = cvt_pk_bf16(b[0], b[1]); w.w = cvt_pk_bf16(b[2], b[3]); return w; }

template <class Epi, class Sched, bool ALIGN_EPI, bool FP8 = false>
__device__ __forceinline__ void gemm_phase(LAS unsigned char* lds, const void* A, int lda, int kbytes, const Sched& S, const Epi& E, int wid) {
    const int lane = fresh_lane(), tid = wid * 64 + lane, wr = wid >> 2, wc = wid & 3, fr = lane & 15, fq = lane >> 4;
    const int nt = kbytes / 128; const int ldb = S.ldb;
    constexpr bool GA = Sched::GATHER;
    unsigned voffB[2], voffA[2]; int RA[2]; unsigned CA[2];
#pragma unroll
    for (int i = 0; i < 2; ++i) { int R, C; stage_rc(tid * 16 + i * 8192, R, C); const int Rb = (R & ~31) + perm32(R & 31);
        RA[i] = R; CA[i] = (unsigned)C * 2u; voffA[i] = (unsigned)(R * lda) + (unsigned)C * 2u; voffB[i] = (unsigned)(Rb * ldb) + (unsigned)C * 2u; }
    const size_t hstepA = (size_t)HALF * lda;
    const size_t kstep = (size_t)(BK * 2);
    const size_t hstepB = (size_t)HALF * ldb;
    const unsigned ldsw = (unsigned)wid * 1024u;
    const int aoff = lds_byte(wr * 64 + fr, fq * 8), boff = lds_byte(wc * 32 + fr, fq * 8);
#define PG8_SA(b, h) (((b) * 2 + (h)) * HTB)
#define PG8_SB(b, h) ((4 + (b) * 2 + (h)) * HTB)
#define PG8_STAGE(bufoff, gbase, voff) do { _Pragma("unroll") for (int _i = 0; _i < 2; ++_i) \
        __builtin_amdgcn_global_load_lds((const unsigned*)((const char*)(gbase) + (voff)[_i]), (LAS unsigned*)(lds + (bufoff) + ldsw + _i * 8192), 16, 0, 0); } while (0)
#define PG8_LDA(dst, b, h) do { _Pragma("unroll") for (int m = 0; m < 4; ++m) _Pragma("unroll") for (int k = 0; k < 2; ++k) dst[m][k] = *(const LAS bf16x8*)(lds + PG8_SA(b, h) + aoff + m * 2048 + k * 1024); } while (0)
#define PG8_LDB(dst, b, h) do { _Pragma("unroll") for (int n = 0; n < 2; ++n) _Pragma("unroll") for (int k = 0; k < 2; ++k) dst[n][k] = *(const LAS bf16x8*)(lds + PG8_SB(b, h) + boff + n * 2048 + k * 1024); } while (0)
#define PG8_MMA(ai, bj, At, Bt) do { __builtin_amdgcn_s_setprio(1); \
        if constexpr (FP8) { _Pragma("unroll") for (int m = 0; m < 4; ++m) _Pragma("unroll") for (int n = 0; n < 2; ++n) { \
            const i32x8 bb_ = __builtin_shufflevector(__builtin_bit_cast(i32x4, Bt[n][0]), __builtin_bit_cast(i32x4, Bt[n][1]), 0, 1, 2, 3, 4, 5, 6, 7); \
            const i32x8 aa_ = __builtin_shufflevector(__builtin_bit_cast(i32x4, At[m][0]), __builtin_bit_cast(i32x4, At[m][1]), 0, 1, 2, 3, 4, 5, 6, 7); \
            asm volatile("v_mfma_scale_f32_16x16x128_f8f6f4 %0, %1, %2, %0, %3, %3 op_sel_hi:[0,0,0]" : "+v"(acc[ai][bj][m][n]) : "v"(bb_), "v"(aa_), "v"(sc1_)); } } \
        else { _Pragma("unroll") for (int m = 0; m < 4; ++m) _Pragma("unroll") for (int n = 0; n < 2; ++n) _Pragma("unroll") for (int k = 0; k < 2; ++k) \
            acc[ai][bj][m][n] = __builtin_amdgcn_mfma_f32_16x16x32_bf16(Bt[n][k], At[m][k], acc[ai][bj][m][n], 0, 0, 0); } \
        __builtin_amdgcn_s_setprio(0); } while (0)
#define PG8_WAIT_V(n) asm volatile("s_waitcnt vmcnt(" #n ")" ::: "memory")
#define PG8_WAIT_L(n) asm volatile("s_waitcnt lgkmcnt(" #n ")" ::: "memory")
#define PG8_BAR __builtin_amdgcn_s_barrier()
#define PG8_SCHED __builtin_amdgcn_sched_barrier(0)
#define PG8_STA(bufoff, nx, h, kb) do { if constexpr (GA) { unsigned _w[2]; _Pragma("unroll") for (int _i = 0; _i < 2; ++_i) _w[_i] = (nx) ? vN[h][_i] : vA[h][_i]; PG8_STAGE(bufoff, Ab + (kb), _w); } \
        else { PG8_STAGE(bufoff, ((nx) ? nA : cA) + (h) * hstepA + (kb), voffA); } } while (0)
#define PG8_AOFF(dst, u) do { _Pragma("unroll") for (int _h = 0; _h < 2; ++_h) _Pragma("unroll") for (int _i = 0; _i < 2; ++_i) \
        dst[_h][_i] = (unsigned)S.arow(u, _h * HALF + RA[_i]) * (unsigned)lda + CA[_i]; } while (0)
#define PG8_AROW(dst, u) do { _Pragma("unroll") for (int _h = 0; _h < 2; ++_h) _Pragma("unroll") for (int _i = 0; _i < 2; ++_i) \
        dst[_h][_i] = (unsigned)S.arow(u, _h * HALF + RA[_i]); } while (0)
    Unit cur, nxt; int ui = 0;
    if (!S.next(0, cur)) return;
    f32x4 acc[2][2][4][2];
#pragma unroll
    for (int a = 0; a < 2; ++a)
#pragma unroll
        for (int b = 0; b < 2; ++b)
#pragma unroll
            for (int m = 0; m < 4; ++m)
#pragma unroll
                for (int n = 0; n < 2; ++n) acc[a][b][m][n] = (f32x4){0.f, 0.f, 0.f, 0.f};
    bf16x8 At[4][2], B0[2][2], B1[2][2];
    int sc1_ = 0x7f7f7f7f; asm volatile("" : "+v"(sc1_));
    unsigned vA[2][2], vN[2][2];
    if constexpr (GA) { PG8_AOFF(vA, cur); }
    const char* Ab = (const char*)A;
    const char* cA = Ab + (size_t)S.arow(cur, 0) * lda; const char* nA = cA;
    const char* cB = S.bptr(cur);
    PG8_STAGE(PG8_SB(0, 0), cB, voffB); PG8_STAGE(PG8_SB(0, 1), cB + hstepB, voffB); PG8_STA(PG8_SA(0, 0), false, 0, 0); PG8_STA(PG8_SA(0, 1), false, 1, 0);
    if (wr == 1) PG8_BAR;
    PG8_WAIT_V(2); PG8_BAR;
    PG8_STAGE(PG8_SB(1, 0), cB + kstep, voffB); PG8_STA(PG8_SA(1, 0), false, 0, kstep); PG8_STAGE(PG8_SB(1, 1), cB + hstepB + kstep, voffB);
    PG8_WAIT_V(6); PG8_BAR;
    for (;;) {
        const bool has_next = S.next(ui + 1, nxt, cur.e);
        if constexpr (GA) { if (has_next) { PG8_AROW(vN, nxt); } else {
#pragma unroll
            for (int _h = 0; _h < 2; ++_h)
#pragma unroll
                for (int _i = 0; _i < 2; ++_i) vN[_h][_i] = vA[_h][_i]; } }
        else { nA = has_next ? Ab + (size_t)S.arow(nxt, 0) * lda : cA; }
        const char* nB = has_next ? S.bptr(nxt) : cB;
#pragma unroll 1
        for (int t = 0; t < nt; t += 2) {
            const bool last = (t == nt - 2);
            if constexpr (GA) { if (last && has_next) {
#pragma unroll
                for (int _h = 0; _h < 2; ++_h)
#pragma unroll
                    for (int _i = 0; _i < 2; ++_i) vN[_h][_i] = vN[_h][_i] * (unsigned)lda + CA[_i]; } }
            const size_t k1 = (size_t)(t + 1) * kstep, k2 = last ? 0 : (size_t)(t + 2) * kstep, k3 = k2 + kstep;
            const char* b2 = last ? nB : cB + (size_t)(t + 2) * kstep; const char* b3 = b2 + kstep;
            PG8_LDB(B0, 0, 0); PG8_LDB(B1, 0, 1); PG8_SCHED; PG8_LDA(At, 0, 0); PG8_STA(PG8_SA(1, 1), false, 1, k1);
            PG8_WAIT_V(8); PG8_WAIT_L(0); PG8_BAR; PG8_MMA(0, 0, At, B0); PG8_MMA(0, 1, At, B1); PG8_BAR; PG8_SCHED;
            PG8_LDA(At, 0, 1); PG8_STAGE(PG8_SB(0, 0), b2, voffB); PG8_STAGE(PG8_SB(0, 1), b2 + hstepB, voffB); PG8_STA(PG8_SA(0, 0), last, 0, k2);
            PG8_WAIT_V(8); PG8_WAIT_L(0); PG8_BAR; PG8_MMA(1, 0, At, B0); PG8_MMA(1, 1, At, B1); PG8_BAR; PG8_SCHED;
            PG8_LDB(B0, 1, 0); PG8_LDB(B1, 1, 1); PG8_SCHED; PG8_LDA(At, 1, 0); PG8_STA(PG8_SA(0, 1), last, 1, k2);
            PG8_WAIT_V(8); PG8_WAIT_L(0); PG8_BAR; PG8_MMA(0, 0, At, B0); PG8_MMA(0, 1, At, B1); PG8_BAR; PG8_SCHED;
            PG8_LDA(At, 1, 1); PG8_STAGE(PG8_SB(1, 0), b3, voffB); PG8_STAGE(PG8_SB(1, 1), b3 + hstepB, voffB); PG8_STA(PG8_SA(1, 0), last, 0, k3);
            PG8_WAIT_V(8); PG8_WAIT_L(0); PG8_BAR; PG8_MMA(1, 0, At, B0); PG8_MMA(1, 1, At, B1); PG8_BAR; PG8_SCHED;
        }
        if constexpr (ALIGN_EPI) { if (wr == 0) PG8_BAR; }
        if constexpr (FP8) asm volatile("s_nop 15\n\ts_nop 7" ::: "memory");
        E(acc, cur, wr, wc, fr, fq);
        if (!has_next) break;
#pragma unroll
        for (int a = 0; a < 2; ++a)
#pragma unroll
            for (int b = 0; b < 2; ++b)
#pragma unroll
                for (int m = 0; m < 4; ++m)
#pragma unroll
                    for (int n = 0; n < 2; ++n) acc[a][b][m][n] = (f32x4){0.f, 0.f, 0.f, 0.f};
        cur = nxt; cB = nB; cA = nA; ++ui;
        if constexpr (GA) {
#pragma unroll
        for (int _h = 0; _h < 2; ++_h)
#pragma unroll
            for (int _i = 0; _i < 2; ++_i) vA[_h][_i] = vN[_h][_i]; }
        if constexpr (ALIGN_EPI) { if (wr == 1) PG8_BAR; }
    }
    PG8_WAIT_V(0);
    if constexpr (!ALIGN_EPI) { if (wr == 0) PG8_BAR; }
    PG8_BAR;
#undef PG8_SA
#undef PG8_SB
#undef PG8_STAGE
#undef PG8_LDA
#undef PG8_LDB
#undef PG8_MMA
#undef PG8_WAIT_V
#undef PG8_WAIT_L
#undef PG8_BAR
#undef PG8_SCHED
#undef PG8_AOFF
#undef PG8_AROW
#undef PG8_STA
}

struct EpiPlain {
    bf16_t* O; int ldc; float scale;
    __device__ __forceinline__ void operator()(const f32x4 (&acc)[2][2][4][2], const Unit& u, int wr, int wc, int fr_, int fq_) const {
        int ln_ = __builtin_amdgcn_mbcnt_hi(~0u, __builtin_amdgcn_mbcnt_lo(~0u, 0u)); asm volatile("" : "+v"(ln_)); const int fr = ln_ & 15, fq = ln_ >> 4;
        const int row0 = u.pm * BM + wr * 64 + fr, col0 = u.pn * BM + wc * 32 + 8 * fq;
#pragma unroll
        for (int ai = 0; ai < 2; ++ai)
#pragma unroll
            for (int m = 0; m < 4; ++m) { bf16_t* rowp = O + (size_t)(row0 + ai * HALF + m * 16) * ldc + col0;
#pragma unroll
                for (int bj = 0; bj < 2; ++bj) *(u32x4*)(rowp + bj * HALF) = pack8(acc[ai][bj][m][0] * scale, acc[ai][bj][m][1] * scale); }
    }
};

struct EpiInProj {
    bf16_t* proj; float* ssq_q; float* ssq_kv; bf16_t* Km; bf16_t* Vtd; const float* rcos; const float* rsin;
    __device__ __forceinline__ void operator()(const f32x4 (&acc)[2][2][4][2], const Unit& u, int wr, int wc, int fr_, int fq_) const {
        int ln_ = __builtin_amdgcn_mbcnt_hi(~0u, __builtin_amdgcn_mbcnt_lo(~0u, 0u)); asm volatile("" : "+v"(ln_)); const int fr = ln_ & 15, fq = ln_ >> 4;
        const int row0 = u.pm * BM + wr * 64 + fr, col0 = u.pn * BM + wc * 32 + 8 * fq;
        const int pn = u.pn;
#pragma unroll
        for (int ai = 0; ai < 2; ++ai)
#pragma unroll
            for (int m = 0; m < 4; ++m) {
                const int row = row0 + ai * HALF + m * 16;
                bf16_t* rowp = proj + (size_t)row * NPROJ + col0;
                float sq = 0.f;
#pragma unroll
                for (int bj = 0; bj < 2; ++bj) {
                    const f32x4 v0 = acc[ai][bj][m][0], v1 = acc[ai][bj][m][1];
                    *(u32x4*)(rowp + bj * HALF) = pack8(v0, v1);
                    if (pn == 0 || (pn == 1 && bj == 0)) sq += (v0[0] * v0[0] + v0[1] * v0[1]) + (v0[2] * v0[2] + v0[3] * v0[3]) + (v1[0] * v1[0] + v1[1] * v1[1]) + (v1[2] * v1[2] + v1[3] * v1[3]);
                    if (pn == 1 && bj == 1 && wc == 0) {
                        const int i0 = 8 * (fq & 1);
                        const f32x4 c0 = *(const f32x4*)(rcos + (size_t)row * 16 + i0), c1 = *(const f32x4*)(rcos + (size_t)row * 16 + i0 + 4);
                        const f32x4 s0 = *(const f32x4*)(rsin + (size_t)row * 16 + i0), s1 = *(const f32x4*)(rsin + (size_t)row * 16 + i0 + 4);
                        f32x4 o0, o1; const float sg = (fq < 2) ? -1.f : 1.f;
#pragma unroll
                        for (int j = 0; j < 4; ++j) { const float p0 = __shfl_xor(v0[j], 32), p1 = __shfl_xor(v1[j], 32);
                            o0[j] = v0[j] * c0[j] + sg * p0 * s0[j]; o1[j] = v1[j] * c1[j] + sg * p1 * s1[j]; }
                        const u32x4 w = pack8(o0, o1);
#pragma unroll
                        for (int h = 0; h < 8; ++h) *(u32x4*)(Km + (size_t)row * 768 + h * 96 + 64 + 8 * fq) = w;
                    }
                    if (pn == 4 && bj == 1) {
                        const int b = row >> 11, s = row & 2047, cv0 = wc * 32 + 8 * fq;
#pragma unroll
                        for (int j = 0; j < 8; ++j) { const int cv = cv0 + j; const float val = (j < 4) ? v0[j & 3] : v1[j & 3];
                            Vtd[((size_t)(b * 2 + (cv >> 6)) * 64 + (cv & 63)) * SEQ + s] = (bf16_t)f2bf(val); }
                    }
                }
                if (pn <= 1) { sq += __shfl_xor(sq, 16); sq += __shfl_xor(sq, 32); if (fq == 0) (pn == 0 ? ssq_q : ssq_kv)[(size_t)row * 4 + wc] = sq; }
            }
    }
};

struct EpiQb {
    bf16_t* Qm; const float* ssq_q; const float* rcos; const float* rsin; float c2;
    __device__ __forceinline__ void operator()(const f32x4 (&acc)[2][2][4][2], const Unit& u, int wr, int wc, int fr_, int fq_) const {
        int ln_ = __builtin_amdgcn_mbcnt_hi(~0u, __builtin_amdgcn_mbcnt_lo(~0u, 0u)); asm volatile("" : "+v"(ln_)); const int fr = ln_ & 15, fq = ln_ >> 4;
        const int row0 = u.pm * BM + wr * 64 + fr, col0 = u.pn * BM + wc * 32 + 8 * fq;
#pragma unroll
        for (int ai = 0; ai < 2; ++ai)
#pragma unroll
            for (int m = 0; m < 4; ++m) {
                const int row = row0 + ai * HALF + m * 16;
                const f32x4 rs = *(const f32x4*)(ssq_q + (size_t)row * 4);
                const float rstd = rsqrtf(((rs[0] + rs[1]) + (rs[2] + rs[3])) * (1.f / 256.f) + EPS) * c2;
#pragma unroll
                for (int bj = 0; bj < 2; ++bj) {
                    f32x4 v0 = acc[ai][bj][m][0] * rstd, v1 = acc[ai][bj][m][1] * rstd;
                    const int G = 8 * u.pn + 4 * bj + wc;
                    if (G % 3 == 2) {
                        const int i0 = 8 * (fq & 1);
                        const f32x4 c0 = *(const f32x4*)(rcos + (size_t)row * 16 + i0), c1 = *(const f32x4*)(rcos + (size_t)row * 16 + i0 + 4);
                        const f32x4 s0 = *(const f32x4*)(rsin + (size_t)row * 16 + i0), s1 = *(const f32x4*)(rsin + (size_t)row * 16 + i0 + 4);
                        f32x4 o0, o1; const float sg = (fq < 2) ? -1.f : 1.f;
#pragma unroll
                        for (int j = 0; j < 4; ++j) { const float p0 = __shfl_xor(v0[j], 32), p1 = __shfl_xor(v1[j], 32);
                            o0[j] = v0[j] * c0[j] + sg * p0 * s0[j]; o1[j] = v1[j] * c1[j] + sg * p1 * s1[j]; }
                        v0 = o0; v1 = o1;
                    }
                    *(u32x4*)(Qm + (size_t)row * 768 + col0 + bj * HALF) = pack8(v0, v1);
                }
                asm volatile("" ::: "memory");
            }
    }
};

struct EpiKvb {
    bf16_t* Km; bf16_t* Vtm; const float* ssq_kv;
    __device__ __forceinline__ void operator()(const f32x4 (&acc)[2][2][4][2], const Unit& u, int wr, int wc, int fr_, int fq_) const {
        int ln_ = __builtin_amdgcn_mbcnt_hi(~0u, __builtin_amdgcn_mbcnt_lo(~0u, 0u)); asm volatile("" : "+v"(ln_)); const int fr = ln_ & 15, fq = ln_ >> 4;
        const int row0 = u.pm * BM + wr * 64 + fr, col0 = u.pn * BM + wc * 32 + 8 * fq;
#pragma unroll
        for (int ai = 0; ai < 2; ++ai)
#pragma unroll
            for (int m = 0; m < 4; ++m) {
                const int row = row0 + ai * HALF + m * 16;
                const f32x4 rs = *(const f32x4*)(ssq_kv + (size_t)row * 4);
                const float rstd = rsqrtf(((rs[0] + rs[1]) + (rs[2] + rs[3])) * (1.f / 128.f) + EPS);
#pragma unroll
                for (int bj = 0; bj < 2; ++bj) {
                    const f32x4 v0 = acc[ai][bj][m][0] * rstd, v1 = acc[ai][bj][m][1] * rstd;
                    const int col = col0 + bj * HALF;
                    if (u.pn < 2) { const int h = col >> 6, d = col & 63; *(u32x4*)(Km + (size_t)row * 768 + h * 96 + d) = pack8(v0, v1); }
                    else { const int cv = col - 512, h = cv >> 6, d0 = cv & 63, b = row >> 11, s = row & 2047;
#pragma unroll
                        for (int j = 0; j < 8; ++j) { const float val = (j < 4) ? v0[j & 3] : v1[j & 3];
                            Vtm[((size_t)(b * 8 + h) * 64 + d0 + j) * SEQ + s] = (bf16_t)f2bf(val); } }
                }
            }
    }
};

constexpr float W8_SCALE = 64.f, W8_INV = 1.f / 64.f;
struct EpiMoe1 {
    unsigned char* act; const float* b1;
    __device__ __forceinline__ void operator()(const f32x4 (&acc)[2][2][4][2], const Unit& u, int wr, int wc, int fr_, int fq_) const {
        int ln_ = __builtin_amdgcn_mbcnt_hi(~0u, __builtin_amdgcn_mbcnt_lo(~0u, 0u)); asm volatile("" : "+v"(ln_)); const int fr = ln_ & 15, fq = ln_ >> 4;
        const int row0 = u.pm * BM + wr * 64 + fr, col0 = u.pn * BM + wc * 32 + 8 * fq;
        f32x4 bv[2][2];
#pragma unroll
        for (int bj = 0; bj < 2; ++bj)
#pragma unroll
            for (int n = 0; n < 2; ++n) bv[bj][n] = *(const f32x4*)(b1 + (size_t)u.e * 2048 + col0 + bj * HALF + 4 * n);
#pragma unroll
        for (int ai = 0; ai < 2; ++ai)
#pragma unroll
            for (int m = 0; m < 4; ++m) {
                unsigned char* rowp = act + (size_t)(row0 + ai * HALF + m * 16) * FE + (col0 >> 1);
#pragma unroll
                for (int bj = 0; bj < 2; ++bj) {
                    const f32x4 v0 = acc[ai][bj][m][0] * W8_INV + bv[bj][0], v1 = acc[ai][bj][m][1] * W8_INV + bv[bj][1];
                    float o[4];
#pragma unroll
                    for (int p = 0; p < 4; ++p) { const float g = fminf((p < 2) ? v0[2 * (p & 1)] : v1[2 * (p & 1)], 7.f);
                        const float l = fminf(fmaxf((p < 2) ? v0[2 * (p & 1) + 1] : v1[2 * (p & 1) + 1], -7.f), 7.f);
                        const float sg = __builtin_amdgcn_rcpf(1.f + __builtin_amdgcn_exp2f(-1.702f * LOG2E * g));
                        o[p] = g * sg * (l + 1.f); }
                    int w = 0; w = __builtin_amdgcn_cvt_pk_fp8_f32(o[0], o[1], w, false); w = __builtin_amdgcn_cvt_pk_fp8_f32(o[2], o[3], w, true);
                    *(int*)(rowp + bj * (HALF / 2)) = w;
                }
            }
    }
};

struct EpiMoe2 {
    unsigned char* yb; const float* b2;
    __device__ __forceinline__ void operator()(const f32x4 (&acc)[2][2][4][2], const Unit& u, int wr, int wc, int fr_, int fq_) const {
        int ln_ = __builtin_amdgcn_mbcnt_hi(~0u, __builtin_amdgcn_mbcnt_lo(~0u, 0u)); asm volatile("" : "+v"(ln_)); const int fr = ln_ & 15, fq = ln_ >> 4;
        const int row0 = u.pm * BM + wr * 64 + fr, col0 = u.pn * BM + wc * 32 + 8 * fq;
        f32x4 bv[2][2];
#pragma unroll
        for (int bj = 0; bj < 2; ++bj)
#pragma unroll
            for (int n = 0; n < 2; ++n) bv[bj][n] = *(const f32x4*)(b2 + (size_t)u.e * 1024 + col0 + bj * HALF + 4 * n);
#pragma unroll
        for (int ai = 0; ai < 2; ++ai)
#pragma unroll
            for (int m = 0; m < 4; ++m) { unsigned char* rowp = yb + (size_t)(row0 + ai * HALF + m * 16) * FE + col0;
#pragma unroll
                for (int bj = 0; bj < 2; ++bj) { const f32x4 v0 = acc[ai][bj][m][0] * W8_INV + bv[bj][0], v1 = acc[ai][bj][m][1] * W8_INV + bv[bj][1];
                    int w0 = 0, w1 = 0; w0 = __builtin_amdgcn_cvt_pk_fp8_f32(v0[0], v0[1], w0, false); w0 = __builtin_amdgcn_cvt_pk_fp8_f32(v0[2], v0[3], w0, true);
                    w1 = __builtin_amdgcn_cvt_pk_fp8_f32(v1[0], v1[1], w1, false); w1 = __builtin_amdgcn_cvt_pk_fp8_f32(v1[2], v1[3], w1, true);
                    *(u32x2*)(rowp + bj * HALF) = (u32x2){(unsigned)w0, (unsigned)w1}; } }
    }
};
}

struct Args {
    const float* x; const float* c; const int* pos; const float* w_ada; const float* b_ada;
    const float* g_pre_mix; const float* g_post_mix; const float* g_pre_ffn; const float* g_post_ffn;
    const float* w_in; const float* g_q_a; const float* g_kv_a; const float* w_q_b; const float* w_kv_b; const float* w_o;
    const float* w_router; const float* b_router; const float* w_mlp1; const float* b_mlp1; const float* w_mlp2; const float* b_mlp2;
    float* out; unsigned char* ws; int ph_lo, ph_hi;
};

__device__ __forceinline__ unsigned cvt_pk_bf16_(float lo, float hi) { unsigned r; asm volatile("v_cvt_pk_bf16_f32 %0, %1, %2" : "=v"(r) : "v"(lo), "v"(hi)); return r; }
template <bool FP8>
__device__ __forceinline__ void transpose_item(const float* W, int ldw, int srccol0, int nvalid, bool kvalid, const float* kscale, float cscale,
                                               void* WT, int ldk, int dstrow0, int k0, LAS float* scr, int lane) {
    const int kr = lane >> 3, n4 = (lane & 7) * 4;
#pragma unroll
    for (int i = 0; i < 8; ++i) { const int kk = kr + 8 * i;
        f32x4 v = (f32x4){0.f, 0.f, 0.f, 0.f};
        if (kvalid && n4 < nvalid) { v = *(const f32x4*)(W + (size_t)(k0 + kk) * ldw + srccol0 + n4); float sc = cscale; if (kscale) sc *= kscale[k0 + kk]; v = v * sc; }
        *(LAS f32x4*)(scr + kk * 36 + n4) = v; }
    LDS_WAIT(); asm volatile("" ::: "memory");
    const int n = lane & 31, kh = lane >> 5;
    const LAS float* sp = scr + (32 * kh) * 36 + n;
    if constexpr (FP8) {
        int w[8];
#pragma unroll
        for (int q = 0; q < 8; ++q) { float f0 = sp[(4 * q) * 36], f1 = sp[(4 * q + 1) * 36], f2 = sp[(4 * q + 2) * 36], f3 = sp[(4 * q + 3) * 36];
            f0 = fminf(fmaxf(f0, -448.f), 448.f); f1 = fminf(fmaxf(f1, -448.f), 448.f); f2 = fminf(fmaxf(f2, -448.f), 448.f); f3 = fminf(fmaxf(f3, -448.f), 448.f);
            int t = 0; t = __builtin_amdgcn_cvt_pk_fp8_f32(f0, f1, t, false); t = __builtin_amdgcn_cvt_pk_fp8_f32(f2, f3, t, true); w[q] = t; }
        unsigned char* dst = (unsigned char*)WT + (size_t)(dstrow0 + n) * ldk + k0 + 32 * kh;
        *(i32x4*)dst = (i32x4){w[0], w[1], w[2], w[3]}; *(i32x4*)(dst + 16) = (i32x4){w[4], w[5], w[6], w[7]};
    } else {
        unsigned w[16];
#pragma unroll
        for (int q = 0; q < 16; ++q) w[q] = cvt_pk_bf16_(sp[(2 * q) * 36], sp[(2 * q + 1) * 36]);
        bf16_t* dst = (bf16_t*)WT + (size_t)(dstrow0 + n) * ldk + k0 + 32 * kh;
#pragma unroll
        for (int q = 0; q < 4; ++q) *(u32x4*)(dst + 8 * q) = (u32x4){w[4 * q], w[4 * q + 1], w[4 * q + 2], w[4 * q + 3]};
    }
    LDS_WAIT(); asm volatile("" ::: "memory");
}

__device__ __forceinline__ void moe_item_decode(const Args& a, int r, const float*& W, int& ldw, unsigned char*& WT, int& srccol, int& k0) {
    constexpr int I_M1 = 32 * 16 * 64;
    if (r < I_M1) { const int e = r / 1024, q = r % 1024, kb = q / 64, nb = q % 64; W = a.w_mlp1 + (size_t)e * 1024 * 2048; ldw = 2048; WT = a.ws + WS_W1T + (size_t)e * 2048 * 1024; srccol = 32 * nb; k0 = 64 * kb; }
    else { r -= I_M1; const int e = r / 512, q = r % 512, kb = q / 32, nb = q % 32; W = a.w_mlp2 + (size_t)e * 1024 * 1024; ldw = 1024; WT = a.ws + WS_W2T + (size_t)e * 1024 * 1024; srccol = 32 * nb; k0 = 64 * kb; }
}
__device__ __forceinline__ void moe_item_load(const Args& a, int r, f32x4 (&v)[8], int lane) {
    const float* W; int ldw, srccol, k0; unsigned char* WT; moe_item_decode(a, r, W, ldw, WT, srccol, k0);
    const int kr = lane >> 3, n4 = (lane & 7) * 4;
#pragma unroll
    for (int i = 0; i < 8; ++i) v[i] = __builtin_nontemporal_load((const f32x4*)(W + (size_t)(k0 + kr + 8 * i) * ldw + srccol + n4));
}
__device__ __forceinline__ void moe_item_finish(const Args& a, int r, const f32x4 (&v)[8], LAS float* scr, int lane) {
    const float* W; int ldw, srccol, k0; unsigned char* WT; moe_item_decode(a, r, W, ldw, WT, srccol, k0);
    const int kr = lane >> 3, n4 = (lane & 7) * 4;
#pragma unroll
    for (int i = 0; i < 8; ++i) *(LAS f32x4*)(scr + (kr + 8 * i) * 36 + n4) = v[i] * pg8::W8_SCALE;
    LDS_WAIT(); asm volatile("" ::: "memory");
    const int n = lane & 31, kh = lane >> 5;
    const LAS float* sp = scr + (32 * kh) * 36 + n;
    int w[8];
#pragma unroll
    for (int q = 0; q < 8; ++q) { float f0 = sp[(4 * q) * 36], f1 = sp[(4 * q + 1) * 36], f2 = sp[(4 * q + 2) * 36], f3 = sp[(4 * q + 3) * 36];
        f0 = fminf(fmaxf(f0, -448.f), 448.f); f1 = fminf(fmaxf(f1, -448.f), 448.f); f2 = fminf(fmaxf(f2, -448.f), 448.f); f3 = fminf(fmaxf(f3, -448.f), 448.f);
        int t = 0; t = __builtin_amdgcn_cvt_pk_fp8_f32(f0, f1, t, false); t = __builtin_amdgcn_cvt_pk_fp8_f32(f2, f3, t, true); w[q] = t; }
    unsigned char* dst = WT + (size_t)(srccol + n) * 1024 + k0 + 32 * kh;
    *(i32x4*)dst = (i32x4){w[0], w[1], w[2], w[3]}; *(i32x4*)(dst + 16) = (i32x4){w[4], w[5], w[6], w[7]};
    LDS_WAIT(); asm volatile("" ::: "memory");
}

__device__ __forceinline__ void p0_prologue(const Args& a, LAS unsigned char* lds, int tid, int wave, int lane) {
    unsigned char* ws = a.ws;
    LAS float* scr = (LAS float*)(lds + wave * 9216);
    LAS float* cond = (LAS float*)(lds + 8 * 9216);
    for (int i = tid; i < NB * DM; i += 512) { const float v = a.c[i]; cond[i] = v / (1.f + __expf(-v)); }
    __syncthreads();
    const int gw = blockIdx.x * 8 + wave, NGW = gridDim.x * 8;
    constexpr int I_ADA = 8 * 192, I_IN = 16 * 48, I_QB = 4 * 24, I_KVB = 4 * 32, I_O = 16 * 32, I_M1 = 32 * 16 * 64, I_M2 = 32 * 16 * 32;
    constexpr int NITEMS = I_ADA + I_IN + I_QB + I_KVB + I_O;
    float* modp = (float*)(ws + WS_MODP);
    for (int it = gw; it < NITEMS; it += NGW) {
        int r = it;
        if (r < I_ADA) {
            const int kc = r / 192, cc = r % 192, k0 = 128 * kc + (lane >> 3), c0 = 32 * cc + 4 * (lane & 7);
            f32x4 acc[8];
#pragma unroll
            for (int b = 0; b < 8; ++b) acc[b] = (f32x4){0.f, 0.f, 0.f, 0.f};
#pragma unroll 8
            for (int i = 0; i < 16; ++i) { const int k = k0 + 8 * i;
                const f32x4 w = __builtin_nontemporal_load((const f32x4*)(a.w_ada + (size_t)k * 6144 + c0));
#pragma unroll
                for (int b = 0; b < 8; ++b) acc[b] += w * cond[b * DM + k]; }
#pragma unroll
            for (int b = 0; b < 8; ++b) {
#pragma unroll
                for (int j = 0; j < 4; ++j) { float v = acc[b][j]; v += __shfl_xor(v, 8); v += __shfl_xor(v, 16); v += __shfl_xor(v, 32); acc[b][j] = v; }
                if (lane < 8) *(f32x4*)(modp + (size_t)(kc * 8 + b) * 6144 + c0) = acc[b]; }
            continue;
        }
        r -= I_ADA;
        if (r < I_IN) {
            const int kb = r / 48, nb = r % 48, j = 32 * nb; int src, nv = 32; float cs = 1.f;
            if (j < 416) src = j;
            else if (j < 448) src = 1440 + (j - 416);
            else if (j < 480) { src = 1472; nv = 8; cs = 0.35355339059327373f; }
            else if (j < 512) { src = 0; nv = 0; }
            else if (j < 1024) { src = 416 + (j - 512); cs = 0.125f * LOG2E; }
            else if (j < 1152) src = 928 + (j - 1024);
            else if (j < 1280) src = 1056 + (j - 1152);
            else { src = 1184 + (j - 1280); cs = 0.17677669529663687f; }
            transpose_item<false>(a.w_in, 1480, src, nv, true, nullptr, cs, (bf16_t*)(ws + WS_WIN), 1024, j, 64 * kb, scr, lane); continue;
        }
        r -= I_IN;
        if (r < I_QB) { const int kb = r / 24, nb = r % 24;
            transpose_item<false>(a.w_q_b, 768, 32 * nb, 32, true, a.g_q_a, 1.f, (bf16_t*)(ws + WS_WQB), 256, 32 * nb, 64 * kb, scr, lane); continue; }
        r -= I_QB;
        if (r < I_KVB) { const int kb = r / 32, nb = r % 32, j = 32 * nb; int src;
            if (j < 512) src = (j >> 6) * 128 + (j & 63); else { const int jj = j - 512; src = (jj >> 6) * 128 + 64 + (jj & 63); }
            transpose_item<false>(a.w_kv_b, 1024, src, 32, kb < 2, a.g_kv_a, 1.f, (bf16_t*)(ws + WS_WKVB), 256, j, 64 * kb, scr, lane); continue; }
        r -= I_KVB;
        if (r < I_O) { const int kb = r / 32, nb = r % 32;
            transpose_item<true>(a.w_o, 1024, 32 * nb, 32, true, nullptr, pg8::W8_SCALE, ws + WS_WO, 1024, 32 * nb, 64 * kb, scr, lane); continue; }
    }
}

__device__ __forceinline__ void moe_weights_phase(const Args& a, LAS unsigned char* lds, int wave, int lane, int r0, int r1, int gw, int NGW) {
    LAS float* scr = (LAS float*)(lds + wave * 9216);
    constexpr int I_M1 = 32 * 16 * 64, I_M2 = 32 * 16 * 32;
    {
        const int NM = r1;
        f32x4 va[8], vb[8];
        int r = r0 + gw;
        if (r < NM) moe_item_load(a, r, va, lane);
#pragma unroll 1
        while (r < NM) {
            int r2 = r + NGW; if (r2 < NM) moe_item_load(a, r2, vb, lane);
            moe_item_finish(a, r, va, scr, lane);
            r = r2; if (r >= NM) break;
            r2 = r + NGW; if (r2 < NM) moe_item_load(a, r2, va, lane);
            moe_item_finish(a, r, vb, scr, lane);
            r = r2;
        }
    }
}

__device__ __forceinline__ float mod_at(const Args& a, int b, int j) {
    const float* modp = (const float*)(a.ws + WS_MODP);
    float s = a.b_ada[j];
#pragma unroll
    for (int kc = 0; kc < 8; ++kc) s += modp[(size_t)(kc * 8 + b) * 6144 + j];
    return s;
}

__device__ __forceinline__ void p1_rows(const Args& a, LAS unsigned char* lds, int tid, int wave, int lane) {
    LAS float* Amul = (LAS float*)lds; LAS float* Badd = Amul + DM;
    bf16_t* hb = (bf16_t*)(a.ws + WS_HB);
    float* rcos = (float*)(a.ws + WS_ROPE); float* rsin = rcos + (size_t)MT * 16;
    for (int blk = blockIdx.x; blk < MT / 64; blk += gridDim.x) {
        const int b = blk / 32;
        __syncthreads();
        for (int j = tid; j < DM; j += 512) { const float sh = mod_at(a, b, j), sc = mod_at(a, b, 1024 + j); Amul[j] = a.g_pre_mix[j] * (1.f + sc); Badd[j] = sh; }
        __syncthreads();
#pragma unroll 1
        for (int r0 = wave; r0 < 64; r0 += 32) {
            f32x4 v[4][4];
#pragma unroll
            for (int q = 0; q < 4; ++q) { const f32x4* xr = (const f32x4*)(a.x + (size_t)(blk * 64 + r0 + 8 * q) * DM) + lane;
#pragma unroll
                for (int j = 0; j < 4; ++j) v[q][j] = __builtin_nontemporal_load(xr + 64 * j); }
#pragma unroll
            for (int q = 0; q < 4; ++q) {
                const int row = blk * 64 + r0 + 8 * q;
                float ss = 0.f;
#pragma unroll
                for (int j = 0; j < 4; ++j) ss += (v[q][j][0] * v[q][j][0] + v[q][j][1] * v[q][j][1]) + (v[q][j][2] * v[q][j][2] + v[q][j][3] * v[q][j][3]);
                const float rstd = rsqrtf(wave_sum(ss) * (1.f / DM) + EPS);
                unsigned long long* o8 = (unsigned long long*)(hb + (size_t)row * DM) + lane;
#pragma unroll
                for (int j = 0; j < 4; ++j) { const f32x4 am = *(const LAS f32x4*)(Amul + 4 * lane + 256 * j), bd = *(const LAS f32x4*)(Badd + 4 * lane + 256 * j);
                    const f32x4 h = v[q][j] * rstd * am + bd;
                    o8[64 * j] = (unsigned long long)pk2(h[0], h[1]) | ((unsigned long long)pk2(h[2], h[3]) << 32); }
                if (lane < 16) { const float fr = powf(10000.f, -(float)lane / 16.f); const float ang = (float)a.pos[row] * fr; float sn, cs; sincosf(ang, &sn, &cs);
                    rcos[(size_t)row * 16 + lane] = cs; rsin[(size_t)row * 16 + lane] = sn; }
            }
        }
    }
}

__device__ __forceinline__ unsigned sortable(float v) { const unsigned u = __builtin_bit_cast(unsigned, v + 0.0f); return (u & 0x80000000u) ? ~u : (u | 0x80000000u); }

__device__ __forceinline__ unsigned wave_max_u(unsigned v) {
#pragma unroll
    for (int o = 1; o < 64; o <<= 1) { const unsigned w = (unsigned)__shfl_xor((int)v, o); v = v > w ? v : w; }
    return v; }
__device__ __forceinline__ unsigned wave_min_u(unsigned v) {
#pragma unroll
    for (int o = 1; o < 64; o <<= 1) { const unsigned w = (unsigned)__shfl_xor((int)v, o); v = v < w ? v : w; }
    return v; }

__device__ __forceinline__ void idx_item(LAS unsigned char* lds, const bf16_t* proj, unsigned* bitmap, int b, int tg, int wave, int lane) {
    constexpr int SCS = 2052;
    LAS float* sc = (LAS float*)lds;
    LAS unsigned* cbuf = (LAS unsigned*)(lds + 16 * SCS * 4) + wave * 64;
    const int t0 = tg * 16, nkt = tg + 1;
    const int n = lane & 15, kq = lane >> 4;
    const size_t rowq = (size_t)(b * SEQ + t0 + n);
    bf16x8 qf[8];
#pragma unroll
    for (int h = 0; h < 8; ++h) qf[h] = *(const bf16x8*)(proj + rowq * NPROJ + PC_QIDX + h * 32 + 8 * kq);
    const u32x4 wraw = *(const u32x4*)(proj + rowq * NPROJ + PC_WIDX);
    float w[8]; w[0] = bflo(wraw.x); w[1] = bfhi(wraw.x); w[2] = bflo(wraw.y); w[3] = bfhi(wraw.y); w[4] = bflo(wraw.z); w[5] = bfhi(wraw.z); w[6] = bflo(wraw.w); w[7] = bfhi(wraw.w);
#pragma unroll 1
    for (int base = wave; base < nkt; base += 64) {
        bf16x8 kf[8];
#pragma unroll
        for (int i = 0; i < 8; ++i) { const int kt = base + 8 * i; if (kt < nkt) kf[i] = *(const bf16x8*)(proj + (size_t)(b * SEQ + 16 * kt + n) * NPROJ + PC_KIDX + 8 * kq); }
#pragma unroll
        for (int i = 0; i < 8; ++i) { const int kt = base + 8 * i;
            if (kt < nkt) {
                f32x4 s = (f32x4){0.f, 0.f, 0.f, 0.f};
#pragma unroll
                for (int h = 0; h < 8; ++h) { const f32x4 d = __builtin_amdgcn_mfma_f32_16x16x32_bf16(kf[i], qf[h], (f32x4){0.f, 0.f, 0.f, 0.f}, 0, 0, 0);
#pragma unroll
                    for (int j = 0; j < 4; ++j) s[j] = fmaf(w[h], fmaxf(d[j], 0.f), s[j]); }
                *(LAS f32x4*)(sc + n * SCS + 16 * kt + 4 * kq) = s;
            } }
    }
    __syncthreads();
#pragma unroll 1
    for (int qq = 0; qq < 2; ++qq) {
        const int q = 2 * wave + qq, t = t0 + q;
        unsigned key[32];
#pragma unroll
        for (int j = 0; j < 32; ++j) key[j] = __builtin_bit_cast(unsigned, sc[q * SCS + 64 * j + lane]);
        asm volatile("" : "+v"(key[0]), "+v"(key[1]), "+v"(key[2]), "+v"(key[3]), "+v"(key[4]), "+v"(key[5]), "+v"(key[6]), "+v"(key[7]), "+v"(key[8]), "+v"(key[9]), "+v"(key[10]), "+v"(key[11]), "+v"(key[12]), "+v"(key[13]), "+v"(key[14]), "+v"(key[15]));
        asm volatile("" : "+v"(key[16]), "+v"(key[17]), "+v"(key[18]), "+v"(key[19]), "+v"(key[20]), "+v"(key[21]), "+v"(key[22]), "+v"(key[23]), "+v"(key[24]), "+v"(key[25]), "+v"(key[26]), "+v"(key[27]), "+v"(key[28]), "+v"(key[29]), "+v"(key[30]), "+v"(key[31]));
#pragma unroll
        for (int j = 0; j < 32; ++j) key[j] = (64 * j + lane <= t) ? sortable(__builtin_bit_cast(float, key[j])) : 0u;
        unsigned long long mine = 0ull; int lo_ = lane; asm volatile("" : "+v"(lo_));
        const unsigned long long lt = (1ull << lane) - 1ull;
        if (t + 1 > 256) {
            unsigned mx = key[0], mn = key[0] ? key[0] : 0xffffffffu;
#pragma unroll
            for (int j = 1; j < 32; ++j) { mx = mx > key[j] ? mx : key[j]; const unsigned kk = key[j] ? key[j] : 0xffffffffu; mn = mn < kk ? mn : kk; }
            mx = wave_max_u(mx); mn = wave_min_u(mn);
            mx = (unsigned)__builtin_amdgcn_readfirstlane((int)mx); mn = (unsigned)__builtin_amdgcn_readfirstlane((int)mn);
            unsigned T = mx; int hiCnt = 0, ngt = 0, neq = 0; bool have = false;
            const unsigned diff = mx ^ mn;
            if (diff != 0u) {
                int bit = 31 - __builtin_clz(diff);
                T = mx & ~(((2u << bit) - 1u));
                int cntT = t + 1;
#pragma unroll 1
                while (bit >= 0 && cntT - hiCnt > 64) {
                    const unsigned cand = T | (1u << bit); unsigned cl = 0u;
#pragma unroll
                    for (int j = 0; j < 32; ++j) cl += (key[j] >= cand) ? 1u : 0u;
                    int c = 0;
#pragma unroll
                    for (int bb = 0; bb < 6; ++bb) c += __popcll(__ballot((cl >> bb) & 1u)) << bb;
                    if (c >= 256) { T = cand; cntT = c; } else hiCnt = c;
                    --bit;
                }
                if (bit >= 0) {
                    const unsigned span = (2u << bit) - 1u; int run = 0;
#pragma unroll
                    for (int j = 0; j < 32; ++j) { const bool in = (key[j] != 0u) && ((key[j] - T) <= span); const unsigned long long m = __ballot(in);
                        if (in) cbuf[run + __popcll(m & lt)] = key[j]; run += __popcll(m); if ((j & 3) == 3) __builtin_amdgcn_sched_barrier(0); }
                    LDS_WAIT();
                    const unsigned ck = (lane < run) ? cbuf[lane] : 0u;
#pragma unroll 1
                    for (; bit >= 0; --bit) { const unsigned cand = T | (1u << bit); const int c = __popcll(__ballot(ck >= cand)); if (hiCnt + c >= 256) T = cand; }
                    ngt = hiCnt + __popcll(__ballot(ck > T)); neq = __popcll(__ballot(ck == T)); have = true;
                }
            }
            if (!have) {
#pragma unroll
                for (int j = 0; j < 32; ++j) { ngt += __popcll(__ballot(key[j] > T)); neq += __popcll(__ballot(key[j] == T)); if ((j & 3) == 3) __builtin_amdgcn_sched_barrier(0); }
            }
            const int need = 256 - ngt;
            asm volatile("" : "+s"(T));
            if (neq == need) {
#pragma unroll
                for (int j = 0; j < 32; ++j) { const unsigned long long mk = __ballot(key[j] >= T); mine = (lo_ == j) ? mk : mine; if ((j & 3) == 3) __builtin_amdgcn_sched_barrier(0); }
            } else {
                int run = 0;
#pragma unroll
                for (int j = 0; j < 32; ++j) { const bool eq = key[j] == T; const unsigned long long em = __ballot(eq); const int rank = run + __popcll(em & lt);
                    const unsigned long long mk = __ballot(key[j] > T || (eq && rank < need)); mine = (lo_ == j) ? mk : mine; run += __popcll(em); if ((j & 3) == 3) __builtin_amdgcn_sched_barrier(0); }
            }
        } else {
#pragma unroll
            for (int j = 0; j < 4; ++j) { const unsigned long long mk = __ballot(64 * j + lo_ <= t); mine = (lo_ == j) ? mk : mine; }
        }
        if (lane < 32) ((unsigned long long*)bitmap)[(size_t)(b * SEQ + t) * 32 + lane] = mine;
    }
    __syncthreads();
}

__device__ __forceinline__ int crow(int r, int hi) { return (r & 3) + 8 * (r >> 2) + 4 * hi; }
typedef float f32x2_t __attribute__((ext_vector_type(2))); typedef __bf16 bf16x2_t __attribute__((ext_vector_type(2)));
__device__ __forceinline__ unsigned cvtpk(float lo, float hi) { f32x2_t v = {lo, hi}; bf16x2_t b = __builtin_convertvector(v, bf16x2_t); return __builtin_bit_cast(unsigned, b); }

template <int DQK, bool DSA>
__device__ __forceinline__ void attn_unit(LAS unsigned char* lds, int b, int qt,
                                          const bf16_t* Qp, int ldq, const bf16_t* Kp, int ldk, const bf16_t* Vt, unsigned char* Yp,
                                          const unsigned* bitmap, const int* pos, float c1, float aslope, int tid, int wave, int lane, LAS unsigned* tctr, unsigned& tgen) {
    constexpr int KSTR = DQK * 2 + 16, KBYTES = 64 * KSTR, VSTR = 136, VBYTES = 64 * VSTR, BUF = KBYTES + VBYTES + 256, NKS = DQK / 16, CPR = DQK / 8, NCH = 64 * CPR;
    const int hi = lane >> 5, l31 = lane & 31;
    const int NT = 2 * (qt + 1);
    const int qw0 = 128 * qt + 32 * wave, tq = qw0 + l31;
    const size_t rowq = (size_t)(b * SEQ + tq);
    bf16x8 qf[NKS];
#pragma unroll
    for (int ks = 0; ks < NKS; ++ks) qf[ks] = *(const bf16x8*)(Qp + rowq * ldq + 16 * ks + 8 * hi);
    float ptq = 0.f; if (DSA) ptq = (float)pos[b * SEQ + tq];
    constexpr float THR = 4.0f;
    float mref = 0.f, lrun = 0.f; bool seen = false; f32x16 o[2], negm;
#pragma unroll
    for (int r = 0; r < 16; ++r) { o[0][r] = 0.f; o[1][r] = 0.f; negm[r] = 0.f; }
    u32x4 kreg[NCH / 256], vreg[2]; float preg = 0.f;
#define TEAM_BAR() do { asm volatile("s_waitcnt lgkmcnt(0)" ::: "memory"); tgen += 4u; \
        if (lane == 0) (void)__hip_atomic_fetch_add(tctr, 1u, __ATOMIC_RELAXED, __HIP_MEMORY_SCOPE_WORKGROUP); \
        while ((unsigned)__builtin_amdgcn_readfirstlane((int)__hip_atomic_load(tctr, __ATOMIC_RELAXED, __HIP_MEMORY_SCOPE_WORKGROUP)) < tgen) __builtin_amdgcn_s_sleep(0); \
        asm volatile("" ::: "memory"); } while (0)
#define ATT_LOAD(t) do { const size_t kb_ = (size_t)(b * SEQ + 64 * (t)); \
        _Pragma("unroll") for (int i_ = 0; i_ < NCH / 256; ++i_) { const int c_ = tid + 256 * i_; kreg[i_] = *(const u32x4*)(Kp + (kb_ + c_ / CPR) * ldk + 8 * (c_ % CPR)); } \
        _Pragma("unroll") for (int i_ = 0; i_ < 2; ++i_) { const int c_ = tid + 256 * i_; vreg[i_] = *(const u32x4*)(Vt + (size_t)(c_ >> 3) * SEQ + 64 * (t) + 8 * (c_ & 7)); } \
        if (DSA && tid < 64) preg = (float)pos[b * SEQ + 64 * (t) + tid]; } while (0)
#define ATT_WRITE(bufi) do { LAS unsigned char* bb_ = lds + (bufi) * BUF; \
        _Pragma("unroll") for (int i_ = 0; i_ < NCH / 256; ++i_) { const int c_ = tid + 256 * i_; *(LAS u32x4*)(bb_ + (c_ / CPR) * KSTR + 16 * (c_ % CPR)) = kreg[i_]; } \
        _Pragma("unroll") for (int i_ = 0; i_ < 2; ++i_) { const int c_ = tid + 256 * i_; \
            *(LAS u32x2*)(bb_ + KBYTES + (c_ >> 3) * VSTR + 16 * (c_ & 7)) = (u32x2){vreg[i_].x, vreg[i_].y}; *(LAS u32x2*)(bb_ + KBYTES + (c_ >> 3) * VSTR + 16 * (c_ & 7) + 8) = (u32x2){vreg[i_].z, vreg[i_].w}; } \
        if (DSA && tid < 64) *(LAS float*)(bb_ + KBYTES + VBYTES + 4 * tid) = preg; } while (0)
    u32x2 bwn = (u32x2){0u, 0u}; if (DSA) bwn = *(const u32x2*)(bitmap + rowq * 64);
    ATT_LOAD(0); ATT_WRITE(0); TEAM_BAR();
    for (int t = 0; t < NT; ++t) {
        const u32x2 bw = bwn; if (DSA && t + 1 < NT) bwn = *(const u32x2*)(bitmap + rowq * 64 + 2 * (t + 1));
        if (t + 1 < NT) ATT_LOAD(t + 1);
        if (64 * t <= qw0 + 31) {
            const LAS unsigned char* bb = lds + (t & 1) * BUF;
            f32x16 s0 = negm, s1 = negm;
            bf16x8 kfa[NKS], kfb[NKS];
#pragma unroll
            for (int ks = 0; ks < NKS; ++ks) { kfa[ks] = *(const LAS bf16x8*)(bb + l31 * KSTR + 32 * ks + 16 * hi); kfb[ks] = *(const LAS bf16x8*)(bb + (32 + l31) * KSTR + 32 * ks + 16 * hi); }
            __builtin_amdgcn_sched_barrier(0);
#pragma unroll
            for (int ks = 0; ks < NKS; ++ks) {
                s0 = __builtin_amdgcn_mfma_f32_32x32x16_bf16(kfa[ks], qf[ks], s0, 0, 0, 0);
                s1 = __builtin_amdgcn_mfma_f32_32x32x16_bf16(kfb[ks], qf[ks], s1, 0, 0, 0);
            }
            __builtin_amdgcn_sched_barrier(0);
            const LAS unsigned char* vb = bb + KBYTES;
            u32x2 vlo[8], vhi[8];
#pragma unroll
            for (int kk = 0; kk < 2; ++kk)
#pragma unroll
                for (int s = 0; s < 2; ++s)
#pragma unroll
                    for (int db = 0; db < 2; ++db) { const LAS unsigned char* va = vb + (32 * db + l31) * VSTR + (32 * kk + 16 * s + 4 * hi) * 2;
                        vlo[(kk * 2 + s) * 2 + db] = *(const LAS u32x2*)va; vhi[(kk * 2 + s) * 2 + db] = *(const LAS u32x2*)(va + 16); }
            __builtin_amdgcn_sched_barrier(0);
            if (DSA) {
                asm volatile("s_nop 15\n\ts_nop 3" ::: "memory");
                __builtin_amdgcn_sched_barrier(0);
                const unsigned w0 = bw.x >> (4 * hi), w1 = bw.y >> (4 * hi);
                const LAS float* pp = (const LAS float*)(bb + KBYTES + VBYTES);
                const float nega = -aslope; const unsigned ninf = 0xff800000u;
#define DSA_EL(S, PK, W, BIT) do { float t_, v_; unsigned m_, r_; \
                    asm("v_sub_f32 %0, %1, %2" : "=v"(t_) : "v"(ptq), "v"(PK)); \
                    asm("v_fma_f32 %0, %1, |%2|, %3" : "=v"(v_) : "s"(nega), "v"(t_), "v"(S)); \
                    asm("v_bfe_i32 %0, %1, %2, 1" : "=v"(m_) : "v"(W), "n"(BIT)); \
                    asm("v_bfi_b32 %0, %1, %2, %3" : "=v"(r_) : "v"(m_), "v"(v_), "s"(ninf)); \
                    S = __builtin_bit_cast(float, r_); } while (0)
#pragma unroll
                for (int g = 0; g < 4; ++g) {
                    const f32x4 p0 = *(const LAS f32x4*)(pp + 8 * g + 4 * hi), p1 = *(const LAS f32x4*)(pp + 32 + 8 * g + 4 * hi);
                    DSA_EL(s0[4 * g + 0], p0[0], w0, 8 * g + 0); DSA_EL(s0[4 * g + 1], p0[1], w0, 8 * g + 1); DSA_EL(s0[4 * g + 2], p0[2], w0, 8 * g + 2); DSA_EL(s0[4 * g + 3], p0[3], w0, 8 * g + 3);
                    DSA_EL(s1[4 * g + 0], p1[0], w1, 8 * g + 0); DSA_EL(s1[4 * g + 1], p1[1], w1, 8 * g + 1); DSA_EL(s1[4 * g + 2], p1[2], w1, 8 * g + 2); DSA_EL(s1[4 * g + 3], p1[3], w1, 8 * g + 3);
                }
#undef DSA_EL
            } else {
                if (64 * t + 63 > qw0) {
#pragma unroll
                    for (int r = 0; r < 16; ++r) { const int key = 64 * t + crow(r, hi); if (key > tq) s0[r] = -INFINITY; if (key + 32 > tq) s1[r] = -INFINITY; }
                }
            }
            float mx;
            { float m0 = fmaxf(fmaxf(s0[0], s0[1]), s0[2]), m1 = fmaxf(fmaxf(s0[3], s0[4]), s0[5]), m2 = fmaxf(fmaxf(s1[0], s1[1]), s1[2]), m3 = fmaxf(fmaxf(s1[3], s1[4]), s1[5]);
              m0 = fmaxf(fmaxf(m0, s0[6]), s0[7]); m1 = fmaxf(fmaxf(m1, s0[8]), s0[9]); m2 = fmaxf(fmaxf(m2, s1[6]), s1[7]); m3 = fmaxf(fmaxf(m3, s1[8]), s1[9]);
              m0 = fmaxf(fmaxf(m0, s0[10]), s0[11]); m1 = fmaxf(fmaxf(m1, s0[12]), s0[13]); m2 = fmaxf(fmaxf(m2, s1[10]), s1[11]); m3 = fmaxf(fmaxf(m3, s1[12]), s1[13]);
              m0 = fmaxf(fmaxf(m0, s0[14]), s0[15]); m2 = fmaxf(fmaxf(m2, s1[14]), s1[15]);
              mx = fmaxf(fmaxf(m0, m1), fmaxf(m2, m3)); }
            mx = fmaxf(mx, __shfl_xor(mx, 32));
            {
                const bool fin = mx > -INFINITY, first = fin && !seen, upd = first || (mx > THR);
                if (__any(upd)) {
                    const float dl = upd ? mx : 0.f;
                    const float alpha = first ? 1.f : __builtin_amdgcn_exp2f(-dl);
                    mref += dl; lrun *= alpha;
#pragma unroll
                    for (int r = 0; r < 16; ++r) { s0[r] -= dl; s1[r] -= dl; o[0][r] *= alpha; o[1][r] *= alpha; negm[r] = -mref; }
                }
                seen = seen || fin;
            }
            float psum = 0.f;
#pragma unroll
            for (int r = 0; r < 16; ++r) { s0[r] = __builtin_amdgcn_exp2f(s0[r]); s1[r] = __builtin_amdgcn_exp2f(s1[r]); }
            { float q0 = 0.f, q1 = 0.f, q2 = 0.f, q3 = 0.f;
#pragma unroll
              for (int r = 0; r < 16; r += 4) { q0 += s0[r] + s1[r]; q1 += s0[r + 1] + s1[r + 1]; q2 += s0[r + 2] + s1[r + 2]; q3 += s0[r + 3] + s1[r + 3]; }
              psum = (q0 + q1) + (q2 + q3); }
            lrun += psum;
            unsigned pb0[8], pb1[8];
#pragma unroll
            for (int i = 0; i < 8; ++i) { pb0[i] = cvtpk(s0[2 * i], s0[2 * i + 1]); pb1[i] = cvtpk(s1[2 * i], s1[2 * i + 1]); }
            __builtin_amdgcn_sched_barrier(0);
#pragma unroll
            for (int kk = 0; kk < 2; ++kk)
#pragma unroll
                for (int s = 0; s < 2; ++s) {
                    u32x4 pf; if (kk == 0) pf = (u32x4){pb0[4 * s], pb0[4 * s + 1], pb0[4 * s + 2], pb0[4 * s + 3]}; else pf = (u32x4){pb1[4 * s], pb1[4 * s + 1], pb1[4 * s + 2], pb1[4 * s + 3]};
                    const bf16x8 pfr = __builtin_bit_cast(bf16x8, pf);
#pragma unroll
                    for (int db = 0; db < 2; ++db) { const int fi = (kk * 2 + s) * 2 + db;
                        const bf16x8 vf = __builtin_bit_cast(bf16x8, (u32x4){vlo[fi].x, vlo[fi].y, vhi[fi].x, vhi[fi].y});
                        o[db] = __builtin_amdgcn_mfma_f32_32x32x16_bf16(vf, pfr, o[db], 0, 0, 0); }
                }
        }
        if (t + 1 < NT) ATT_WRITE((t + 1) & 1);
        TEAM_BAR();
    }
#undef ATT_LOAD
#undef ATT_WRITE
#undef TEAM_BAR
    const float lt = lrun + __shfl_xor(lrun, 32);
    const float inv = 1.f / lt;
#pragma unroll
    for (int db = 0; db < 2; ++db)
#pragma unroll
        for (int g = 0; g < 4; ++g) { int w = 0; w = __builtin_amdgcn_cvt_pk_fp8_f32(o[db][4 * g] * inv, o[db][4 * g + 1] * inv, w, false); w = __builtin_amdgcn_cvt_pk_fp8_f32(o[db][4 * g + 2] * inv, o[db][4 * g + 3] * inv, w, true);
            *(int*)(Yp + rowq * DM + 32 * db + 8 * g + 4 * hi) = w; }
}

typedef float f32x2v __attribute__((ext_vector_type(2)));
__device__ __forceinline__ void p6_front(const Args& a, const bf16_t* mix, unsigned char* hb8, const LAS float* GT1, const LAS float* A2, const LAS float* B2, int row, int lane, f32x4 (&xv)[4]) {
    const u32x2* mr = (const u32x2*)(mix + (size_t)row * DM) + lane;
    const f32x4* xr = (const f32x4*)(a.x + (size_t)row * DM) + lane;
    f32x4 mv[4]; float ss = 0.f;
#pragma unroll
    for (int j = 0; j < 4; ++j) { const u32x2 q = __builtin_nontemporal_load(mr + 64 * j); mv[j] = (f32x4){bflo(q.x), bfhi(q.x), bflo(q.y), bfhi(q.y)}; xv[j] = __builtin_nontemporal_load(xr + 64 * j);
        ss += (mv[j][0] * mv[j][0] + mv[j][1] * mv[j][1]) + (mv[j][2] * mv[j][2] + mv[j][3] * mv[j][3]); }
    const float rstd1 = rsqrtf(wave_sum(ss) * (1.f / DM) + EPS);
    float ss2 = 0.f;
    f32x4* orow = (f32x4*)(a.out + (size_t)row * DM) + lane;
#pragma unroll
    for (int j = 0; j < 4; ++j) { const f32x4 g1 = *(const LAS f32x4*)(GT1 + 4 * lane + 256 * j);
        xv[j] = xv[j] + g1 * (mv[j] * rstd1); orow[64 * j] = xv[j];
        ss2 += (xv[j][0] * xv[j][0] + xv[j][1] * xv[j][1]) + (xv[j][2] * xv[j][2] + xv[j][3] * xv[j][3]); }
    const float rstd2 = rsqrtf(wave_sum(ss2) * (1.f / DM) + EPS);
    int* o4 = (int*)(hb8 + (size_t)row * DM) + lane;
#pragma unroll
    for (int j = 0; j < 4; ++j) { const f32x4 am = *(const LAS f32x4*)(A2 + 4 * lane + 256 * j), bd = *(const LAS f32x4*)(B2 + 4 * lane + 256 * j);
        xv[j] = xv[j] * rstd2 * am + bd;
        int w = 0; w = __builtin_amdgcn_cvt_pk_fp8_f32(xv[j][0], xv[j][1], w, false); w = __builtin_amdgcn_cvt_pk_fp8_f32(xv[j][2], xv[j][3], w, true);
        o4[64 * j] = w; }
}
__device__ __forceinline__ void p6_route(const Args& a, float (&pe)[32], LAS int* lcnt, LAS int* info, int r, int lane) {
    { const bool b5 = (lane & 32) != 0, b4 = (lane & 16) != 0, b3 = (lane & 8) != 0, b2 = (lane & 4) != 0, b1 = (lane & 2) != 0;
#pragma unroll
      for (int i = 0; i < 16; ++i) { const float keep = b5 ? pe[16 + i] : pe[i], send = b5 ? pe[i] : pe[16 + i]; pe[i] = keep + __shfl_xor(send, 32); }
#pragma unroll
      for (int i = 0; i < 8; ++i) { const float keep = b4 ? pe[8 + i] : pe[i], send = b4 ? pe[i] : pe[8 + i]; pe[i] = keep + __shfl_xor(send, 16); }
#pragma unroll
      for (int i = 0; i < 4; ++i) { const float keep = b3 ? pe[4 + i] : pe[i], send = b3 ? pe[i] : pe[4 + i]; pe[i] = keep + __shfl_xor(send, 8); }
#pragma unroll
      for (int i = 0; i < 2; ++i) { const float keep = b2 ? pe[2 + i] : pe[i], send = b2 ? pe[i] : pe[2 + i]; pe[i] = keep + __shfl_xor(send, 4); }
      { const float keep = b1 ? pe[1] : pe[0], send = b1 ? pe[0] : pe[1]; pe[0] = keep + __shfl_xor(send, 2); }
      pe[0] += __shfl_xor(pe[0], 1); }
    const int myexp = lane >> 1;
    const float mylg = pe[0] + a.b_router[myexp];
    int rank = 0;
#pragma unroll
    for (int j = 0; j < 32; ++j) { const float vj = __builtin_bit_cast(float, __builtin_amdgcn_readlane(__builtin_bit_cast(int, mylg), 2 * j));
        rank += (vj > mylg || (vj == mylg && j < myexp)) ? 1 : 0; }
    float tv[4]; int ti[4];
#pragma unroll
    for (int p = 0; p < 4; ++p) { const unsigned long long bm = __ballot(rank == p && !(lane & 1)); const int bi = __builtin_ctzll(bm);
        ti[p] = bi >> 1; tv[p] = __builtin_bit_cast(float, __builtin_amdgcn_readlane(__builtin_bit_cast(int, mylg), bi)); }
    float ex[4], es = 0.f;
#pragma unroll
    for (int p = 0; p < 4; ++p) { ex[p] = __expf(tv[p] - tv[0]); es += ex[p]; }
    if (lane < 4) {
        const int e = lane == 0 ? ti[0] : lane == 1 ? ti[1] : lane == 2 ? ti[2] : ti[3];
        const float g = (lane == 0 ? ex[0] : lane == 1 ? ex[1] : lane == 2 ? ex[2] : ex[3]) / es;
        const int lr = __hip_atomic_fetch_add(&lcnt[e], 1, __ATOMIC_RELAXED, __HIP_MEMORY_SCOPE_WORKGROUP);
        info[(r * 4 + lane) * 3 + 0] = e; info[(r * 4 + lane) * 3 + 1] = lr; info[(r * 4 + lane) * 3 + 2] = __builtin_bit_cast(int, g);
    }
}

__device__ __forceinline__ void p6_rows(const Args& a, LAS unsigned char* lds, int tid, int wave, int lane) {
    constexpr int WTS = 1028;
    LAS float* WT = (LAS float*)lds;
    LAS float* GT1 = WT + 32 * WTS; LAS float* A2 = GT1 + DM; LAS float* B2 = A2 + DM;
    LAS int* lcnt = (LAS int*)(B2 + DM); LAS int* lbase = lcnt + 32; LAS int* info = lbase + 32;
    unsigned char* ws = a.ws;
    const bf16_t* mix = (const bf16_t*)(ws + WS_MIX); unsigned char* hb8 = ws + WS_HB;
    int* cnt = (int*)(ws + WS_CTL) + CW_CNT; int* list = (int*)(ws + WS_LIST);
    int* route_e = (int*)(ws + WS_ROUTE); int* route_pos = route_e + MT * 4; float* gate = (float*)(route_pos + MT * 4);
    for (int i = tid; i < DM * NE; i += 512) WT[(i & 31) * WTS + (i >> 5)] = a.w_router[i];
    if (tid < 32) lcnt[tid] = 0;
    for (int blk = blockIdx.x; blk < MT / 64; blk += gridDim.x) {
        const int b = blk / 32;
        __syncthreads();
        for (int j = tid; j < DM; j += 512) { GT1[j] = mod_at(a, b, 2048 + j) * a.g_post_mix[j]; A2[j] = a.g_pre_ffn[j] * (1.f + mod_at(a, b, 4096 + j)); B2[j] = mod_at(a, b, 3072 + j); }
        __syncthreads();
#pragma unroll 1
        for (int it = 0; it < 4; ++it) {
            const int rA = wave + 16 * it, rB = rA + 8;
            const int ln = fresh_lane();
            f32x4 xa[4], xb[4];
            p6_front(a, mix, hb8, GT1, A2, B2, blk * 64 + rA, ln, xa);
            p6_front(a, mix, hb8, GT1, A2, B2, blk * 64 + rB, ln, xb);
            float pa[32], pb[32];
#pragma unroll
            for (int e = 0; e < 32; ++e) { f32x2v accA = (f32x2v){0.f, 0.f}, accB = (f32x2v){0.f, 0.f};
#pragma unroll
                for (int j = 0; j < 4; ++j) { const f32x4 wv = *(const LAS f32x4*)(WT + e * WTS + 4 * ln + 256 * j);
                    const f32x2v w01 = (f32x2v){wv[0], wv[1]}, w23 = (f32x2v){wv[2], wv[3]};
                    accA = __builtin_elementwise_fma((f32x2v){xa[j][0], xa[j][1]}, w01, accA); accA = __builtin_elementwise_fma((f32x2v){xa[j][2], xa[j][3]}, w23, accA);
                    accB = __builtin_elementwise_fma((f32x2v){xb[j][0], xb[j][1]}, w01, accB); accB = __builtin_elementwise_fma((f32x2v){xb[j][2], xb[j][3]}, w23, accB); }
                pa[e] = accA.x + accA.y; pb[e] = accB.x + accB.y; if ((e & 3) == 3) __builtin_amdgcn_sched_barrier(0); }
#pragma unroll 1
            for (int rr = 0; rr < 2; ++rr) {
                const int ln2 = fresh_lane();
                p6_route(a, pa, lcnt, info, rr ? rB : rA, ln2);
#pragma unroll
                for (int e = 0; e < 32; ++e) pa[e] = pb[e];
            }
        }
        __syncthreads();
        if (tid < 32) lbase[tid] = atomicAdd(cnt + CNT_STRIDE * tid, lcnt[tid]);
        __syncthreads();
        if (tid < 256) { const int e = info[tid * 3 + 0], p = lbase[e] + info[tid * 3 + 1]; const int row = blk * 64 + (tid >> 2);
            list[e * MT + p] = row; route_e[row * 4 + (tid & 3)] = e; route_pos[row * 4 + (tid & 3)] = p; gate[row * 4 + (tid & 3)] = __builtin_bit_cast(float, info[tid * 3 + 2]); }
        __syncthreads();
        if (tid < 32) lcnt[tid] = 0;
    }
}

__device__ __forceinline__ void p9_rows(const Args& a, LAS unsigned char* lds, const LAS int* ts, int tid, int wave, int lane) {
    LAS float* GT2 = (LAS float*)lds;
    unsigned char* ws = a.ws;
    const unsigned char* yb = ws + WS_YB;
    const int* route_e = (const int*)(ws + WS_ROUTE); const int* route_pos = route_e + MT * 4; const float* gate = (const float*)(route_pos + MT * 4);
    for (int blk = blockIdx.x; blk < MT / 64; blk += gridDim.x) {
        const int b = blk / 32;
        __syncthreads();
        for (int j = tid; j < DM; j += 512) GT2[j] = mod_at(a, b, 5120 + j) * a.g_post_ffn[j];
        __syncthreads();
#pragma unroll 1
        for (int r0 = wave; r0 < 64; r0 += 16) {
            i32x4 re[2], rp[2]; f32x4 gg[2];
#pragma unroll
            for (int q = 0; q < 2; ++q) { const int row = blk * 64 + r0 + 8 * q; re[q] = *(const i32x4*)(route_e + row * 4); rp[q] = *(const i32x4*)(route_pos + row * 4); gg[q] = *(const f32x4*)(gate + row * 4); }
            int yv[2][4][4]; f32x4 xo[2][4];
#pragma unroll
            for (int q = 0; q < 2; ++q) { const int row = blk * 64 + r0 + 8 * q;
#pragma unroll
                for (int k = 0; k < 4; ++k) { const int slot = ts[re[q][k]] * 256 + rp[q][k]; const int* yr = (const int*)(yb + (size_t)slot * FE) + lane;
#pragma unroll
                    for (int j = 0; j < 4; ++j) yv[q][k][j] = __builtin_nontemporal_load(yr + 64 * j); }
                const f32x4* orow = (const f32x4*)(a.out + (size_t)row * DM) + lane;
#pragma unroll
                for (int j = 0; j < 4; ++j) xo[q][j] = __builtin_nontemporal_load(orow + 64 * j); }
#pragma unroll
            for (int q = 0; q < 2; ++q) { const int row = blk * 64 + r0 + 8 * q;
                f32x4 f[4];
#pragma unroll
                for (int j = 0; j < 4; ++j) f[j] = (f32x4){0.f, 0.f, 0.f, 0.f};
#pragma unroll
                for (int k = 0; k < 4; ++k) { const float g = gg[q][k];
#pragma unroll
                    for (int j = 0; j < 4; ++j) { const int w = yv[q][k][j]; const f32x2v lo = __builtin_amdgcn_cvt_pk_f32_fp8(w, false), hi2 = __builtin_amdgcn_cvt_pk_f32_fp8(w, true); f[j] += (f32x4){lo.x, lo.y, hi2.x, hi2.y} * g; } }
                float ss = 0.f;
#pragma unroll
                for (int j = 0; j < 4; ++j) ss += (f[j][0] * f[j][0] + f[j][1] * f[j][1]) + (f[j][2] * f[j][2] + f[j][3] * f[j][3]);
                const float rstd = rsqrtf(wave_sum(ss) * (1.f / DM) + EPS);
                f32x4* orow = (f32x4*)(a.out + (size_t)row * DM) + lane;
#pragma unroll
                for (int j = 0; j < 4; ++j) { const f32x4 g2 = *(const LAS f32x4*)(GT2 + 4 * lane + 256 * j); __builtin_nontemporal_store(xo[q][j] + g2 * (f[j] * rstd), orow + 64 * j); }
            }
        }
    }
}

#define XB_TMO      128
#define XB_XCNT(j)  (256  + 64 * (j))
#define XB_XSUB(j)  (1280 + 64 * (j))
#define XB_XGEN(j)  (2304 + 64 * (j))
#define XB_TOP      3328
#define XB_TOPGEN   3392
#define XCD_BAR_WORDS 3456
#define XB_SPIN_CAP (1u << 22)
__device__ __forceinline__ unsigned xb_ld(unsigned* p)              { return __hip_atomic_load(p, __ATOMIC_RELAXED, __HIP_MEMORY_SCOPE_AGENT); }
__device__ __forceinline__ unsigned xb_add(unsigned* p, unsigned v) { return __hip_atomic_fetch_add(p, v, __ATOMIC_RELAXED, __HIP_MEMORY_SCOPE_AGENT); }
__device__ __forceinline__ unsigned xb_xcc_id() { return (unsigned)__builtin_amdgcn_s_getreg((3 << 11) | 20) & 0xFu; }
#define XB_SPIN(cond, bar) do { unsigned _sp = 0; while (cond) { __builtin_amdgcn_s_sleep(1); \
    if ((++_sp & 255u) == 0u) { if (xb_ld(&(bar)[XB_TMO])) break; if (_sp > XB_SPIN_CAP) { atomicAdd(&(bar)[XB_TMO], 1u); break; } } } } while (0)
struct XcdBarrier { unsigned* bar; unsigned x; volatile LAS unsigned* st; };
__device__ __forceinline__ void xcd_barrier_complete(unsigned* bar, unsigned x, unsigned& nloc, unsigned& nx) {
    const unsigned G = gridDim.x;
    unsigned sum, cnt, mine, sp = 0u;
    for (;;) {
        sum = 0u; cnt = 0u; mine = 0u;
#pragma unroll
        for (unsigned j = 0; j < 16; ++j) { const unsigned c = xb_ld(&bar[XB_XCNT(j)]); sum += c; cnt += (c > 0u) ? 1u : 0u; mine = (j == x) ? c : mine; }
        if (sum == G) break;
        __builtin_amdgcn_s_sleep(1);
        if ((++sp & 255u) == 0u) { if (xb_ld(&bar[XB_TMO])) break; if (sp > XB_SPIN_CAP) { atomicAdd(&bar[XB_TMO], 1u); break; } }
    }
    nloc = mine > 0u ? mine : 1u; nx = cnt > 0u ? cnt : 1u;
}
__device__ __forceinline__ void xcd_barrier(const XcdBarrier& b, bool leader_thread) {
    asm volatile("s_waitcnt vmcnt(0)" ::: "memory");
    __syncthreads();
    if (leader_thread) {
        unsigned* bar = b.bar;
        __builtin_amdgcn_s_waitcnt(0);
        unsigned nloc = b.st[0], nx = b.st[1];
        if (nloc == 0u) { xcd_barrier_complete(bar, b.x, nloc, nx); b.st[0] = nloc; b.st[1] = nx; }
        const unsigned old = xb_add(&bar[XB_XSUB(b.x)], 1u);
        const unsigned gen = old / nloc;
        if (old + 1u == (gen + 1u) * nloc) {
            __builtin_amdgcn_fence(__ATOMIC_RELEASE, "agent");
            asm volatile("s_waitcnt vmcnt(0)" ::: "memory");
            const unsigned og = xb_add(&bar[XB_TOP], 1u);
            const unsigned tg = og / nx;
            if (og + 1u == (tg + 1u) * nx) xb_add(&bar[XB_TOPGEN], 1u);
            else XB_SPIN(xb_ld(&bar[XB_TOPGEN]) == tg, bar);
            __builtin_amdgcn_fence(__ATOMIC_ACQUIRE, "agent");
            xb_add(&bar[XB_XGEN(b.x)], 1u);
            asm volatile("s_waitcnt vmcnt(0)" ::: "memory");
        } else {
            XB_SPIN(xb_ld(&bar[XB_XGEN(b.x)]) == gen, bar);
            __builtin_amdgcn_fence(__ATOMIC_ACQUIRE, "agent");
            asm volatile("s_waitcnt vmcnt(0)" ::: "memory");
        }
    }
    __syncthreads();
}

constexpr int N_PHASES = 10;
constexpr int CONV_EARLY = 5376;
__global__ void __launch_bounds__(512, 2) mk_fwd(Args a) {
    extern __shared__ __attribute__((aligned(16))) unsigned char lds_raw[];
    LAS unsigned char* lds = (LAS unsigned char*)lds_raw;
    const int wave = __builtin_amdgcn_readfirstlane(threadIdx.x >> 6);
    int lane, tid;
#define FRESH() do { lane = fresh_lane(); tid = wave * 64 + lane; } while (0)
    unsigned char* ws = a.ws;
    LAS int* ts = (LAS int*)(lds + LDS_CTRL);
    LAS int* cnts = ts + 40;
    const int lo = a.ph_lo, hi = a.ph_hi;
#ifndef PHASE_MASK
#define PHASE_MASK 0xFFFF
#endif
#define IN(k) (((PHASE_MASK >> (k)) & 1) && lo <= (k) && (k) < hi)
#define SEAM(k) do { if (IN(k) && IN((k) + 1)) { FRESH(); xcd_barrier(xb, tid == 0); } } while (0)
    XcdBarrier xb; xb.bar = (unsigned*)(ws + WS_CTL) + CW_BAR; xb.x = xb_xcc_id(); xb.st = (volatile LAS unsigned*)(lds + LDS_CTRL + 320);
    if (hi - lo > 1) {
        if (threadIdx.x == 0) { xb.st[0] = 0u; xb.st[1] = 0u; (void)xb_add(&xb.bar[XB_XCNT(xb.x)], 1u); }
        __syncthreads();
    }

    if (IN(0)) { FRESH(); p0_prologue(a, lds, tid, wave, lane); }
    SEAM(0);
    if (IN(1)) { FRESH(); p1_rows(a, lds, tid, wave, lane); }
    SEAM(1);
    if (IN(2)) {
        pg8::StaticOrder S; S.init(MT, NPROJ, gridDim.x, blockIdx.x, ws + WS_WIN, 2048);
        float* rcos = (float*)(ws + WS_ROPE);
        pg8::EpiInProj E{(bf16_t*)(ws + WS_PROJ), (float*)(ws + WS_SSQ), (float*)(ws + WS_SSQ) + MT * 4, (bf16_t*)(ws + WS_KM), (bf16_t*)(ws + WS_VTD), rcos, rcos + (size_t)MT * 16};
        __syncthreads();
        pg8::gemm_phase<pg8::EpiInProj, pg8::StaticOrder, true>(lds, ws + WS_HB, 2048, 2048, S, E, wave);
        if (gridDim.x == 256 && blockIdx.x >= 128) { __syncthreads(); FRESH(); moe_weights_phase(a, lds, wave, lane, 0, CONV_EARLY, (blockIdx.x - 128) * 8 + wave, 128 * 8); }
        else if (gridDim.x != 256 && blockIdx.x == 0) { __syncthreads(); FRESH(); moe_weights_phase(a, lds, wave, lane, 0, CONV_EARLY, wave, 8); }
    }
    SEAM(2);
    if (IN(3)) {
        float* rcos = (float*)(ws + WS_ROPE);
        __syncthreads();
#ifndef SUB3
#define SUB3 7
#endif
        if (SUB3 & 1) { pg8::StaticOrder S; S.init(MT, 768, gridDim.x, blockIdx.x, ws + WS_WQB, 512);
          pg8::EpiQb E{(bf16_t*)(ws + WS_QM), (const float*)(ws + WS_SSQ), rcos, rcos + (size_t)MT * 16, 0.10206207261596575f * LOG2E};
          pg8::gemm_phase<pg8::EpiQb, pg8::StaticOrder, true>(lds, (const bf16_t*)(ws + WS_PROJ) + PC_CQ, NPROJ * 2, 512, S, E, wave); }
        __syncthreads();
        if (SUB3 & 2) { pg8::StaticOrder S; S.init(MT, 1024, gridDim.x, blockIdx.x, ws + WS_WKVB, 512);
          pg8::EpiKvb E{(bf16_t*)(ws + WS_KM), (bf16_t*)(ws + WS_VTM), (const float*)(ws + WS_SSQ) + MT * 4};
          pg8::gemm_phase<pg8::EpiKvb, pg8::StaticOrder, true>(lds, (const bf16_t*)(ws + WS_PROJ) + PC_CKV, NPROJ * 2, 512, S, E, wave); }
        __syncthreads();
        FRESH();
        if (SUB3 & 4) for (int v = blockIdx.x; v < 256; v += gridDim.x) {
            const int b = v & 7, aa = v >> 3;
#pragma unroll 1
            for (int i = 0; i < 4; ++i) { const int tg = (i & 1) ? (32 * i + 31 - aa) : (32 * i + aa);
                idx_item(lds, (const bf16_t*)(ws + WS_PROJ), (unsigned*)(ws + WS_BITMAP), b, tg, wave, lane); }
        }
    }
    SEAM(3);
    if (IN(4)) {
        __syncthreads(); FRESH();
        LAS unsigned* tc = (LAS unsigned*)(lds + LDS_CTRL + 336);
        if (tid < 2) tc[tid] = 0u;
        __syncthreads();
        const int team = wave >> 2, wt = wave & 3;
        LAS unsigned char* tl = lds + team * (2 * 22272);
        unsigned tgen = 0u;
        for (int v0_ = blockIdx.x; v0_ < 256; v0_ += gridDim.x) {
            const int v = (gridDim.x == 256) ? ((v0_ & 7) * 32 + (v0_ >> 3)) : v0_;
            const int T = 2 * v + team, bh = T >> 3, b = bh >> 3, h = bh & 7, s2 = T & 7, kvh = h >> 2;
#pragma unroll 1
            for (int i = 0; i < 4; ++i) {
                const int qt = (i & 1) ? 15 - s2 : s2; const bool mla = ((i >> 1) == team);
                const int ln = fresh_lane(), tt = wt * 64 + ln;
                if (mla) attn_unit<96, false>(tl, b, qt, (const bf16_t*)(ws + WS_QM) + h * 96, 768, (const bf16_t*)(ws + WS_KM) + h * 96, 768,
                                              (const bf16_t*)(ws + WS_VTM) + (size_t)(b * 8 + h) * 64 * SEQ, (unsigned char*)(ws + WS_Y) + h * 64, nullptr, nullptr, 0.f, 0.f, tt, wt, ln, tc + team, tgen);
                else attn_unit<64, true>(tl, b, qt, (const bf16_t*)(ws + WS_PROJ) + PC_QD + h * 64, NPROJ, (const bf16_t*)(ws + WS_PROJ) + PC_KD + kvh * 64, NPROJ,
                                         (const bf16_t*)(ws + WS_VTD) + (size_t)(b * 2 + kvh) * 64 * SEQ, (unsigned char*)(ws + WS_Y) + 512 + h * 64, (const unsigned*)(ws + WS_BITMAP), a.pos,
                                         0.125f * LOG2E, exp2f(-(float)(h + 1)) * LOG2E, tt, wt, ln, tc + team, tgen);
            }
        }
    }
    SEAM(4);
    if (IN(5)) {
        pg8::StaticOrder S; S.init(MT, DM, gridDim.x, blockIdx.x, ws + WS_WO, 1024);
        pg8::EpiPlain E{(bf16_t*)(ws + WS_MIX), DM, 1.f / 64.f};
        __syncthreads();
        pg8::gemm_phase<pg8::EpiPlain, pg8::StaticOrder, true, true>(lds, ws + WS_Y, 1024, 1024, S, E, wave);
    }
    SEAM(5);
    if (IN(6)) { __syncthreads(); FRESH(); p6_rows(a, lds, tid, wave, lane); __syncthreads(); FRESH(); moe_weights_phase(a, lds, wave, lane, CONV_EARLY, 32 * 16 * 96, blockIdx.x * 8 + wave, gridDim.x * 8); }
    SEAM(6);
    if (IN(7) || IN(8) || IN(9)) {
        __syncthreads(); FRESH();
        if (tid == 0) { const int* cnt = (const int*)(ws + WS_CTL) + CW_CNT; int acc = 0;
            for (int e = 0; e < 32; ++e) { const int c = cnt[CNT_STRIDE * e]; ts[e] = acc; cnts[e] = c; acc += (c + 255) >> 8; }
            ts[32] = acc; }
        __syncthreads();
    }
    if (IN(7)) {
        pg8::MoeOrder<true> S; S.init(ts, cnts, (const int*)(ws + WS_LIST), ws + WS_W1T, 2048, 1024, 8, gridDim.x, blockIdx.x);
        pg8::EpiMoe1 E{ws + WS_ACT, a.b_mlp1};
        pg8::gemm_phase<pg8::EpiMoe1, pg8::MoeOrder<true>, true, true>(lds, ws + WS_HB, 1024, 1024, S, E, wave);
    }
    SEAM(7);
    if (IN(8)) {
        pg8::MoeOrder<false> S; S.init(ts, cnts, (const int*)(ws + WS_LIST), ws + WS_W2T, 1024, 1024, 4, gridDim.x, blockIdx.x);
        pg8::EpiMoe2 E{ws + WS_YB, a.b_mlp2};
        __syncthreads();
        pg8::gemm_phase<pg8::EpiMoe2, pg8::MoeOrder<false>, true, true>(lds, ws + WS_ACT, 1024, 1024, S, E, wave);
    }
    SEAM(8);
    if (IN(9)) { __syncthreads(); FRESH(); p9_rows(a, lds, ts, tid, wave, lane); }
#undef IN
#undef SEAM
}

extern "C" void kernel_launch(void* const* d_in, const int* in_sizes, int n_in, void* d_out, int out_size, void* d_ws, size_t ws_size, hipStream_t stream) {
    static int grid = 0;
    if (grid == 0) {
        if (n_in != 21 || out_size != MT * DM || ws_size < WS_END) { fprintf(stderr, "kernel_launch: unexpected shapes (n_in %d out %d ws %zu)\n", n_in, out_size, ws_size); grid = -1; return; }
        int dev = 0, cus = 0, per_cu = 0;
        hipGetDevice(&dev); hipDeviceGetAttribute(&cus, hipDeviceAttributeMultiprocessorCount, dev);
        if (hipFuncSetAttribute((const void*)mk_fwd, hipFuncAttributeMaxDynamicSharedMemorySize, LDS_BYTES) != hipSuccess) { fprintf(stderr, "kernel_launch: hipFuncSetAttribute failed\n"); grid = -1; return; }
        if (hipOccupancyMaxActiveBlocksPerMultiprocessor(&per_cu, (const void*)mk_fwd, 512, LDS_BYTES) != hipSuccess || per_cu < 1) { fprintf(stderr, "kernel_launch: occupancy query says %d\n", per_cu); per_cu = 1; }
        (void)hipGetLastError();
        grid = cus;
    }
    if (grid < 0) return;
    hipMemsetAsync((char*)d_ws + WS_CTL, 0, CTL_BYTES, stream);
    Args a{};
    a.x = (const float*)d_in[0]; a.c = (const float*)d_in[1]; a.pos = (const int*)d_in[2]; a.w_ada = (const float*)d_in[3]; a.b_ada = (const float*)d_in[4];
    a.g_pre_mix = (const float*)d_in[5]; a.g_post_mix = (const float*)d_in[6]; a.g_pre_ffn = (const float*)d_in[7]; a.g_post_ffn = (const float*)d_in[8];
    a.w_in = (const float*)d_in[9]; a.g_q_a = (const float*)d_in[10]; a.g_kv_a = (const float*)d_in[11]; a.w_q_b = (const float*)d_in[12]; a.w_kv_b = (const float*)d_in[13]; a.w_o = (const float*)d_in[14];
    a.w_router = (const float*)d_in[15]; a.b_router = (const float*)d_in[16]; a.w_mlp1 = (const float*)d_in[17]; a.b_mlp1 = (const float*)d_in[18]; a.w_mlp2 = (const float*)d_in[19]; a.b_mlp2 = (const float*)d_in[20];
    a.out = (float*)d_out; a.ws = (unsigned char*)d_ws;
#if MK_N_LAUNCHES == 1
    a.ph_lo = 0; a.ph_hi = N_PHASES;
    hipLaunchKernelGGL(mk_fwd, dim3(grid), dim3(512), LDS_BYTES, stream, a);
#else
    for (int p = 0; p < N_PHASES; ++p) { a.ph_lo = p; a.ph_hi = p + 1; hipLaunchKernelGGL(mk_fwd, dim3(grid), dim3(512), LDS_BYTES, stream, a); }
#endif
}
```

```cpp
#include <hip/hip_runtime.h>
#include <cstdio>
#include <cstdint>

#ifndef MK_N_LAUNCHES
#define MK_N_LAUNCHES 1
#endif

#define LAS __attribute__((address_space(3)))
typedef unsigned short bf16_t;
typedef short bf16x8 __attribute__((ext_vector_type(8)));
typedef float f32x4 __attribute__((ext_vector_type(4)));
typedef float f32x16 __attribute__((ext_vector_type(16)));
typedef unsigned u32x4 __attribute__((ext_vector_type(4)));
typedef unsigned u32x2 __attribute__((ext_vector_type(2)));
typedef int i32x4 __attribute__((ext_vector_type(4)));
typedef int i32x8 __attribute__((ext_vector_type(8)));

constexpr int NB = 8, SEQ = 2048, DM = 1024, MT = NB * SEQ;
constexpr int NE = 32, FE = 1024;
constexpr int NPROJ = 1536;
constexpr int PC_CQ = 0, PC_CKV = 256, PC_KROPE = 384, PC_KIDX = 416, PC_WIDX = 448, PC_QD = 512, PC_KD = 1024, PC_VD = 1152, PC_QIDX = 1280;
constexpr float EPS = 1e-6f;
constexpr float LOG2E = 1.4426950408889634f;
constexpr int MAXTILES = 288;
constexpr int NSLOT = MAXTILES * 256;

constexpr size_t MiB = 1u << 20;
constexpr size_t WS_CTL = 0, CTL_BYTES = 64 * 1024;
constexpr size_t WS_MODP = 1 * MiB;
constexpr size_t WS_ROPE = 3 * MiB;
constexpr size_t WS_SSQ = 5 * MiB;
constexpr size_t WS_ROUTE = 6 * MiB;
constexpr size_t WS_LIST = 7 * MiB;
constexpr size_t WS_WIN = 9 * MiB;
constexpr size_t WS_WQB = 12 * MiB;
constexpr size_t WS_WKVB = 13 * MiB;
constexpr size_t WS_WO = 14 * MiB;
constexpr size_t WS_BITMAP = 16 * MiB;
constexpr size_t WS_VTM = 20 * MiB;
constexpr size_t WS_VTD = 36 * MiB;
constexpr size_t WS_HB = 40 * MiB;
constexpr size_t WS_PROJ = 72 * MiB;
constexpr size_t WS_QM = 120 * MiB;
constexpr size_t WS_KM = 144 * MiB;
constexpr size_t WS_Y = 168 * MiB;
constexpr size_t WS_MIX = 200 * MiB;
constexpr size_t WS_W1T = 232 * MiB;
constexpr size_t WS_W2T = 360 * MiB;
constexpr size_t WS_ACT = 424 * MiB;
constexpr size_t WS_YB = 568 * MiB;
constexpr size_t WS_END = 712 * MiB;
constexpr int CW_CNT = 64, CNT_STRIDE = 64;
constexpr int CW_BAR = 8192;

constexpr int LDS_BYTES = 163840;
constexpr int LDS_CTRL = 163328;

__device__ __forceinline__ unsigned f2bf(float f) { unsigned u = __builtin_bit_cast(unsigned, f); return (u + 0x7fffu + ((u >> 16) & 1u)) >> 16; }
__device__ __forceinline__ unsigned pk2(float lo, float hi) { return f2bf(lo) | (f2bf(hi) << 16); }
__device__ __forceinline__ float bflo(unsigned u) { return __builtin_bit_cast(float, u << 16); }
__device__ __forceinline__ float bfhi(unsigned u) { return __builtin_bit_cast(float, u & 0xffff0000u); }
__device__ __forceinline__ float wave_sum(float v) {
#pragma unroll
    for (int o = 1; o < 64; o <<= 1) v += __shfl_xor(v, o);
    return v;
}
#define LDS_WAIT() asm volatile("s_waitcnt lgkmcnt(0)" ::: "memory")
__device__ __forceinline__ int fresh_lane() { int l = __builtin_amdgcn_mbcnt_hi(~0u, __builtin_amdgcn_mbcnt_lo(~0u, 0u)); asm volatile("" : "+v"(l)); return l; }

namespace pg8 {
constexpr int BM = 256, BK = 64, HALF = 128, HTB = HALF * BK * 2, STAGE_BYTES = 8 * HTB, NXCD = 8, WGM = 8;
__host__ __device__ __forceinline__ int lds_byte(int r, int c) { const int st = (r >> 4) * 2 + (c >> 5), rr = r & 15, cc = c & 31, ob = rr * 64 + cc * 2; return st * 1024 + (ob ^ (((ob >> 9) & 1) << 5)); }
__host__ __device__ __forceinline__ void stage_rc(int b, int& R, int& C) { const int st = b / 1024, sb = b % 1024, swz = sb ^ (((sb >> 9) & 1) << 5); R = (st >> 1) * 16 + swz / 64; C = (st & 1) * 32 + (swz % 64) / 2; }
__host__ __device__ __forceinline__ int perm32(int rho) { const int n = rho >> 4, i = rho & 15; return 8 * (i >> 2) + 4 * n + (i & 3); }

struct Unit { int pm, pn, e, mt; };

struct StaticOrder {
    static constexpr bool GATHER = false;
    int nM, nN, nwg, G, c; const char* Bt; int ldb;
    __device__ void init(int M, int N, int G_, int c_, const void* Bt_, int ldb_bytes) { nM = M / BM; nN = N / BM; nwg = nM * nN; G = G_; c = c_; Bt = (const char*)Bt_; ldb = ldb_bytes; }
    __device__ bool next(int i, Unit& u, int ehint = 0) const {
        const long L = (long)i * G + c; if (L >= nwg) return false;
        int wgid = (int)L; { const int q = nwg / NXCD, r = nwg % NXCD, xcd = wgid % NXCD, off = wgid / NXCD; wgid = (xcd < r ? xcd * (q + 1) : r * (q + 1) + (xcd - r) * q) + off; }
        const int nig = WGM * nN, gid = wgid / nig, fm = gid * WGM, gsz = (nM - fm) < WGM ? (nM - fm) : WGM;
        u.pm = fm + ((wgid % nig) % gsz); u.pn = (wgid % nig) / gsz; u.e = 0; u.mt = 0; return true;
    }
    __device__ __forceinline__ const char* bptr(const Unit& u) const { return Bt + (size_t)u.pn * BM * ldb; }
    __device__ __forceinline__ int arow(const Unit& u, int r) const { return u.pm * BM + r; }
};

template <bool GATHER_> struct MoeOrder {
    static constexpr bool GATHER = GATHER_;
    const LAS int* ts;
    const LAS int* cnts;
    const int* list;
    const char* Bt; int nrows_b  , ldb  , nN, G, c, nwg;
    __device__ void init(const LAS int* ts_, const LAS int* cnts_, const int* list_, const void* Bt_, int nrows_b_, int ldb_, int nN_, int G_, int c_) {
        ts = ts_; cnts = cnts_; list = list_; Bt = (const char*)Bt_; nrows_b = nrows_b_; ldb = ldb_; nN = nN_; G = G_; c = c_; nwg = __builtin_amdgcn_readfirstlane(ts_[32]) * nN_; }
    __device__ bool next(int i, Unit& u, int ehint = 0) const {
        const long L = (long)i * G + c; if (L >= nwg) return false;
        int wgid = (int)L; { const int q = nwg / NXCD, r = nwg % NXCD, xcd = wgid % NXCD, off = wgid / NXCD; wgid = (xcd < r ? xcd * (q + 1) : r * (q + 1) + (xcd - r) * q) + off; }
        int e = ehint;
        while (e < 31 && __builtin_amdgcn_readfirstlane(ts[e + 1]) * nN <= wgid) ++e;
        const int t0 = __builtin_amdgcn_readfirstlane(ts[e]), T = __builtin_amdgcn_readfirstlane(ts[e + 1]) - t0, local = wgid - t0 * nN;
        u.e = e; u.pn = local / T; u.mt = local % T; u.pm = t0 + u.mt; return true;
    }
    __device__ __forceinline__ const char* bptr(const Unit& u) const { return Bt + ((size_t)u.e * nrows_b + (size_t)u.pn * BM) * ldb; }
    __device__ __forceinline__ int arow(const Unit& u, int r) const {
        if (!GATHER) return u.pm * BM + r;
        const int p = u.mt * BM + r; return (p < cnts[u.e]) ? list[u.e * MT + p] : 0;
    }
};

__device__ __forceinline__ unsigned cvt_pk_bf16(float lo, float hi) { unsigned r; asm volatile("v_cvt_pk_bf16_f32 %0, %1, %2" : "=v"(r) : "v"(lo), "v"(hi)); return r; }
__device__ __forceinline__ u32x4 pack8(const f32x4& a, const f32x4& b) { u32x4 w; w.x = cvt_pk_bf16(a[0], a[1]); w.y = cvt_pk_bf16(a[2], a[3]); w.z = cvt_pk_bf16(b[0], b[1]); w.w = cvt_pk_bf16(b[2], b[3]); return w; }

template <class Epi, class Sched, bool ALIGN_EPI, bool FP8 = false>
__device__ __forceinline__ void gemm_phase(LAS unsigned char* lds, const void* A, int lda, int kbytes, const Sched& S, const Epi& E, int wid) {
    const int lane = fresh_lane(), tid = wid * 64 + lane, wr = wid >> 2, wc = wid & 3, fr = lane & 15, fq = lane >> 4;
    const int nt = kbytes / 128; const int ldb = S.ldb;
    constexpr bool GA = Sched::GATHER;
    unsigned voffB[2], voffA[2]; int RA[2]; unsigned CA[2];
#pragma unroll
    for (int i = 0; i < 2; ++i) { int R, C; stage_rc(tid * 16 + i * 8192, R, C); const int Rb = (R & ~31) + perm32(R & 31);
        RA[i] = R; CA[i] = (unsigned)C * 2u; voffA[i] = (unsigned)(R * lda) + (unsigned)C * 2u; voffB[i] = (unsigned)(Rb * ldb) + (unsigned)C * 2u; }
    const size_t hstepA = (size_t)HALF * lda;
    const size_t kstep = (size_t)(BK * 2);
    const size_t hstepB = (size_t)HALF * ldb;
    const unsigned ldsw = (unsigned)wid * 1024u;
    const int aoff = lds_byte(wr * 64 + fr, fq * 8), boff = lds_byte(wc * 32 + fr, fq * 8);
#define PG8_SA(b, h) (((b) * 2 + (h)) * HTB)
#define PG8_SB(b, h) ((4 + (b) * 2 + (h)) * HTB)
#define PG8_STAGE(bufoff, gbase, voff) do { _Pragma("unroll") for (int _i = 0; _i < 2; ++_i) \
        __builtin_amdgcn_global_load_lds((const unsigned*)((const char*)(gbase) + (voff)[_i]), (LAS unsigned*)(lds + (bufoff) + ldsw + _i * 8192), 16, 0, 0); } while (0)
#define PG8_LDA(dst, b, h) do { _Pragma("unroll") for (int m = 0; m < 4; ++m) _Pragma("unroll") for (int k = 0; k < 2; ++k) dst[m][k] = *(const LAS bf16x8*)(lds + PG8_SA(b, h) + aoff + m * 2048 + k * 1024); } while (0)
#define PG8_LDB(dst, b, h) do { _Pragma("unroll") for (int n = 0; n < 2; ++n) _Pragma("unroll") for (int k = 0; k < 2; ++k) dst[n][k] = *(const LAS bf16x8*)(lds + PG8_SB(b, h) + boff + n * 2048 + k * 1024); } while (0)
#define PG8_MMA(ai, bj, At, Bt) do { __builtin_amdgcn_s_setprio(1); \
        if constexpr (FP8) { _Pragma("unroll") for (int m = 0; m < 4; ++m) _Pragma("unroll") for (int n = 0; n < 2; ++n) { \
            const i32x8 bb_ = __builtin_shufflevector(__builtin_bit_cast(i32x4, Bt[n][0]), __builtin_bit_cast(i32x4, Bt[n][1]), 0, 1, 2, 3, 4, 5, 6, 7); \
            const i32x8 aa_ = __builtin_shufflevector(__builtin_bit_cast(i32x4, At[m][0]), __builtin_bit_cast(i32x4, At[m][1]), 0, 1, 2, 3, 4, 5, 6, 7); \
            asm volatile("v_mfma_scale_f32_16x16x128_f8f6f4 %0, %1, %2, %0, %3, %3 op_sel_hi:[0,0,0]" : "+v"(acc[ai][bj][m][n]) : "v"(bb_), "v"(aa_), "v"(sc1_)); } } \
        else { _Pragma("unroll") for (int m = 0; m < 4; ++m) _Pragma("unroll") for (int n = 0; n < 2; ++n) _Pragma("unroll") for (int k = 0; k < 2; ++k) \
            acc[ai][bj][m][n] = __builtin_amdgcn_mfma_f32_16x16x32_bf16(Bt[n][k], At[m][k], acc[ai][bj][m][n], 0, 0, 0); } \
        __builtin_amdgcn_s_setprio(0); } while (0)
#define PG8_WAIT_V(n) asm volatile("s_waitcnt vmcnt(" #n ")" ::: "memory")
#define PG8_WAIT_L(n) asm volatile("s_waitcnt lgkmcnt(" #n ")" ::: "memory")
#define PG8_BAR __builtin_amdgcn_s_barrier()
#define PG8_SCHED __builtin_amdgcn_sched_barrier(0)
#define PG8_STA(bufoff, nx, h, kb) do { if constexpr (GA) { unsigned _w[2]; _Pragma("unroll") for (int _i = 0; _i < 2; ++_i) _w[_i] = (nx) ? vN[h][_i] : vA[h][_i]; PG8_STAGE(bufoff, Ab + (kb), _w); } \
        else { PG8_STAGE(bufoff, ((nx) ? nA : cA) + (h) * hstepA + (kb), voffA); } } while (0)
#define PG8_AOFF(dst, u) do { _Pragma("unroll") for (int _h = 0; _h < 2; ++_h) _Pragma("unroll") for (int _i = 0; _i < 2; ++_i) \
        dst[_h][_i] = (unsigned)S.arow(u, _h * HALF + RA[_i]) * (unsigned)lda + CA[_i]; } while (0)
#define PG8_AROW(dst, u) do { _Pragma("unroll") for (int _h = 0; _h < 2; ++_h) _Pragma("unroll") for (int _i = 0; _i < 2; ++_i) \
        dst[_h][_i] = (unsigned)S.arow(u, _h * HALF + RA[_i]); } while (0)
    Unit cur, nxt; int ui = 0;
    if (!S.next(0, cur)) return;
    f32x4 acc[2][2][4][2];
#pragma unroll
    for (int a = 0; a < 2; ++a)
#pragma unroll
        for (int b = 0; b < 2; ++b)
#pragma unroll
            for (int m = 0; m < 4; ++m)
#pragma unroll
                for (int n = 0; n < 2; ++n) acc[a][b][m][n] = (f32x4){0.f, 0.f, 0.f, 0.f};
    bf16x8 At[4][2], B0[2][2], B1[2][2];
    int sc1_ = 0x7f7f7f7f; asm volatile("" : "+v"(sc1_));
    unsigned vA[2][2], vN[2][2];
    if constexpr (GA) { PG8_AOFF(vA, cur); }
    const char* Ab = (const char*)A;
    const char* cA = Ab + (size_t)S.arow(cur, 0) * lda; const char* nA = cA;
    const char* cB = S.bptr(cur);
    PG8_STAGE(PG8_SB(0, 0), cB, voffB); PG8_STAGE(PG8_SB(0, 1), cB + hstepB, voffB); PG8_STA(PG8_SA(0, 0), false, 0, 0); PG8_STA(PG8_SA(0, 1), false, 1, 0);
    if (wr == 1) PG8_BAR;
    PG8_WAIT_V(2); PG8_BAR;
    PG8_STAGE(PG8_SB(1, 0), cB + kstep, voffB); PG8_STA(PG8_SA(1, 0), false, 0, kstep); PG8_STAGE(PG8_SB(1, 1), cB + hstepB + kstep, voffB);
    PG8_WAIT_V(6); PG8_BAR;
    for (;;) {
        const bool has_next = S.next(ui + 1, nxt, cur.e);
        if constexpr (GA) { if (has_next) { PG8_AROW(vN, nxt); } else {
#pragma unroll
            for (int _h = 0; _h < 2; ++_h)
#pragma unroll
                for (int _i = 0; _i < 2; ++_i) vN[_h][_i] = vA[_h][_i]; } }
        else { nA = has_next ? Ab + (size_t)S.arow(nxt, 0) * lda : cA; }
        const char* nB = has_next ? S.bptr(nxt) : cB;
#pragma unroll 1
        for (int t = 0; t < nt; t += 2) {
            const bool last = (t == nt - 2);
            if constexpr (GA) { if (last && has_next) {
#pragma unroll
                for (int _h = 0; _h < 2; ++_h)
#pragma unroll
                    for (int _i = 0; _i < 2; ++_i) vN[_h][_i] = vN[_h][_i] * (unsigned)lda + CA[_i]; } }
            const size_t k1 = (size_t)(t + 1) * kstep, k2 = last ? 0 : (size_t)(t + 2) * kstep, k3 = k2 + kstep;
            const char* b2 = last ? nB : cB + (size_t)(t + 2) * kstep; const char* b3 = b2 + kstep;
            PG8_LDB(B0, 0, 0); PG8_LDB(B1, 0, 1); PG8_SCHED; PG8_LDA(At, 0, 0); PG8_STA(PG8_SA(1, 1), false, 1, k1);
            PG8_WAIT_V(8); PG8_WAIT_L(0); PG8_BAR; PG8_MMA(0, 0, At, B0); PG8_MMA(0, 1, At, B1); PG8_BAR; PG8_SCHED;
            PG8_LDA(At, 0, 1); PG8_STAGE(PG8_SB(0, 0), b2, voffB); PG8_STAGE(PG8_SB(0, 1), b2 + hstepB, voffB); PG8_STA(PG8_SA(0, 0), last, 0, k2);
            PG8_WAIT_V(8); PG8_WAIT_L(0); PG8_BAR; PG8_MMA(1, 0, At, B0); PG8_MMA(1, 1, At, B1); PG8_BAR; PG8_SCHED;
            PG8_LDB(B0, 1, 0); PG8_LDB(B1, 1, 1); PG8_SCHED; PG8_LDA(At, 1, 0); PG8_STA(PG8_SA(0, 1), last, 1, k2);
            PG8_WAIT_V(8); PG8_WAIT_L(0); PG8_BAR; PG8_MMA(0, 0, At, B0); PG8_MMA(0, 1, At, B1); PG8_BAR; PG8_SCHED;
            PG8_LDA(At, 1, 1); PG8_STAGE(PG8_SB(1, 0), b3, voffB); PG8_STAGE(PG8_SB(1, 1), b3 + hstepB, voffB); PG8_STA(PG8_SA(1, 0), last, 0, k3);
            PG8_WAIT_V(8); PG8_WAIT_L(0); PG8_BAR; PG8_MMA(1, 0, At, B0); PG8_MMA(1, 1, At, B1); PG8_BAR; PG8_SCHED;
        }
        if constexpr (ALIGN_EPI) { if (wr == 0) PG8_BAR; }
        if constexpr (FP8) asm volatile("s_nop 15\n\ts_nop 7" ::: "memory");
        E(acc, cur, wr, wc, fr, fq);
        if (!has_next) break;
#pragma unroll
        for (int a = 0; a < 2; ++a)
#pragma unroll
            for (int b = 0; b < 2; ++b)
#pragma unroll
                for (int m = 0; m < 4; ++m)
#pragma unroll
                    for (int n = 0; n < 2; ++n) acc[a][b][m][n] = (f32x4){0.f, 0.f, 0.f, 0.f};
        cur = nxt; cB = nB; cA = nA; ++ui;
        if constexpr (GA) {
#pragma unroll
        for (int _h = 0; _h < 2; ++_h)
#pragma unroll
            for (int _i = 0; _i < 2; ++_i) vA[_h][_i] = vN[_h][_i]; }
        if constexpr (ALIGN_EPI) { if (wr == 1) PG8_BAR; }
    }
    PG8_WAIT_V(0);
    if constexpr (!ALIGN_EPI) { if (wr == 0) PG8_BAR; }
    PG8_BAR;
#undef PG8_SA
#undef PG8_SB
#undef PG8_STAGE
#undef PG8_LDA
#undef PG8_LDB
#undef PG8_MMA
#undef PG8_WAIT_V
#undef PG8_WAIT_L
#undef PG8_BAR
#undef PG8_SCHED
#undef PG8_AOFF
#undef PG8_AROW
#undef PG8_STA
}

struct EpiPlain {
    bf16_t* O; int ldc; float scale;
    __device__ __forceinline__ void operator()(const f32x4 (&acc)[2][2][4][2], const Unit& u, int wr, int wc, int fr_, int fq_) const {
        int ln_ = __builtin_amdgcn_mbcnt_hi(~0u, __builtin_amdgcn_mbcnt_lo(~0u, 0u)); asm volatile("" : "+v"(ln_)); const int fr = ln_ & 15, fq = ln_ >> 4;
        const int row0 = u.pm * BM + wr * 64 + fr, col0 = u.pn * BM + wc * 32 + 8 * fq;
#pragma unroll
        for (int ai = 0; ai < 2; ++ai)
#pragma unroll
            for (int m = 0; m < 4; ++m) { bf16_t* rowp = O + (size_t)(row0 + ai * HALF + m * 16) * ldc + col0;
#pragma unroll
                for (int bj = 0; bj < 2; ++bj) *(u32x4*)(rowp + bj * HALF) = pack8(acc[ai][bj][m][0] * scale, acc[ai][bj][m][1] * scale); }
    }
};

struct EpiInProj {
    bf16_t* proj; float* ssq_q; float* ssq_kv; bf16_t* Km; bf16_t* Vtd; const float* rcos; const float* rsin;
    __device__ __forceinline__ void operator()(const f32x4 (&acc)[2][2][4][2], const Unit& u, int wr, int wc, int fr_, int fq_) const {
        int ln_ = __builtin_amdgcn_mbcnt_hi(~0u, __builtin_amdgcn_mbcnt_lo(~0u, 0u)); asm volatile("" : "+v"(ln_)); const int fr = ln_ & 15, fq = ln_ >> 4;
        const int row0 = u.pm * BM + wr * 64 + fr, col0 = u.pn * BM + wc * 32 + 8 * fq;
        const int pn = u.pn;
#pragma unroll
        for (int ai = 0; ai < 2; ++ai)
#pragma unroll
            for (int m = 0; m < 4; ++m) {
                const int row = row0 + ai * HALF + m * 16;
                bf16_t* rowp = proj + (size_t)row * NPROJ + col0;
                float sq = 0.f;
#pragma unroll
                for (int bj = 0; bj < 2; ++bj) {
                    const f32x4 v0 = acc[ai][bj][m][0], v1 = acc[ai][bj][m][1];
                    *(u32x4*)(rowp + bj * HALF) = pack8(v0, v1);
                    if (pn == 0 || (pn == 1 && bj == 0)) sq += (v0[0] * v0[0] + v0[1] * v0[1]) + (v0[2] * v0[2] + v0[3] * v0[3]) + (v1[0] * v1[0] + v1[1] * v1[1]) + (v1[2] * v1[2] + v1[3] * v1[3]);
                    if (pn == 1 && bj == 1 && wc == 0) {
                        const int i0 = 8 * (fq & 1);
                        const f32x4 c0 = *(const f32x4*)(rcos + (size_t)row * 16 + i0), c1 = *(const f32x4*)(rcos + (size_t)row * 16 + i0 + 4);
                        const f32x4 s0 = *(const f32x4*)(rsin + (size_t)row * 16 + i0), s1 = *(const f32x4*)(rsin + (size_t)row * 16 + i0 + 4);
                        f32x4 o0, o1; const float sg = (fq < 2) ? -1.f : 1.f;
#pragma unroll
                        for (int j = 0; j < 4; ++j) { const float p0 = __shfl_xor(v0[j], 32), p1 = __shfl_xor(v1[j], 32);
                            o0[j] = v0[j] * c0[j] + sg * p0 * s0[j]; o1[j] = v1[j] * c1[j] + sg * p1 * s1[j]; }
                        const u32x4 w = pack8(o0, o1);
#pragma unroll
                        for (int h = 0; h < 8; ++h) *(u32x4*)(Km + (size_t)row * 768 + h * 96 + 64 + 8 * fq) = w;
                    }
                    if (pn == 4 && bj == 1) {
                        const int b = row >> 11, s = row & 2047, cv0 = wc * 32 + 8 * fq;
#pragma unroll
                        for (int j = 0; j < 8; ++j) { const int cv = cv0 + j; const float val = (j < 4) ? v0[j & 3] : v1[j & 3];
                            Vtd[((size_t)(b * 2 + (cv >> 6)) * 64 + (cv & 63)) * SEQ + s] = (bf16_t)f2bf(val); }
                    }
                }
                if (pn <= 1) { sq += __shfl_xor(sq, 16); sq += __shfl_xor(sq, 32); if (fq == 0) (pn == 0 ? ssq_q : ssq_kv)[(size_t)row * 4 + wc] = sq; }
            }
    }
};

struct EpiQb {
    bf16_t* Qm; const float* ssq_q; const float* rcos; const float* rsin; float c2;
    __device__ __forceinline__ void operator()(const f32x4 (&acc)[2][2][4][2], const Unit& u, int wr, int wc, int fr_, int fq_) const {
        int ln_ = __builtin_amdgcn_mbcnt_hi(~0u, __builtin_amdgcn_mbcnt_lo(~0u, 0u)); asm volatile("" : "+v"(ln_)); const int fr = ln_ & 15, fq = ln_ >> 4;
        const int row0 = u.pm * BM + wr * 64 + fr, col0 = u.pn * BM + wc * 32 + 8 * fq;
#pragma unroll
        for (int ai = 0; ai < 2; ++ai)
#pragma unroll
            for (int m = 0; m < 4; ++m) {
                const int row = row0 + ai * HALF + m * 16;
                const f32x4 rs = *(const f32x4*)(ssq_q + (size_t)row * 4);
                const float rstd = rsqrtf(((rs[0] + rs[1]) + (rs[2] + rs[3])) * (1.f / 256.f) + EPS) * c2;
#pragma unroll
                for (int bj = 0; bj < 2; ++bj) {
                    f32x4 v0 = acc[ai][bj][m][0] * rstd, v1 = acc[ai][bj][m][1] * rstd;
                    const int G = 8 * u.pn + 4 * bj + wc;
                    if (G % 3 == 2) {
                        const int i0 = 8 * (fq & 1);
                        const f32x4 c0 = *(const f32x4*)(rcos + (size_t)row * 16 + i0), c1 = *(const f32x4*)(rcos + (size_t)row * 16 + i0 + 4);
                        const f32x4 s0 = *(const f32x4*)(rsin + (size_t)row * 16 + i0), s1 = *(const f32x4*)(rsin + (size_t)row * 16 + i0 + 4);
                        f32x4 o0, o1; const float sg = (fq < 2) ? -1.f : 1.f;
#pragma unroll
                        for (int j = 0; j < 4; ++j) { const float p0 = __shfl_xor(v0[j], 32), p1 = __shfl_xor(v1[j], 32);
                            o0[j] = v0[j] * c0[j] + sg * p0 * s0[j]; o1[j] = v1[j] * c1[j] + sg * p1 * s1[j]; }
                        v0 = o0; v1 = o1;
                    }
                    *(u32x4*)(Qm + (size_t)row * 768 + col0 + bj * HALF) = pack8(v0, v1);
                }
                asm volatile("" ::: "memory");
            }
    }
};

struct EpiKvb {
    bf16_t* Km; bf16_t* Vtm; const float* ssq_kv;
    __device__ __forceinline__ void operator()(const f32x4 (&acc)[2][2][4][2], const Unit& u, int wr, int wc, int fr_, int fq_) const {
        int ln_ = __builtin_amdgcn_mbcnt_hi(~0u, __builtin_amdgcn_mbcnt_lo(~0u, 0u)); asm volatile("" : "+v"(ln_)); const int fr = ln_ & 15, fq = ln_ >> 4;
        const int row0 = u.pm * BM + wr * 64 + fr, col0 = u.pn * BM + wc * 32 + 8 * fq;
#pragma unroll
        for (int ai = 0; ai < 2; ++ai)
#pragma unroll
            for (int m = 0; m < 4; ++m) {
                const int row = row0 + ai * HALF + m * 16;
                const f32x4 rs = *(const f32x4*)(ssq_kv + (size_t)row * 4);
                const float rstd = rsqrtf(((rs[0] + rs[1]) + (rs[2] + rs[3])) * (1.f / 128.f) + EPS);
#pragma unroll
                for (int bj = 0; bj < 2; ++bj) {
                    const f32x4 v0 = acc[ai][bj][m][0] * rstd, v1 = acc[ai][bj][m][1] * rstd;
                    const int col = col0 + bj * HALF;
                    if (u.pn < 2) { const int h = col >> 6, d = col & 63; *(u32x4*)(Km + (size_t)row * 768 + h * 96 + d) = pack8(v0, v1); }
                    else { const int cv = col - 512, h = cv >> 6, d0 = cv & 63, b = row >> 11, s = row & 2047;
#pragma unroll
                        for (int j = 0; j < 8; ++j) { const float val = (j < 4) ? v0[j & 3] : v1[j & 3];
                            Vtm[((size_t)(b * 8 + h) * 64 + d0 + j) * SEQ + s] = (bf16_t)f2bf(val); } }
                }
            }
    }
};

constexpr float W8_SCALE = 64.f, W8_INV = 1.f / 64.f;
struct EpiMoe1 {
    unsigned char* act; const float* b1;
    __device__ __forceinline__ void operator()(const f32x4 (&acc)[2][2][4][2], const Unit& u, int wr, int wc, int fr_, int fq_) const {
        int ln_ = __builtin_amdgcn_mbcnt_hi(~0u, __builtin_amdgcn_mbcnt_lo(~0u, 0u)); asm volatile("" : "+v"(ln_)); const int fr = ln_ & 15, fq = ln_ >> 4;
        const int row0 = u.pm * BM + wr * 64 + fr, col0 = u.pn * BM + wc * 32 + 8 * fq;
        f32x4 bv[2][2];
#pragma unroll
        for (int bj = 0; bj < 2; ++bj)
#pragma unroll
            for (int n = 0; n < 2; ++n) bv[bj][n] = *(const f32x4*)(b1 + (size_t)u.e * 2048 + col0 + bj * HALF + 4 * n);
#pragma unroll
        for (int ai = 0; ai < 2; ++ai)
#pragma unroll
            for (int m = 0; m < 4; ++m) {
                unsigned char* rowp = act + (size_t)(row0 + ai * HALF + m * 16) * FE + (col0 >> 1);
#pragma unroll
                for (int bj = 0; bj < 2; ++bj) {
                    const f32x4 v0 = acc[ai][bj][m][0] * W8_INV + bv[bj][0], v1 = acc[ai][bj][m][1] * W8_INV + bv[bj][1];
                    float o[4];
#pragma unroll
                    for (int p = 0; p < 4; ++p) { const float g = fminf((p < 2) ? v0[2 * (p & 1)] : v1[2 * (p & 1)], 7.f);
                        const float l = fminf(fmaxf((p < 2) ? v0[2 * (p & 1) + 1] : v1[2 * (p & 1) + 1], -7.f), 7.f);
                        const float sg = __builtin_amdgcn_rcpf(1.f + __builtin_amdgcn_exp2f(-1.702f * LOG2E * g));
                        o[p] = g * sg * (l + 1.f); }
                    int w = 0; w = __builtin_amdgcn_cvt_pk_fp8_f32(o[0], o[1], w, false); w = __builtin_amdgcn_cvt_pk_fp8_f32(o[2], o[3], w, true);
                    *(int*)(rowp + bj * (HALF / 2)) = w;
                }
            }
    }
};

struct EpiMoe2 {
    unsigned char* yb; const float* b2;
    __device__ __forceinline__ void operator()(const f32x4 (&acc)[2][2][4][2], const Unit& u, int wr, int wc, int fr_, int fq_) const {
        int ln_ = __builtin_amdgcn_mbcnt_hi(~0u, __builtin_amdgcn_mbcnt_lo(~0u, 0u)); asm volatile("" : "+v"(ln_)); const int fr = ln_ & 15, fq = ln_ >> 4;
        const int row0 = u.pm * BM + wr * 64 + fr, col0 = u.pn * BM + wc * 32 + 8 * fq;
        f32x4 bv[2][2];
#pragma unroll
        for (int bj = 0; bj < 2; ++bj)
#pragma unroll
            for (int n = 0; n < 2; ++n) bv[bj][n] = *(const f32x4*)(b2 + (size_t)u.e * 1024 + col0 + bj * HALF + 4 * n);
#pragma unroll
        for (int ai = 0; ai < 2; ++ai)
#pragma unroll
            for (int m = 0; m < 4; ++m) { unsigned char* rowp = yb + (size_t)(row0 + ai * HALF + m * 16) * FE + col0;
#pragma unroll
                for (int bj = 0; bj < 2; ++bj) { const f32x4 v0 = acc[ai][bj][m][0] * W8_INV + bv[bj][0], v1 = acc[ai][bj][m][1] * W8_INV + bv[bj][1];
                    int w0 = 0, w1 = 0; w0 = __builtin_amdgcn_cvt_pk_fp8_f32(v0[0], v0[1], w0, false); w0 = __builtin_amdgcn_cvt_pk_fp8_f32(v0[2], v0[3], w0, true);
                    w1 = __builtin_amdgcn_cvt_pk_fp8_f32(v1[0], v1[1], w1, false); w1 = __builtin_amdgcn_cvt_pk_fp8_f32(v1[2], v1[3], w1, true);
                    *(u32x2*)(rowp + bj * HALF) = (u32x2){(unsigned)w0, (unsigned)w1}; } }
    }
};
}

struct Args {
    const float* x; const float* c; const int* pos; const float* w_ada; const float* b_ada;
    const float* g_pre_mix; const float* g_post_mix; const float* g_pre_ffn; const float* g_post_ffn;
    const float* w_in; const float* g_q_a; const float* g_kv_a; const float* w_q_b; const float* w_kv_b; const float* w_o;
    const float* w_router; const float* b_router; const float* w_mlp1; const float* b_mlp1; const float* w_mlp2; const float* b_mlp2;
    float* out; unsigned char* ws; int ph_lo, ph_hi;
};

__device__ __forceinline__ unsigned cvt_pk_bf16_(float lo, float hi) { unsigned r; asm volatile("v_cvt_pk_bf16_f32 %0, %1, %2" : "=v"(r) : "v"(lo), "v"(hi)); return r; }
template <bool FP8>
__device__ __forceinline__ void transpose_item(const float* W, int ldw, int srccol0, int nvalid, bool kvalid, const float* kscale, float cscale,
                                               void* WT, int ldk, int dstrow0, int k0, LAS float* scr, int lane) {
    const int kr = lane >> 3, n4 = (lane & 7) * 4;
#pragma unroll
    for (int i = 0; i < 8; ++i) { const int kk = kr + 8 * i;
        f32x4 v = (f32x4){0.f, 0.f, 0.f, 0.f};
        if (kvalid && n4 < nvalid) { v = *(const f32x4*)(W + (size_t)(k0 + kk) * ldw + srccol0 + n4); float sc = cscale; if (kscale) sc *= kscale[k0 + kk]; v = v * sc; }
        *(LAS f32x4*)(scr + kk * 36 + n4) = v; }
    LDS_WAIT(); asm volatile("" ::: "memory");
    const int n = lane & 31, kh = lane >> 5;
    const LAS float* sp = scr + (32 * kh) * 36 + n;
    if constexpr (FP8) {
        int w[8];
#pragma unroll
        for (int q = 0; q < 8; ++q) { float f0 = sp[(4 * q) * 36], f1 = sp[(4 * q + 1) * 36], f2 = sp[(4 * q + 2) * 36], f3 = sp[(4 * q + 3) * 36];
            f0 = fminf(fmaxf(f0, -448.f), 448.f); f1 = fminf(fmaxf(f1, -448.f), 448.f); f2 = fminf(fmaxf(f2, -448.f), 448.f); f3 = fminf(fmaxf(f3, -448.f), 448.f);
            int t = 0; t = __builtin_amdgcn_cvt_pk_fp8_f32(f0, f1, t, false); t = __builtin_amdgcn_cvt_pk_fp8_f32(f2, f3, t, true); w[q] = t; }
        unsigned char* dst = (unsigned char*)WT + (size_t)(dstrow0 + n) * ldk + k0 + 32 * kh;
        *(i32x4*)dst = (i32x4){w[0], w[1], w[2], w[3]}; *(i32x4*)(dst + 16) = (i32x4){w[4], w[5], w[6], w[7]};
    } else {
        unsigned w[16];
#pragma unroll
        for (int q = 0; q < 16; ++q) w[q] = cvt_pk_bf16_(sp[(2 * q) * 36], sp[(2 * q + 1) * 36]);
        bf16_t* dst = (bf16_t*)WT + (size_t)(dstrow0 + n) * ldk + k0 + 32 * kh;
#pragma unroll
        for (int q = 0; q < 4; ++q) *(u32x4*)(dst + 8 * q) = (u32x4){w[4 * q], w[4 * q + 1], w[4 * q + 2], w[4 * q + 3]};
    }
    LDS_WAIT(); asm volatile("" ::: "memory");
}

__device__ __forceinline__ void moe_item_decode(const Args& a, int r, const float*& W, int& ldw, unsigned char*& WT, int& srccol, int& k0) {
    constexpr int I_M1 = 32 * 16 * 64;
    if (r < I_M1) { const int e = r / 1024, q = r % 1024, kb = q / 64, nb = q % 64; W = a.w_mlp1 + (size_t)e * 1024 * 2048; ldw = 2048; WT = a.ws + WS_W1T + (size_t)e * 2048 * 1024; srccol = 32 * nb; k0 = 64 * kb; }
    else { r -= I_M1; const int e = r / 512, q = r % 512, kb = q / 32, nb = q % 32; W = a.w_mlp2 + (size_t)e * 1024 * 1024; ldw = 1024; WT = a.ws + WS_W2T + (size_t)e * 1024 * 1024; srccol = 32 * nb; k0 = 64 * kb; }
}
__device__ __forceinline__ void moe_item_load(const Args& a, int r, f32x4 (&v)[8], int lane) {
    const float* W; int ldw, srccol, k0; unsigned char* WT; moe_item_decode(a, r, W, ldw, WT, srccol, k0);
    const int kr = lane >> 3, n4 = (lane & 7) * 4;
#pragma unroll
    for (int i = 0; i < 8; ++i) v[i] = __builtin_nontemporal_load((const f32x4*)(W + (size_t)(k0 + kr + 8 * i) * ldw + srccol + n4));
}
__device__ __forceinline__ void moe_item_finish(const Args& a, int r, const f32x4 (&v)[8], LAS float* scr, int lane) {
    const float* W; int ldw, srccol, k0; unsigned char* WT; moe_item_decode(a, r, W, ldw, WT, srccol, k0);
    const int kr = lane >> 3, n4 = (lane & 7) * 4;
#pragma unroll
    for (int i = 0; i < 8; ++i) *(LAS f32x4*)(scr + (kr + 8 * i) * 36 + n4) = v[i] * pg8::W8_SCALE;
    LDS_WAIT(); asm volatile("" ::: "memory");
    const int n = lane & 31, kh = lane >> 5;
    const LAS float* sp = scr + (32 * kh) * 36 + n;
    int w[8];
#pragma unroll
    for (int q = 0; q < 8; ++q) { float f0 = sp[(4 * q) * 36], f1 = sp[(4 * q + 1) * 36], f2 = sp[(4 * q + 2) * 36], f3 = sp[(4 * q + 3) * 36];
        f0 = fminf(fmaxf(f0, -448.f), 448.f); f1 = fminf(fmaxf(f1, -448.f), 448.f); f2 = fminf(fmaxf(f2, -448.f), 448.f); f3 = fminf(fmaxf(f3, -448.f), 448.f);
        int t = 0; t = __builtin_amdgcn_cvt_pk_fp8_f32(f0, f1, t, false); t = __builtin_amdgcn_cvt_pk_fp8_f32(f2, f3, t, true); w[q] = t; }
    unsigned char* dst = WT + (size_t)(srccol + n) * 1024 + k0 + 32 * kh;
    *(i32x4*)dst = (i32x4){w[0], w[1], w[2], w[3]}; *(i32x4*)(dst + 16) = (i32x4){w[4], w[5], w[6], w[7]};
    LDS_WAIT(); asm volatile("" ::: "memory");
}

__device__ __forceinline__ void p0_prologue(const Args& a, LAS unsigned char* lds, int tid, int wave, int lane) {
    unsigned char* ws = a.ws;
    LAS float* scr = (LAS float*)(lds + wave * 9216);
    LAS float* cond = (LAS float*)(lds + 8 * 9216);
    for (int i = tid; i < NB * DM; i += 512) { const float v = a.c[i]; cond[i] = v / (1.f + __expf(-v)); }
    __syncthreads();
    const int gw = blockIdx.x * 8 + wave, NGW = gridDim.x * 8;
    constexpr int I_ADA = 8 * 192, I_IN = 16 * 48, I_QB = 4 * 24, I_KVB = 4 * 32, I_O = 16 * 32, I_M1 = 32 * 16 * 64, I_M2 = 32 * 16 * 32;
    constexpr int NITEMS = I_ADA + I_IN + I_QB + I_KVB + I_O;
    float* modp = (float*)(ws + WS_MODP);
    for (int it = gw; it < NITEMS; it += NGW) {
        int r = it;
        if (r < I_ADA) {
            const int kc = r / 192, cc = r % 192, k0 = 128 * kc + (lane >> 3), c0 = 32 * cc + 4 * (lane & 7);
            f32x4 acc[8];
#pragma unroll
            for (int b = 0; b < 8; ++b) acc[b] = (f32x4){0.f, 0.f, 0.f, 0.f};
#pragma unroll 8
            for (int i = 0; i < 16; ++i) { const int k = k0 + 8 * i;
                const f32x4 w = __builtin_nontemporal_load((const f32x4*)(a.w_ada + (size_t)k * 6144 + c0));
#pragma unroll
                for (int b = 0; b < 8; ++b) acc[b] += w * cond[b * DM + k]; }
#pragma unroll
            for (int b = 0; b < 8; ++b) {
#pragma unroll
                for (int j = 0; j < 4; ++j) { float v = acc[b][j]; v += __shfl_xor(v, 8); v += __shfl_xor(v, 16); v += __shfl_xor(v, 32); acc[b][j] = v; }
                if (lane < 8) *(f32x4*)(modp + (size_t)(kc * 8 + b) * 6144 + c0) = acc[b]; }
            continue;
        }
        r -= I_ADA;
        if (r < I_IN) {
            const int kb = r / 48, nb = r % 48, j = 32 * nb; int src, nv = 32; float cs = 1.f;
            if (j < 416) src = j;
            else if (j < 448) src = 1440 + (j - 416);
            else if (j < 480) { src = 1472; nv = 8; cs = 0.35355339059327373f; }
            else if (j < 512) { src = 0; nv = 0; }
            else if (j < 1024) { src = 416 + (j - 512); cs = 0.125f * LOG2E; }
            else if (j < 1152) src = 928 + (j - 1024);
            else if (j < 1280) src = 1056 + (j - 1152);
            else { src = 1184 + (j - 1280); cs = 0.17677669529663687f; }
            transpose_item<false>(a.w_in, 1480, src, nv, true, nullptr, cs, (bf16_t*)(ws + WS_WIN), 1024, j, 64 * kb, scr, lane); continue;
        }
        r -= I_IN;
        if (r < I_QB) { const int kb = r / 24, nb = r % 24;
            transpose_item<false>(a.w_q_b, 768, 32 * nb, 32, true, a.g_q_a, 1.f, (bf16_t*)(ws + WS_WQB), 256, 32 * nb, 64 * kb, scr, lane); continue; }
        r -= I_QB;
        if (r < I_KVB) { const int kb = r / 32, nb = r % 32, j = 32 * nb; int src;
            if (j < 512) src = (j >> 6) * 128 + (j & 63); else { const int jj = j - 512; src = (jj >> 6) * 128 + 64 + (jj & 63); }
            transpose_item<false>(a.w_kv_b, 1024, src, 32, kb < 2, a.g_kv_a, 1.f, (bf16_t*)(ws + WS_WKVB), 256, j, 64 * kb, scr, lane); continue; }
        r -= I_KVB;
        if (r < I_O) { const int kb = r / 32, nb = r % 32;
            transpose_item<true>(a.w_o, 1024, 32 * nb, 32, true, nullptr, pg8::W8_SCALE, ws + WS_WO, 1024, 32 * nb, 64 * kb, scr, lane); continue; }
    }
}

__device__ __forceinline__ void moe_weights_phase(const Args& a, LAS unsigned char* lds, int wave, int lane, int r0, int r1, int gw, int NGW) {
    LAS float* scr = (LAS float*)(lds + wave * 9216);
    constexpr int I_M1 = 32 * 16 * 64, I_M2 = 32 * 16 * 32;
    {
        const int NM = r1;
        f32x4 va[8], vb[8];
        int r = r0 + gw;
        if (r < NM) moe_item_load(a, r, va, lane);
#pragma unroll 1
        while (r < NM) {
            int r2 = r + NGW; if (r2 < NM) moe_item_load(a, r2, vb, lane);
            moe_item_finish(a, r, va, scr, lane);
            r = r2; if (r >= NM) break;
            r2 = r + NGW; if (r2 < NM) moe_item_load(a, r2, va, lane);
            moe_item_finish(a, r, vb, scr, lane);
            r = r2;
        }
    }
}

__device__ __forceinline__ float mod_at(const Args& a, int b, int j) {
    const float* modp = (const float*)(a.ws + WS_MODP);
    float s = a.b_ada[j];
#pragma unroll
    for (int kc = 0; kc < 8; ++kc) s += modp[(size_t)(kc * 8 + b) * 6144 + j];
    return s;
}

__device__ __forceinline__ void p1_rows(const Args& a, LAS unsigned char* lds, int tid, int wave, int lane) {
    LAS float* Amul = (LAS float*)lds; LAS float* Badd = Amul + DM;
    bf16_t* hb = (bf16_t*)(a.ws + WS_HB);
    float* rcos = (float*)(a.ws + WS_ROPE); float* rsin = rcos + (size_t)MT * 16;
    for (int blk = blockIdx.x; blk < MT / 64; blk += gridDim.x) {
        const int b = blk / 32;
        __syncthreads();
        for (int j = tid; j < DM; j += 512) { const float sh = mod_at(a, b, j), sc = mod_at(a, b, 1024 + j); Amul[j] = a.g_pre_mix[j] * (1.f + sc); Badd[j] = sh; }
        __syncthreads();
#pragma unroll 1
        for (int r0 = wave; r0 < 64; r0 += 32) {
            f32x4 v[4][4];
#pragma unroll
            for (int q = 0; q < 4; ++q) { const f32x4* xr = (const f32x4*)(a.x + (size_t)(blk * 64 + r0 + 8 * q) * DM) + lane;
#pragma unroll
                for (int j = 0; j < 4; ++j) v[q][j] = __builtin_nontemporal_load(xr + 64 * j); }
#pragma unroll
            for (int q = 0; q < 4; ++q) {
                const int row = blk * 64 + r0 + 8 * q;
                float ss = 0.f;
#pragma unroll
                for (int j = 0; j < 4; ++j) ss += (v[q][j][0] * v[q][j][0] + v[q][j][1] * v[q][j][1]) + (v[q][j][2] * v[q][j][2] + v[q][j][3] * v[q][j][3]);
                const float rstd = rsqrtf(wave_sum(ss) * (1.f / DM) + EPS);
                unsigned long long* o8 = (unsigned long long*)(hb + (size_t)row * DM) + lane;
#pragma unroll
                for (int j = 0; j < 4; ++j) { const f32x4 am = *(const LAS f32x4*)(Amul + 4 * lane + 256 * j), bd = *(const LAS f32x4*)(Badd + 4 * lane + 256 * j);
                    const f32x4 h = v[q][j] * rstd * am + bd;
                    o8[64 * j] = (unsigned long long)pk2(h[0], h[1]) | ((unsigned long long)pk2(h[2], h[3]) << 32); }
                if (lane < 16) { const float fr = powf(10000.f, -(float)lane / 16.f); const float ang = (float)a.pos[row] * fr; float sn, cs; sincosf(ang, &sn, &cs);
                    rcos[(size_t)row * 16 + lane] = cs; rsin[(size_t)row * 16 + lane] = sn; }
            }
        }
    }
}

__device__ __forceinline__ unsigned sortable(float v) { const unsigned u = __builtin_bit_cast(unsigned, v + 0.0f); return (u & 0x80000000u) ? ~u : (u | 0x80000000u); }

__device__ __forceinline__ unsigned wave_max_u(unsigned v) {
#pragma unroll
    for (int o = 1; o < 64; o <<= 1) { const unsigned w = (unsigned)__shfl_xor((int)v, o); v = v > w ? v : w; }
    return v; }
__device__ __forceinline__ unsigned wave_min_u(unsigned v) {
#pragma unroll
    for (int o = 1; o < 64; o <<= 1) { const unsigned w = (unsigned)__shfl_xor((int)v, o); v = v < w ? v : w; }
    return v; }

template <int NR>
__device__ __forceinline__ void idx_item(LAS unsigned char* lds, const bf16_t* proj, unsigned* bitmap, int b, int tg, int wave, int lane) {
    constexpr int SCS = 2052;
    LAS float* sc = (LAS float*)lds;
    LAS unsigned* cbuf = (LAS unsigned*)(lds + 16 * SCS * 4) + wave * 64;
    const int t0 = tg * 16, nkt = tg + 1;
    const int n = lane & 15, kq = lane >> 4;
    const size_t rowq = (size_t)(b * SEQ + t0 + n);
    bf16x8 qf[8];
#pragma unroll
    for (int h = 0; h < 8; ++h) qf[h] = *(const bf16x8*)(proj + rowq * NPROJ + PC_QIDX + h * 32 + 8 * kq);
    const u32x4 wraw = *(const u32x4*)(proj + rowq * NPROJ + PC_WIDX);
    float w[8]; w[0] = bflo(wraw.x); w[1] = bfhi(wraw.x); w[2] = bflo(wraw.y); w[3] = bfhi(wraw.y); w[4] = bflo(wraw.z); w[5] = bfhi(wraw.z); w[6] = bflo(wraw.w); w[7] = bfhi(wraw.w);
#pragma unroll 1
    for (int base = wave; base < nkt; base += 64) {
        bf16x8 kf[8];
#pragma unroll
        for (int i = 0; i < 8; ++i) { const int kt = base + 8 * i; if (kt < nkt) kf[i] = *(const bf16x8*)(proj + (size_t)(b * SEQ + 16 * kt + n) * NPROJ + PC_KIDX + 8 * kq); }
#pragma unroll
        for (int i = 0; i < 8; ++i) { const int kt = base + 8 * i;
            if (kt < nkt) {
                f32x4 s = (f32x4){0.f, 0.f, 0.f, 0.f};
#pragma unroll
                for (int h = 0; h < 8; ++h) { const f32x4 d = __builtin_amdgcn_mfma_f32_16x16x32_bf16(kf[i], qf[h], (f32x4){0.f, 0.f, 0.f, 0.f}, 0, 0, 0);
#pragma unroll
                    for (int j = 0; j < 4; ++j) s[j] = fmaf(w[h], fmaxf(d[j], 0.f), s[j]); }
                *(LAS f32x4*)(sc + n * SCS + 16 * kt + 4 * kq) = s;
            } }
    }
    __syncthreads();
#pragma unroll 1
    for (int qq = 0; qq < 2; ++qq) {
        const int q = 2 * wave + qq, t = t0 + q;
        unsigned key[NR];
#pragma unroll
        for (int j = 0; j < NR; ++j) key[j] = __builtin_bit_cast(unsigned, sc[q * SCS + 64 * j + lane]);
#pragma unroll
        for (int j = 0; j < NR; j += 8) asm volatile("" : "+v"(key[j]), "+v"(key[j + 1]), "+v"(key[j + 2]), "+v"(key[j + 3]), "+v"(key[j + 4]), "+v"(key[j + 5]), "+v"(key[j + 6]), "+v"(key[j + 7]));
#pragma unroll
        for (int j = 0; j < NR; ++j) key[j] = (64 * j + lane <= t) ? sortable(__builtin_bit_cast(float, key[j])) : 0u;
        unsigned long long mine = 0ull; int lo_ = lane; asm volatile("" : "+v"(lo_));
        const unsigned long long lt = (1ull << lane) - 1ull;
        if (t + 1 > 256) {
            unsigned mx = key[0], mn = key[0] ? key[0] : 0xffffffffu;
#pragma unroll
            for (int j = 1; j < NR; ++j) { mx = mx > key[j] ? mx : key[j]; const unsigned kk = key[j] ? key[j] : 0xffffffffu; mn = mn < kk ? mn : kk; }
            mx = wave_max_u(mx); mn = wave_min_u(mn);
            mx = (unsigned)__builtin_amdgcn_readfirstlane((int)mx); mn = (unsigned)__builtin_amdgcn_readfirstlane((int)mn);
            unsigned T = mx; int hiCnt = 0, ngt = 0, neq = 0; bool have = false;
            const unsigned diff = mx ^ mn;
            if (diff != 0u) {
                int bit = 31 - __builtin_clz(diff);
                T = mx & ~(((2u << bit) - 1u));
                int cntT = t + 1;
#pragma unroll 1
                while (bit >= 0 && cntT - hiCnt > 64) {
                    const unsigned cand = T | (1u << bit); unsigned cl = 0u;
#pragma unroll
                    for (int j = 0; j < NR; ++j) cl += (key[j] >= cand) ? 1u : 0u;
                    int c = 0;
#pragma unroll
                    for (int bb = 0; bb < 6; ++bb) c += __popcll(__ballot((cl >> bb) & 1u)) << bb;
                    if (c >= 256) { T = cand; cntT = c; } else hiCnt = c;
                    --bit;
                }
                if (bit >= 0) {
                    const unsigned span = (2u << bit) - 1u; int run = 0;
#pragma unroll
                    for (int j = 0; j < NR; ++j) { const bool in = (key[j] != 0u) && ((key[j] - T) <= span); const unsigned long long m = __ballot(in);
                        if (in) cbuf[run + __popcll(m & lt)] = key[j]; run += __popcll(m); if ((j & 3) == 3) __builtin_amdgcn_sched_barrier(0); }
                    LDS_WAIT();
                    const unsigned ck = (lane < run) ? cbuf[lane] : 0u;
#pragma unroll 1
                    for (; bit >= 0; --bit) { const unsigned cand = T | (1u << bit); const int c = __popcll(__ballot(ck >= cand)); if (hiCnt + c >= 256) T = cand; }
                    ngt = hiCnt + __popcll(__ballot(ck > T)); neq = __popcll(__ballot(ck == T)); have = true;
                }
            }
            if (!have) {
#pragma unroll
                for (int j = 0; j < NR; ++j) { ngt += __popcll(__ballot(key[j] > T)); neq += __popcll(__ballot(key[j] == T)); if ((j & 3) == 3) __builtin_amdgcn_sched_barrier(0); }
            }
            const int need = 256 - ngt;
            asm volatile("" : "+s"(T));
            if (neq == need) {
#pragma unroll
                for (int j = 0; j < NR; ++j) { const unsigned long long mk = __ballot(key[j] >= T); mine = (lo_ == j) ? mk : mine; if ((j & 3) == 3) __builtin_amdgcn_sched_barrier(0); }
            } else {
                int run = 0;
#pragma unroll
                for (int j = 0; j < NR; ++j) { const bool eq = key[j] == T; const unsigned long long em = __ballot(eq); const int rank = run + __popcll(em & lt);
                    const unsigned long long mk = __ballot(key[j] > T || (eq && rank < need)); mine = (lo_ == j) ? mk : mine; run += __popcll(em); if ((j & 3) == 3) __builtin_amdgcn_sched_barrier(0); }
            }
        } else {
#pragma unroll
            for (int j = 0; j < 4; ++j) { const unsigned long long mk = __ballot(64 * j + lo_ <= t); mine = (lo_ == j) ? mk : mine; }
        }
        if (lane < 32) ((unsigned long long*)bitmap)[(size_t)(b * SEQ + t) * 32 + lane] = mine;
    }
    __syncthreads();
}

__device__ __forceinline__ int crow(int r, int hi) { return (r & 3) + 8 * (r >> 2) + 4 * hi; }
typedef float f32x2_t __attribute__((ext_vector_type(2))); typedef __bf16 bf16x2_t __attribute__((ext_vector_type(2)));
__device__ __forceinline__ unsigned cvtpk(float lo, float hi) { f32x2_t v = {lo, hi}; bf16x2_t b = __builtin_convertvector(v, bf16x2_t); return __builtin_bit_cast(unsigned, b); }

template <int DQK, bool DSA>
__device__ __forceinline__ void attn_unit(LAS unsigned char* lds, int b, int qt,
                                          const bf16_t* Qp, int ldq, const bf16_t* Kp, int ldk, const bf16_t* Vt, unsigned char* Yp,
                                          const unsigned* bitmap, const int* pos, float c1, float aslope, int tid, int wave, int lane, LAS unsigned* tctr, unsigned& tgen) {
    constexpr int KSTR = DQK * 2 + 16, KBYTES = 64 * KSTR, VSTR = 136, VBYTES = 64 * VSTR, BUF = KBYTES + VBYTES + 256, NKS = DQK / 16, CPR = DQK / 8, NCH = 64 * CPR;
    const int hi = lane >> 5, l31 = lane & 31;
    const int NT = 2 * (qt + 1);
    const int qw0 = 128 * qt + 32 * wave, tq = qw0 + l31;
    const size_t rowq = (size_t)(b * SEQ + tq);
    bf16x8 qf[NKS];
#pragma unroll
    for (int ks = 0; ks < NKS; ++ks) qf[ks] = *(const bf16x8*)(Qp + rowq * ldq + 16 * ks + 8 * hi);
    float ptq = 0.f; if (DSA) ptq = (float)pos[b * SEQ + tq];
    constexpr float THR = 4.0f;
    float mref = 0.f, lrun = 0.f; bool seen = false; f32x16 o[2], negm;
#pragma unroll
    for (int r = 0; r < 16; ++r) { o[0][r] = 0.f; o[1][r] = 0.f; negm[r] = 0.f; }
    u32x4 kreg[NCH / 256], vreg[2]; float preg = 0.f;
#define TEAM_BAR() do { asm volatile("s_waitcnt lgkmcnt(0)" ::: "memory"); tgen += 4u; \
        if (lane == 0) (void)__hip_atomic_fetch_add(tctr, 1u, __ATOMIC_RELAXED, __HIP_MEMORY_SCOPE_WORKGROUP); \
        while ((unsigned)__builtin_amdgcn_readfirstlane((int)__hip_atomic_load(tctr, __ATOMIC_RELAXED, __HIP_MEMORY_SCOPE_WORKGROUP)) < tgen) __builtin_amdgcn_s_sleep(0); \
        asm volatile("" ::: "memory"); } while (0)
#define ATT_LOAD(t) do { const size_t kb_ = (size_t)(b * SEQ + 64 * (t)); \
        _Pragma("unroll") for (int i_ = 0; i_ < NCH / 256; ++i_) { const int c_ = tid + 256 * i_; kreg[i_] = *(const u32x4*)(Kp + (kb_ + c_ / CPR) * ldk + 8 * (c_ % CPR)); } \
        _Pragma("unroll") for (int i_ = 0; i_ < 2; ++i_) { const int c_ = tid + 256 * i_; vreg[i_] = *(const u32x4*)(Vt + (size_t)(c_ >> 3) * SEQ + 64 * (t) + 8 * (c_ & 7)); } \
        if (DSA && tid < 64) preg = (float)pos[b * SEQ + 64 * (t) + tid]; } while (0)
#define ATT_WRITE(bufi) do { LAS unsigned char* bb_ = lds + (bufi) * BUF; \
        _Pragma("unroll") for (int i_ = 0; i_ < NCH / 256; ++i_) { const int c_ = tid + 256 * i_; *(LAS u32x4*)(bb_ + (c_ / CPR) * KSTR + 16 * (c_ % CPR)) = kreg[i_]; } \
        _Pragma("unroll") for (int i_ = 0; i_ < 2; ++i_) { const int c_ = tid + 256 * i_; \
            *(LAS u32x2*)(bb_ + KBYTES + (c_ >> 3) * VSTR + 16 * (c_ & 7)) = (u32x2){vreg[i_].x, vreg[i_].y}; *(LAS u32x2*)(bb_ + KBYTES + (c_ >> 3) * VSTR + 16 * (c_ & 7) + 8) = (u32x2){vreg[i_].z, vreg[i_].w}; } \
        if (DSA && tid < 64) *(LAS float*)(bb_ + KBYTES + VBYTES + 4 * tid) = preg; } while (0)
    u32x2 bwn = (u32x2){0u, 0u}; if (DSA) bwn = *(const u32x2*)(bitmap + rowq * 64);
    ATT_LOAD(0); ATT_WRITE(0); TEAM_BAR();
    for (int t = 0; t < NT; ++t) {
        const u32x2 bw = bwn; if (DSA && t + 1 < NT) bwn = *(const u32x2*)(bitmap + rowq * 64 + 2 * (t + 1));
        if (t + 1 < NT) ATT_LOAD(t + 1);
        if (64 * t <= qw0 + 31) {
            const LAS unsigned char* bb = lds + (t & 1) * BUF;
            f32x16 s0 = negm, s1 = negm;
            bf16x8 kfa[NKS], kfb[NKS];
#pragma unroll
            for (int ks = 0; ks < NKS; ++ks) { kfa[ks] = *(const LAS bf16x8*)(bb + l31 * KSTR + 32 * ks + 16 * hi); kfb[ks] = *(const LAS bf16x8*)(bb + (32 + l31) * KSTR + 32 * ks + 16 * hi); }
            __builtin_amdgcn_sched_barrier(0);
#pragma unroll
            for (int ks = 0; ks < NKS; ++ks) {
                s0 = __builtin_amdgcn_mfma_f32_32x32x16_bf16(kfa[ks], qf[ks], s0, 0, 0, 0);
                s1 = __builtin_amdgcn_mfma_f32_32x32x16_bf16(kfb[ks], qf[ks], s1, 0, 0, 0);
            }
            __builtin_amdgcn_sched_barrier(0);
            const LAS unsigned char* vb = bb + KBYTES;
            u32x2 vlo[8], vhi[8];
#pragma unroll
            for (int kk = 0; kk < 2; ++kk)
#pragma unroll
                for (int s = 0; s < 2; ++s)
#pragma unroll
                    for (int db = 0; db < 2; ++db) { const LAS unsigned char* va = vb + (32 * db + l31) * VSTR + (32 * kk + 16 * s + 4 * hi) * 2;
                        vlo[(kk * 2 + s) * 2 + db] = *(const LAS u32x2*)va; vhi[(kk * 2 + s) * 2 + db] = *(const LAS u32x2*)(va + 16); }
            __builtin_amdgcn_sched_barrier(0);
            if (DSA) {
                asm volatile("s_nop 15\n\ts_nop 3" ::: "memory");
                __builtin_amdgcn_sched_barrier(0);
                const unsigned w0 = bw.x >> (4 * hi), w1 = bw.y >> (4 * hi);
                const LAS float* pp = (const LAS float*)(bb + KBYTES + VBYTES);
                const float nega = -aslope; const unsigned ninf = 0xff800000u;
#define DSA_EL(S, PK, W, BIT) do { float t_, v_; unsigned m_, r_; \
                    asm("v_sub_f32 %0, %1, %2" : "=v"(t_) : "v"(ptq), "v"(PK)); \
                    asm("v_fma_f32 %0, %1, |%2|, %3" : "=v"(v_) : "s"(nega), "v"(t_), "v"(S)); \
                    asm("v_bfe_i32 %0, %1, %2, 1" : "=v"(m_) : "v"(W), "n"(BIT)); \
                    asm("v_bfi_b32 %0, %1, %2, %3" : "=v"(r_) : "v"(m_), "v"(v_), "s"(ninf)); \
                    S = __builtin_bit_cast(float, r_); } while (0)
#pragma unroll
                for (int g = 0; g < 4; ++g) {
                    const f32x4 p0 = *(const LAS f32x4*)(pp + 8 * g + 4 * hi), p1 = *(const LAS f32x4*)(pp + 32 + 8 * g + 4 * hi);
                    DSA_EL(s0[4 * g + 0], p0[0], w0, 8 * g + 0); DSA_EL(s0[4 * g + 1], p0[1], w0, 8 * g + 1); DSA_EL(s0[4 * g + 2], p0[2], w0, 8 * g + 2); DSA_EL(s0[4 * g + 3], p0[3], w0, 8 * g + 3);
                    DSA_EL(s1[4 * g + 0], p1[0], w1, 8 * g + 0); DSA_EL(s1[4 * g + 1], p1[1], w1, 8 * g + 1); DSA_EL(s1[4 * g + 2], p1[2], w1, 8 * g + 2); DSA_EL(s1[4 * g + 3], p1[3], w1, 8 * g + 3);
                }
#undef DSA_EL
            } else {
                if (64 * t + 63 > qw0) {
#pragma unroll
                    for (int r = 0; r < 16; ++r) { const int key = 64 * t + crow(r, hi); if (key > tq) s0[r] = -INFINITY; if (key + 32 > tq) s1[r] = -INFINITY; }
                }
            }
            float mx;
            { float m0 = fmaxf(fmaxf(s0[0], s0[1]), s0[2]), m1 = fmaxf(fmaxf(s0[3], s0[4]), s0[5]), m2 = fmaxf(fmaxf(s1[0], s1[1]), s1[2]), m3 = fmaxf(fmaxf(s1[3], s1[4]), s1[5]);
              m0 = fmaxf(fmaxf(m0, s0[6]), s0[7]); m1 = fmaxf(fmaxf(m1, s0[8]), s0[9]); m2 = fmaxf(fmaxf(m2, s1[6]), s1[7]); m3 = fmaxf(fmaxf(m3, s1[8]), s1[9]);
              m0 = fmaxf(fmaxf(m0, s0[10]), s0[11]); m1 = fmaxf(fmaxf(m1, s0[12]), s0[13]); m2 = fmaxf(fmaxf(m2, s1[10]), s1[11]); m3 = fmaxf(fmaxf(m3, s1[12]), s1[13]);
              m0 = fmaxf(fmaxf(m0, s0[14]), s0[15]); m2 = fmaxf(fmaxf(m2, s1[14]), s1[15]);
              mx = fmaxf(fmaxf(m0, m1), fmaxf(m2, m3)); }
            mx = fmaxf(mx, __shfl_xor(mx, 32));
            {
                const bool fin = mx > -INFINITY, first = fin && !seen, upd = first || (mx > THR);
                if (__any(upd)) {
                    const float dl = upd ? mx : 0.f;
                    const float alpha = first ? 1.f : __builtin_amdgcn_exp2f(-dl);
                    mref += dl; lrun *= alpha;
#pragma unroll
                    for (int r = 0; r < 16; ++r) { s0[r] -= dl; s1[r] -= dl; o[0][r] *= alpha; o[1][r] *= alpha; negm[r] = -mref; }
                }
                seen = seen || fin;
            }
            float psum = 0.f;
#pragma unroll
            for (int r = 0; r < 16; ++r) { s0[r] = __builtin_amdgcn_exp2f(s0[r]); s1[r] = __builtin_amdgcn_exp2f(s1[r]); }
            { float q0 = 0.f, q1 = 0.f, q2 = 0.f, q3 = 0.f;
#pragma unroll
              for (int r = 0; r < 16; r += 4) { q0 += s0[r] + s1[r]; q1 += s0[r + 1] + s1[r + 1]; q2 += s0[r + 2] + s1[r + 2]; q3 += s0[r + 3] + s1[r + 3]; }
              psum = (q0 + q1) + (q2 + q3); }
            lrun += psum;
            unsigned pb0[8], pb1[8];
#pragma unroll
            for (int i = 0; i < 8; ++i) { pb0[i] = cvtpk(s0[2 * i], s0[2 * i + 1]); pb1[i] = cvtpk(s1[2 * i], s1[2 * i + 1]); }
            __builtin_amdgcn_sched_barrier(0);
#pragma unroll
            for (int kk = 0; kk < 2; ++kk)
#pragma unroll
                for (int s = 0; s < 2; ++s) {
                    u32x4 pf; if (kk == 0) pf = (u32x4){pb0[4 * s], pb0[4 * s + 1], pb0[4 * s + 2], pb0[4 * s + 3]}; else pf = (u32x4){pb1[4 * s], pb1[4 * s + 1], pb1[4 * s + 2], pb1[4 * s + 3]};
                    const bf16x8 pfr = __builtin_bit_cast(bf16x8, pf);
#pragma unroll
                    for (int db = 0; db < 2; ++db) { const int fi = (kk * 2 + s) * 2 + db;
                        const bf16x8 vf = __builtin_bit_cast(bf16x8, (u32x4){vlo[fi].x, vlo[fi].y, vhi[fi].x, vhi[fi].y});
                        o[db] = __builtin_amdgcn_mfma_f32_32x32x16_bf16(vf, pfr, o[db], 0, 0, 0); }
                }
        }
        if (t + 1 < NT) ATT_WRITE((t + 1) & 1);
        TEAM_BAR();
    }
#undef ATT_LOAD
#undef ATT_WRITE
#undef TEAM_BAR
    const float lt = lrun + __shfl_xor(lrun, 32);
    const float inv = 1.f / lt;
#pragma unroll
    for (int db = 0; db < 2; ++db)
#pragma unroll
        for (int g = 0; g < 4; ++g) { int w = 0; w = __builtin_amdgcn_cvt_pk_fp8_f32(o[db][4 * g] * inv, o[db][4 * g + 1] * inv, w, false); w = __builtin_amdgcn_cvt_pk_fp8_f32(o[db][4 * g + 2] * inv, o[db][4 * g + 3] * inv, w, true);
            *(int*)(Yp + rowq * DM + 32 * db + 8 * g + 4 * hi) = w; }
}

typedef float f32x2v __attribute__((ext_vector_type(2)));
__device__ __forceinline__ void p6_front(const Args& a, const bf16_t* mix, unsigned char* hb8, const LAS float* GT1, const LAS float* A2, const LAS float* B2, int row, int lane, f32x4 (&xv)[4]) {
    const u32x2* mr = (const u32x2*)(mix + (size_t)row * DM) + lane;
    const f32x4* xr = (const f32x4*)(a.x + (size_t)row * DM) + lane;
    f32x4 mv[4]; float ss = 0.f;
#pragma unroll
    for (int j = 0; j < 4; ++j) { const u32x2 q = __builtin_nontemporal_load(mr + 64 * j); mv[j] = (f32x4){bflo(q.x), bfhi(q.x), bflo(q.y), bfhi(q.y)}; xv[j] = __builtin_nontemporal_load(xr + 64 * j);
        ss += (mv[j][0] * mv[j][0] + mv[j][1] * mv[j][1]) + (mv[j][2] * mv[j][2] + mv[j][3] * mv[j][3]); }
    const float rstd1 = rsqrtf(wave_sum(ss) * (1.f / DM) + EPS);
    float ss2 = 0.f;
    f32x4* orow = (f32x4*)(a.out + (size_t)row * DM) + lane;
#pragma unroll
    for (int j = 0; j < 4; ++j) { const f32x4 g1 = *(const LAS f32x4*)(GT1 + 4 * lane + 256 * j);
        xv[j] = xv[j] + g1 * (mv[j] * rstd1); orow[64 * j] = xv[j];
        ss2 += (xv[j][0] * xv[j][0] + xv[j][1] * xv[j][1]) + (xv[j][2] * xv[j][2] + xv[j][3] * xv[j][3]); }
    const float rstd2 = rsqrtf(wave_sum(ss2) * (1.f / DM) + EPS);
    int* o4 = (int*)(hb8 + (size_t)row * DM) + lane;
#pragma unroll
    for (int j = 0; j < 4; ++j) { const f32x4 am = *(const LAS f32x4*)(A2 + 4 * lane + 256 * j), bd = *(const LAS f32x4*)(B2 + 4 * lane + 256 * j);
        xv[j] = xv[j] * rstd2 * am + bd;
        int w = 0; w = __builtin_amdgcn_cvt_pk_fp8_f32(xv[j][0], xv[j][1], w, false); w = __builtin_amdgcn_cvt_pk_fp8_f32(xv[j][2], xv[j][3], w, true);
        o4[64 * j] = w; }
}
__device__ __forceinline__ void p6_route(const Args& a, float (&pe)[32], LAS int* lcnt, LAS int* info, int r, int lane) {
    { const bool b5 = (lane & 32) != 0, b4 = (lane & 16) != 0, b3 = (lane & 8) != 0, b2 = (lane & 4) != 0, b1 = (lane & 2) != 0;
#pragma unroll
      for (int i = 0; i < 16; ++i) { const float keep = b5 ? pe[16 + i] : pe[i], send = b5 ? pe[i] : pe[16 + i]; pe[i] = keep + __shfl_xor(send, 32); }
#pragma unroll
      for (int i = 0; i < 8; ++i) { const float keep = b4 ? pe[8 + i] : pe[i], send = b4 ? pe[i] : pe[8 + i]; pe[i] = keep + __shfl_xor(send, 16); }
#pragma unroll
      for (int i = 0; i < 4; ++i) { const float keep = b3 ? pe[4 + i] : pe[i], send = b3 ? pe[i] : pe[4 + i]; pe[i] = keep + __shfl_xor(send, 8); }
#pragma unroll
      for (int i = 0; i < 2; ++i) { const float keep = b2 ? pe[2 + i] : pe[i], send = b2 ? pe[i] : pe[2 + i]; pe[i] = keep + __shfl_xor(send, 4); }
      { const float keep = b1 ? pe[1] : pe[0], send = b1 ? pe[0] : pe[1]; pe[0] = keep + __shfl_xor(send, 2); }
      pe[0] += __shfl_xor(pe[0], 1); }
    const int myexp = lane >> 1;
    const float mylg = pe[0] + a.b_router[myexp];
    int rank = 0;
#pragma unroll
    for (int j = 0; j < 32; ++j) { const float vj = __builtin_bit_cast(float, __builtin_amdgcn_readlane(__builtin_bit_cast(int, mylg), 2 * j));
        rank += (vj > mylg || (vj == mylg && j < myexp)) ? 1 : 0; }
    float tv[4]; int ti[4];
#pragma unroll
    for (int p = 0; p < 4; ++p) { const unsigned long long bm = __ballot(rank == p && !(lane & 1)); const int bi = __builtin_ctzll(bm);
        ti[p] = bi >> 1; tv[p] = __builtin_bit_cast(float, __builtin_amdgcn_readlane(__builtin_bit_cast(int, mylg), bi)); }
    float ex[4], es = 0.f;
#pragma unroll
    for (int p = 0; p < 4; ++p) { ex[p] = __expf(tv[p] - tv[0]); es += ex[p]; }
    if (lane < 4) {
        const int e = lane == 0 ? ti[0] : lane == 1 ? ti[1] : lane == 2 ? ti[2] : ti[3];
        const float g = (lane == 0 ? ex[0] : lane == 1 ? ex[1] : lane == 2 ? ex[2] : ex[3]) / es;
        const int lr = __hip_atomic_fetch_add(&lcnt[e], 1, __ATOMIC_RELAXED, __HIP_MEMORY_SCOPE_WORKGROUP);
        info[(r * 4 + lane) * 3 + 0] = e; info[(r * 4 + lane) * 3 + 1] = lr; info[(r * 4 + lane) * 3 + 2] = __builtin_bit_cast(int, g);
    }
}

__device__ __forceinline__ void p6_rows(const Args& a, LAS unsigned char* lds, int tid, int wave, int lane) {
    constexpr int WTS = 1028;
    LAS float* WT = (LAS float*)lds;
    LAS float* GT1 = WT + 32 * WTS; LAS float* A2 = GT1 + DM; LAS float* B2 = A2 + DM;
    LAS int* lcnt = (LAS int*)(B2 + DM); LAS int* lbase = lcnt + 32; LAS int* info = lbase + 32;
    unsigned char* ws = a.ws;
    const bf16_t* mix = (const bf16_t*)(ws + WS_MIX); unsigned char* hb8 = ws + WS_HB;
    int* cnt = (int*)(ws + WS_CTL) + CW_CNT; int* list = (int*)(ws + WS_LIST);
    int* route_e = (int*)(ws + WS_ROUTE); int* route_pos = route_e + MT * 4; float* gate = (float*)(route_pos + MT * 4);
    for (int i = tid; i < DM * NE; i += 512) WT[(i & 31) * WTS + (i >> 5)] = a.w_router[i];
    if (tid < 32) lcnt[tid] = 0;
    for (int blk = blockIdx.x; blk < MT / 64; blk += gridDim.x) {
        const int b = blk / 32;
        __syncthreads();
        for (int j = tid; j < DM; j += 512) { GT1[j] = mod_at(a, b, 2048 + j) * a.g_post_mix[j]; A2[j] = a.g_pre_ffn[j] * (1.f + mod_at(a, b, 4096 + j)); B2[j] = mod_at(a, b, 3072 + j); }
        __syncthreads();
#pragma unroll 1
        for (int it = 0; it < 4; ++it) {
            const int rA = wave + 16 * it, rB = rA + 8;
            const int ln = fresh_lane();
            f32x4 xa[4], xb[4];
            p6_front(a, mix, hb8, GT1, A2, B2, blk * 64 + rA, ln, xa);
            p6_front(a, mix, hb8, GT1, A2, B2, blk * 64 + rB, ln, xb);
            float pa[32], pb[32];
#pragma unroll
            for (int e = 0; e < 32; ++e) { f32x2v accA = (f32x2v){0.f, 0.f}, accB = (f32x2v){0.f, 0.f};
#pragma unroll
                for (int j = 0; j < 4; ++j) { const f32x4 wv = *(const LAS f32x4*)(WT + e * WTS + 4 * ln + 256 * j);
                    const f32x2v w01 = (f32x2v){wv[0], wv[1]}, w23 = (f32x2v){wv[2], wv[3]};
                    accA = __builtin_elementwise_fma((f32x2v){xa[j][0], xa[j][1]}, w01, accA); accA = __builtin_elementwise_fma((f32x2v){xa[j][2], xa[j][3]}, w23, accA);
                    accB = __builtin_elementwise_fma((f32x2v){xb[j][0], xb[j][1]}, w01, accB); accB = __builtin_elementwise_fma((f32x2v){xb[j][2], xb[j][3]}, w23, accB); }
                pa[e] = accA.x + accA.y; pb[e] = accB.x + accB.y; if ((e & 3) == 3) __builtin_amdgcn_sched_barrier(0); }
#pragma unroll 1
            for (int rr = 0; rr < 2; ++rr) {
                const int ln2 = fresh_lane();
                p6_route(a, pa, lcnt, info, rr ? rB : rA, ln2);
#pragma unroll
                for (int e = 0; e < 32; ++e) pa[e] = pb[e];
            }
        }
        __syncthreads();
        if (tid < 32) lbase[tid] = atomicAdd(cnt + CNT_STRIDE * tid, lcnt[tid]);
        __syncthreads();
        if (tid < 256) { const int e = info[tid * 3 + 0], p = lbase[e] + info[tid * 3 + 1]; const int row = blk * 64 + (tid >> 2);
            list[e * MT + p] = row; route_e[row * 4 + (tid & 3)] = e; route_pos[row * 4 + (tid & 3)] = p; gate[row * 4 + (tid & 3)] = __builtin_bit_cast(float, info[tid * 3 + 2]); }
        __syncthreads();
        if (tid < 32) lcnt[tid] = 0;
    }
}

__device__ __forceinline__ void p9_rows(const Args& a, LAS unsigned char* lds, const LAS int* ts, int tid, int wave, int lane) {
    LAS float* GT2 = (LAS float*)lds;
    unsigned char* ws = a.ws;
    const unsigned char* yb = ws + WS_YB;
    const int* route_e = (const int*)(ws + WS_ROUTE); const int* route_pos = route_e + MT * 4; const float* gate = (const float*)(route_pos + MT * 4);
    for (int blk = blockIdx.x; blk < MT / 64; blk += gridDim.x) {
        const int b = blk / 32;
        __syncthreads();
        for (int j = tid; j < DM; j += 512) GT2[j] = mod_at(a, b, 5120 + j) * a.g_post_ffn[j];
        __syncthreads();
#pragma unroll 1
        for (int r0 = wave; r0 < 64; r0 += 16) {
            i32x4 re[2], rp[2]; f32x4 gg[2];
#pragma unroll
            for (int q = 0; q < 2; ++q) { const int row = blk * 64 + r0 + 8 * q; re[q] = *(const i32x4*)(route_e + row * 4); rp[q] = *(const i32x4*)(route_pos + row * 4); gg[q] = *(const f32x4*)(gate + row * 4); }
            int yv[2][4][4]; f32x4 xo[2][4];
#pragma unroll
            for (int q = 0; q < 2; ++q) { const int row = blk * 64 + r0 + 8 * q;
#pragma unroll
                for (int k = 0; k < 4; ++k) { const int slot = ts[re[q][k]] * 256 + rp[q][k]; const int* yr = (const int*)(yb + (size_t)slot * FE) + lane;
#pragma unroll
                    for (int j = 0; j < 4; ++j) yv[q][k][j] = __builtin_nontemporal_load(yr + 64 * j); }
                const f32x4* orow = (const f32x4*)(a.out + (size_t)row * DM) + lane;
#pragma unroll
                for (int j = 0; j < 4; ++j) xo[q][j] = __builtin_nontemporal_load(orow + 64 * j); }
#pragma unroll
            for (int q = 0; q < 2; ++q) { const int row = blk * 64 + r0 + 8 * q;
                f32x4 f[4];
#pragma unroll
                for (int j = 0; j < 4; ++j) f[j] = (f32x4){0.f, 0.f, 0.f, 0.f};
#pragma unroll
                for (int k = 0; k < 4; ++k) { const float g = gg[q][k];
#pragma unroll
                    for (int j = 0; j < 4; ++j) { const int w = yv[q][k][j]; const f32x2v lo = __builtin_amdgcn_cvt_pk_f32_fp8(w, false), hi2 = __builtin_amdgcn_cvt_pk_f32_fp8(w, true); f[j] += (f32x4){lo.x, lo.y, hi2.x, hi2.y} * g; } }
                float ss = 0.f;
#pragma unroll
                for (int j = 0; j < 4; ++j) ss += (f[j][0] * f[j][0] + f[j][1] * f[j][1]) + (f[j][2] * f[j][2] + f[j][3] * f[j][3]);
                const float rstd = rsqrtf(wave_sum(ss) * (1.f / DM) + EPS);
                f32x4* orow = (f32x4*)(a.out + (size_t)row * DM) + lane;
#pragma unroll
                for (int j = 0; j < 4; ++j) { const f32x4 g2 = *(const LAS f32x4*)(GT2 + 4 * lane + 256 * j); __builtin_nontemporal_store(xo[q][j] + g2 * (f[j] * rstd), orow + 64 * j); }
            }
        }
    }
}

#define XB_TMO      128
#define XB_XCNT(j)  (256  + 64 * (j))
#define XB_XSUB(j)  (1280 + 64 * (j))
#define XB_XGEN(j)  (2304 + 64 * (j))
#define XB_TOP      3328
#define XB_TOPGEN   3392
#define XCD_BAR_WORDS 3456
#define XB_SPIN_CAP (1u << 22)
__device__ __forceinline__ unsigned xb_ld(unsigned* p)              { return __hip_atomic_load(p, __ATOMIC_RELAXED, __HIP_MEMORY_SCOPE_AGENT); }
__device__ __forceinline__ unsigned xb_add(unsigned* p, unsigned v) { return __hip_atomic_fetch_add(p, v, __ATOMIC_RELAXED, __HIP_MEMORY_SCOPE_AGENT); }
__device__ __forceinline__ unsigned xb_xcc_id() { return (unsigned)__builtin_amdgcn_s_getreg((3 << 11) | 20) & 0xFu; }
#define XB_SPIN(cond, bar) do { unsigned _sp = 0; while (cond) { __builtin_amdgcn_s_sleep(1); \
    if ((++_sp & 255u) == 0u) { if (xb_ld(&(bar)[XB_TMO])) break; if (_sp > XB_SPIN_CAP) { atomicAdd(&(bar)[XB_TMO], 1u); break; } } } } while (0)
struct XcdBarrier { unsigned* bar; unsigned x; volatile LAS unsigned* st; };
__device__ __forceinline__ void xcd_barrier_complete(unsigned* bar, unsigned x, unsigned& nloc, unsigned& nx) {
    const unsigned G = gridDim.x;
    unsigned sum, cnt, mine, sp = 0u;
    for (;;) {
        sum = 0u; cnt = 0u; mine = 0u;
#pragma unroll
        for (unsigned j = 0; j < 16; ++j) { const unsigned c = xb_ld(&bar[XB_XCNT(j)]); sum += c; cnt += (c > 0u) ? 1u : 0u; mine = (j == x) ? c : mine; }
        if (sum == G) break;
        __builtin_amdgcn_s_sleep(1);
        if ((++sp & 255u) == 0u) { if (xb_ld(&bar[XB_TMO])) break; if (sp > XB_SPIN_CAP) { atomicAdd(&bar[XB_TMO], 1u); break; } }
    }
    nloc = mine > 0u ? mine : 1u; nx = cnt > 0u ? cnt : 1u;
}
__device__ __forceinline__ void xcd_barrier(const XcdBarrier& b, bool leader_thread) {
    asm volatile("s_waitcnt vmcnt(0)" ::: "memory");
    __syncthreads();
    if (leader_thread) {
        unsigned* bar = b.bar;
        __builtin_amdgcn_s_waitcnt(0);
        unsigned nloc = b.st[0], nx = b.st[1];
        if (nloc == 0u) { xcd_barrier_complete(bar, b.x, nloc, nx); b.st[0] = nloc; b.st[1] = nx; }
        const unsigned old = xb_add(&bar[XB_XSUB(b.x)], 1u);
        const unsigned gen = old / nloc;
        if (old + 1u == (gen + 1u) * nloc) {
            __builtin_amdgcn_fence(__ATOMIC_RELEASE, "agent");
            asm volatile("s_waitcnt vmcnt(0)" ::: "memory");
            const unsigned og = xb_add(&bar[XB_TOP], 1u);
            const unsigned tg = og / nx;
            if (og + 1u == (tg + 1u) * nx) xb_add(&bar[XB_TOPGEN], 1u);
            else XB_SPIN(xb_ld(&bar[XB_TOPGEN]) == tg, bar);
            __builtin_amdgcn_fence(__ATOMIC_ACQUIRE, "agent");
            xb_add(&bar[XB_XGEN(b.x)], 1u);
            asm volatile("s_waitcnt vmcnt(0)" ::: "memory");
        } else {
            XB_SPIN(xb_ld(&bar[XB_XGEN(b.x)]) == gen, bar);
            __builtin_amdgcn_fence(__ATOMIC_ACQUIRE, "agent");
            asm volatile("s_waitcnt vmcnt(0)" ::: "memory");
        }
    }
    __syncthreads();
}

constexpr int N_PHASES = 10;
constexpr int CONV_EARLY = 5376;
__global__ void __launch_bounds__(512, 2) mk_fwd(Args a) {
    extern __shared__ __attribute__((aligned(16))) unsigned char lds_raw[];
    LAS unsigned char* lds = (LAS unsigned char*)lds_raw;
    const int wave = __builtin_amdgcn_readfirstlane(threadIdx.x >> 6);
    int lane, tid;
#define FRESH() do { lane = fresh_lane(); tid = wave * 64 + lane; } while (0)
    unsigned char* ws = a.ws;
    LAS int* ts = (LAS int*)(lds + LDS_CTRL);
    LAS int* cnts = ts + 40;
    const int lo = a.ph_lo, hi = a.ph_hi;
#ifndef PHASE_MASK
#define PHASE_MASK 0xFFFF
#endif
#define IN(k) (((PHASE_MASK >> (k)) & 1) && lo <= (k) && (k) < hi)
#define SEAM(k) do { if (IN(k) && IN((k) + 1)) { FRESH(); xcd_barrier(xb, tid == 0); } } while (0)
    XcdBarrier xb; xb.bar = (unsigned*)(ws + WS_CTL) + CW_BAR; xb.x = xb_xcc_id(); xb.st = (volatile LAS unsigned*)(lds + LDS_CTRL + 320);
    if (hi - lo > 1) {
        if (threadIdx.x == 0) { xb.st[0] = 0u; xb.st[1] = 0u; (void)xb_add(&xb.bar[XB_XCNT(xb.x)], 1u); }
        __syncthreads();
    }

    if (IN(0)) { FRESH(); p0_prologue(a, lds, tid, wave, lane); }
    SEAM(0);
    if (IN(1)) { FRESH(); p1_rows(a, lds, tid, wave, lane); }
    SEAM(1);
    if (IN(2)) {
        pg8::StaticOrder S; S.init(MT, NPROJ, gridDim.x, blockIdx.x, ws + WS_WIN, 2048);
        float* rcos = (float*)(ws + WS_ROPE);
        pg8::EpiInProj E{(bf16_t*)(ws + WS_PROJ), (float*)(ws + WS_SSQ), (float*)(ws + WS_SSQ) + MT * 4, (bf16_t*)(ws + WS_KM), (bf16_t*)(ws + WS_VTD), rcos, rcos + (size_t)MT * 16};
        __syncthreads();
        pg8::gemm_phase<pg8::EpiInProj, pg8::StaticOrder, true>(lds, ws + WS_HB, 2048, 2048, S, E, wave);
        if (gridDim.x == 256 && blockIdx.x >= 128) { __syncthreads(); FRESH(); moe_weights_phase(a, lds, wave, lane, 0, CONV_EARLY, (blockIdx.x - 128) * 8 + wave, 128 * 8); }
        else if (gridDim.x != 256 && blockIdx.x == 0) { __syncthreads(); FRESH(); moe_weights_phase(a, lds, wave, lane, 0, CONV_EARLY, wave, 8); }
    }
    SEAM(2);
    if (IN(3)) {
        float* rcos = (float*)(ws + WS_ROPE);
        __syncthreads();
#ifndef SUB3
#define SUB3 7
#endif
        if (SUB3 & 1) { pg8::StaticOrder S; S.init(MT, 768, gridDim.x, blockIdx.x, ws + WS_WQB, 512);
          pg8::EpiQb E{(bf16_t*)(ws + WS_QM), (const float*)(ws + WS_SSQ), rcos, rcos + (size_t)MT * 16, 0.10206207261596575f * LOG2E};
          pg8::gemm_phase<pg8::EpiQb, pg8::StaticOrder, true>(lds, (const bf16_t*)(ws + WS_PROJ) + PC_CQ, NPROJ * 2, 512, S, E, wave); }
        __syncthreads();
        if (SUB3 & 2) { pg8::StaticOrder S; S.init(MT, 1024, gridDim.x, blockIdx.x, ws + WS_WKVB, 512);
          pg8::EpiKvb E{(bf16_t*)(ws + WS_KM), (bf16_t*)(ws + WS_VTM), (const float*)(ws + WS_SSQ) + MT * 4};
          pg8::gemm_phase<pg8::EpiKvb, pg8::StaticOrder, true>(lds, (const bf16_t*)(ws + WS_PROJ) + PC_CKV, NPROJ * 2, 512, S, E, wave); }
        __syncthreads();
        FRESH();
        if (SUB3 & 4) for (int v = blockIdx.x; v < 256; v += gridDim.x) {
            const int b = v & 7, aa = v >> 3;
            idx_item<8>(lds, (const bf16_t*)(ws + WS_PROJ), (unsigned*)(ws + WS_BITMAP), b, aa, wave, lane);
            FRESH(); idx_item<16>(lds, (const bf16_t*)(ws + WS_PROJ), (unsigned*)(ws + WS_BITMAP), b, 63 - aa, wave, lane);
            FRESH(); idx_item<24>(lds, (const bf16_t*)(ws + WS_PROJ), (unsigned*)(ws + WS_BITMAP), b, 64 + aa, wave, lane);
            FRESH(); idx_item<32>(lds, (const bf16_t*)(ws + WS_PROJ), (unsigned*)(ws + WS_BITMAP), b, 127 - aa, wave, lane);
        }
    }
    SEAM(3);
    if (IN(4)) {
        __syncthreads(); FRESH();
        LAS unsigned* tc = (LAS unsigned*)(lds + LDS_CTRL + 336);
        if (tid < 2) tc[tid] = 0u;
        __syncthreads();
        const int team = wave >> 2, wt = wave & 3;
        LAS unsigned char* tl = lds + team * (2 * 22272);
        unsigned tgen = 0u;
        for (int v0_ = blockIdx.x; v0_ < 256; v0_ += gridDim.x) {
            const int v = (gridDim.x == 256) ? ((v0_ & 7) * 32 + (v0_ >> 3)) : v0_;
            const int T = 2 * v + team, bh = T >> 3, b = bh >> 3, h = bh & 7, s2 = T & 7, kvh = h >> 2;
#pragma unroll 1
            for (int i = 0; i < 4; ++i) {
                const int qt = (i & 1) ? 15 - s2 : s2; const bool mla = ((i >> 1) == team);
                const int ln = fresh_lane(), tt = wt * 64 + ln;
                if (mla) attn_unit<96, false>(tl, b, qt, (const bf16_t*)(ws + WS_QM) + h * 96, 768, (const bf16_t*)(ws + WS_KM) + h * 96, 768,
                                              (const bf16_t*)(ws + WS_VTM) + (size_t)(b * 8 + h) * 64 * SEQ, (unsigned char*)(ws + WS_Y) + h * 64, nullptr, nullptr, 0.f, 0.f, tt, wt, ln, tc + team, tgen);
                else attn_unit<64, true>(tl, b, qt, (const bf16_t*)(ws + WS_PROJ) + PC_QD + h * 64, NPROJ, (const bf16_t*)(ws + WS_PROJ) + PC_KD + kvh * 64, NPROJ,
                                         (const bf16_t*)(ws + WS_VTD) + (size_t)(b * 2 + kvh) * 64 * SEQ, (unsigned char*)(ws + WS_Y) + 512 + h * 64, (const unsigned*)(ws + WS_BITMAP), a.pos,
                                         0.125f * LOG2E, exp2f(-(float)(h + 1)) * LOG2E, tt, wt, ln, tc + team, tgen);
            }
        }
    }
    SEAM(4);
    if (IN(5)) {
        pg8::StaticOrder S; S.init(MT, DM, gridDim.x, blockIdx.x, ws + WS_WO, 1024);
        pg8::EpiPlain E{(bf16_t*)(ws + WS_MIX), DM, 1.f / 64.f};
        __syncthreads();
        pg8::gemm_phase<pg8::EpiPlain, pg8::StaticOrder, true, true>(lds, ws + WS_Y, 1024, 1024, S, E, wave);
    }
    SEAM(5);
    if (IN(6)) { __syncthreads(); FRESH(); p6_rows(a, lds, tid, wave, lane); __syncthreads(); FRESH(); moe_weights_phase(a, lds, wave, lane, CONV_EARLY, 32 * 16 * 96, blockIdx.x * 8 + wave, gridDim.x * 8); }
    SEAM(6);
    if (IN(7) || IN(8) || IN(9)) {
        __syncthreads(); FRESH();
        if (tid == 0) { const int* cnt = (const int*)(ws + WS_CTL) + CW_CNT; int acc = 0;
            for (int e = 0; e < 32; ++e) { const int c = cnt[CNT_STRIDE * e]; ts[e] = acc; cnts[e] = c; acc += (c + 255) >> 8; }
            ts[32] = acc; }
        __syncthreads();
    }
    if (IN(7)) {
        pg8::MoeOrder<true> S; S.init(ts, cnts, (const int*)(ws + WS_LIST), ws + WS_W1T, 2048, 1024, 8, gridDim.x, blockIdx.x);
        pg8::EpiMoe1 E{ws + WS_ACT, a.b_mlp1};
        pg8::gemm_phase<pg8::EpiMoe1, pg8::MoeOrder<true>, true, true>(lds, ws + WS_HB, 1024, 1024, S, E, wave);
    }
    SEAM(7);
    if (IN(8)) {
        pg8::MoeOrder<false> S; S.init(ts, cnts, (const int*)(ws + WS_LIST), ws + WS_W2T, 1024, 1024, 4, gridDim.x, blockIdx.x);
        pg8::EpiMoe2 E{ws + WS_YB, a.b_mlp2};
        __syncthreads();
        pg8::gemm_phase<pg8::EpiMoe2, pg8::MoeOrder<false>, true, true>(lds, ws + WS_ACT, 1024, 1024, S, E, wave);
    }
    SEAM(8);
    if (IN(9)) { __syncthreads(); FRESH(); p9_rows(a, lds, ts, tid, wave, lane); }
#undef IN
#undef SEAM
}

extern "C" void kernel_launch(void* const* d_in, const int* in_sizes, int n_in, void* d_out, int out_size, void* d_ws, size_t ws_size, hipStream_t stream) {
    static int grid = 0;
    if (grid == 0) {
        if (n_in != 21 || out_size != MT * DM || ws_size < WS_END) { fprintf(stderr, "kernel_launch: unexpected shapes (n_in %d out %d ws %zu)\n", n_in, out_size, ws_size); grid = -1; return; }
        int dev = 0, cus = 0, per_cu = 0;
        hipGetDevice(&dev); hipDeviceGetAttribute(&cus, hipDeviceAttributeMultiprocessorCount, dev);
        if (hipFuncSetAttribute((const void*)mk_fwd, hipFuncAttributeMaxDynamicSharedMemorySize, LDS_BYTES) != hipSuccess) { fprintf(stderr, "kernel_launch: hipFuncSetAttribute failed\n"); grid = -1; return; }
        if (hipOccupancyMaxActiveBlocksPerMultiprocessor(&per_cu, (const void*)mk_fwd, 512, LDS_BYTES) != hipSuccess || per_cu < 1) { fprintf(stderr, "kernel_launch: occupancy query says %d\n", per_cu); per_cu = 1; }
        (void)hipGetLastError();
        grid = cus;
    }
    if (grid < 0) return;
    hipMemsetAsync((char*)d_ws + WS_CTL, 0, CTL_BYTES, stream);
    Args a{};
    a.x = (const float*)d_in[0]; a.c = (const float*)d_in[1]; a.pos = (const int*)d_in[2]; a.w_ada = (const float*)d_in[3]; a.b_ada = (const float*)d_in[4];
    a.g_pre_mix = (const float*)d_in[5]; a.g_post_mix = (const float*)d_in[6]; a.g_pre_ffn = (const float*)d_in[7]; a.g_post_ffn = (const float*)d_in[8];
    a.w_in = (const float*)d_in[9]; a.g_q_a = (const float*)d_in[10]; a.g_kv_a = (const float*)d_in[11]; a.w_q_b = (const float*)d_in[12]; a.w_kv_b = (const float*)d_in[13]; a.w_o = (const float*)d_in[14];
    a.w_router = (const float*)d_in[15]; a.b_router = (const float*)d_in[16]; a.w_mlp1 = (const float*)d_in[17]; a.b_mlp1 = (const float*)d_in[18]; a.w_mlp2 = (const float*)d_in[19]; a.b_mlp2 = (const float*)d_in[20];
    a.out = (float*)d_out; a.ws = (unsigned char*)d_ws;
#if MK_N_LAUNCHES == 1
    a.ph_lo = 0; a.ph_hi = N_PHASES;
    hipLaunchKernelGGL(mk_fwd, dim3(grid), dim3(512), LDS_BYTES, stream, a);
#else
    for (int p = 0; p < N_PHASES; ++p) { a.ph_lo = p; a.ph_hi = p + 1; hipLaunchKernelGGL(mk_fwd, dim3(grid), dim3(512), LDS_BYTES, stream, a); }
#endif
}
```

```cpp
#include <hip/hip_runtime.h>
#include <cstdio>
#include <cstdint>

#ifndef MK_N_LAUNCHES
#define MK_N_LAUNCHES 1
#endif

#define LAS __attribute__((address_space(3)))
typedef unsigned short bf16_t;
typedef short bf16x8 __attribute__((ext_vector_type(8)));
typedef float f32x4 __attribute__((ext_vector_type(4)));
typedef float f32x16 __attribute__((ext_vector_type(16)));
typedef unsigned u32x4 __attribute__((ext_vector_type(4)));
typedef unsigned u32x2 __attribute__((ext_vector_type(2)));
typedef int i32x4 __attribute__((ext_vector_type(4)));
typedef int i32x8 __attribute__((ext_vector_type(8)));

constexpr int NB = 8, SEQ = 2048, DM = 1024, MT = NB * SEQ;
constexpr int NE = 32, FE = 1024;
constexpr int NPROJ = 1536;
constexpr int PC_CQ = 0, PC_CKV = 256, PC_KROPE = 384, PC_KIDX = 416, PC_WIDX = 448, PC_QD = 512, PC_KD = 1024, PC_VD = 1152, PC_QIDX = 1280;
constexpr float EPS = 1e-6f;
constexpr float LOG2E = 1.4426950408889634f;
constexpr int MAXTILES = 288;
constexpr int NSLOT = MAXTILES * 256;

constexpr size_t MiB = 1u << 20;
constexpr size_t WS_CTL = 0, CTL_BYTES = 64 * 1024;
constexpr size_t WS_MODP = 1 * MiB;
constexpr size_t WS_ROPE = 3 * MiB;
constexpr size_t WS_SSQ = 5 * MiB;
constexpr size_t WS_ROUTE = 6 * MiB;
constexpr size_t WS_LIST = 7 * MiB;
constexpr size_t WS_WIN = 9 * MiB;
constexpr size_t WS_WQB = 12 * MiB;
constexpr size_t WS_WKVB = 13 * MiB;
constexpr size_t WS_WO = 14 * MiB;
constexpr size_t WS_BITMAP = 16 * MiB;
constexpr size_t WS_VTM = 20 * MiB;
constexpr size_t WS_VTD = 36 * MiB;
constexpr size_t WS_HB = 40 * MiB;
constexpr size_t WS_PROJ = 72 * MiB;
constexpr size_t WS_QM = 120 * MiB;
constexpr size_t WS_KM = 144 * MiB;
constexpr size_t WS_Y = 168 * MiB;
constexpr size_t WS_MIX = 200 * MiB;
constexpr size_t WS_W1T = 232 * MiB;
constexpr size_t WS_W2T = 360 * MiB;
constexpr size_t WS_ACT = 424 * MiB;
constexpr size_t WS_YB = 568 * MiB;
constexpr size_t WS_END = 712 * MiB;
constexpr int CW_CNT = 64, CNT_STRIDE = 64;
constexpr int CW_BAR = 8192;

constexpr int LDS_BYTES = 163840;
constexpr int LDS_CTRL = 163328;

__device__ __forceinline__ unsigned f2bf(float f) { unsigned u = __builtin_bit_cast(unsigned, f); return (u + 0x7fffu + ((u >> 16) & 1u)) >> 16; }
__device__ __forceinline__ unsigned pk2(float lo, float hi) { return f2bf(lo) | (f2bf(hi) << 16); }
__device__ __forceinline__ float bflo(unsigned u) { return __builtin_bit_cast(float, u << 16); }
__device__ __forceinline__ float bfhi(unsigned u) { return __builtin_bit_cast(float, u & 0xffff0000u); }
__device__ __forceinline__ float wave_sum(float v) {
#pragma unroll
    for (int o = 1; o < 64; o <<= 1) v += __shfl_xor(v, o);
    return v;
}
#define LDS_WAIT() asm volatile("s_waitcnt lgkmcnt(0)" ::: "memory")
__device__ __forceinline__ int fresh_lane() { int l = __builtin_amdgcn_mbcnt_hi(~0u, __builtin_amdgcn_mbcnt_lo(~0u, 0u)); asm volatile("" : "+v"(l)); return l; }

namespace pg8 {
constexpr int BM = 256, BK = 64, HALF = 128, HTB = HALF * BK * 2, STAGE_BYTES = 8 * HTB, NXCD = 8, WGM = 8;
__host__ __device__ __forceinline__ int lds_byte(int r, int c) { const int st = (r >> 4) * 2 + (c >> 5), rr = r & 15, cc = c & 31, ob = rr * 64 + cc * 2; return st * 1024 + (ob ^ (((ob >> 9) & 1) << 5)); }
__host__ __device__ __forceinline__ void stage_rc(int b, int& R, int& C) { const int st = b / 1024, sb = b % 1024, swz = sb ^ (((sb >> 9) & 1) << 5); R = (st >> 1) * 16 + swz / 64; C = (st & 1) * 32 + (swz % 64) / 2; }
__host__ __device__ __forceinline__ int perm32(int rho) { const int n = rho >> 4, i = rho & 15; return 8 * (i >> 2) + 4 * n + (i & 3); }

struct Unit { int pm, pn, e, mt; };

struct StaticOrder {
    static constexpr bool GATHER = false;
    int nM, nN, nwg, G, c; const char* Bt; int ldb;
    __device__ void init(int M, int N, int G_, int c_, const void* Bt_, int ldb_bytes) { nM = M / BM; nN = N / BM; nwg = nM * nN; G = G_; c = c_; Bt = (const char*)Bt_; ldb = ldb_bytes; }
    __device__ bool next(int i, Unit& u, int ehint = 0) const {
        const long L = (long)i * G + c; if (L >= nwg) return false;
        int wgid = (int)L; { const int q = nwg / NXCD, r = nwg % NXCD, xcd = wgid % NXCD, off = wgid / NXCD; wgid = (xcd < r ? xcd * (q + 1) : r * (q + 1) + (xcd - r) * q) + off; }
        const int nig = WGM * nN, gid = wgid / nig, fm = gid * WGM, gsz = (nM - fm) < WGM ? (nM - fm) : WGM;
        u.pm = fm + ((wgid % nig) % gsz); u.pn = (wgid % nig) / gsz; u.e = 0; u.mt = 0; return true;
    }
    __device__ __forceinline__ const char* bptr(const Unit& u) const { return Bt + (size_t)u.pn * BM * ldb; }
    __device__ __forceinline__ int arow(const Unit& u, int r) const { return u.pm * BM + r; }
};

template <bool GATHER_> struct MoeOrder {
    static constexpr bool GATHER = GATHER_;
    const LAS int* ts;
    const LAS int* cnts;
    const int* list;
    const char* Bt; int nrows_b  , ldb  , nN, G, c, nwg;
    __device__ void init(const LAS int* ts_, const LAS int* cnts_, const int* list_, const void* Bt_, int nrows_b_, int ldb_, int nN_, int G_, int c_) {
        ts = ts_; cnts = cnts_; list = list_; Bt = (const char*)Bt_; nrows_b = nrows_b_; ldb = ldb_; nN = nN_; G = G_; c = c_; nwg = __builtin_amdgcn_readfirstlane(ts_[32]) * nN_; }
    __device__ bool next(int i, Unit& u, int ehint = 0) const {
        const long L = (long)i * G + c; if (L >= nwg) return false;
        int wgid = (int)L; { const int q = nwg / NXCD, r = nwg % NXCD, xcd = wgid % NXCD, off = wgid / NXCD; wgid = (xcd < r ? xcd * (q + 1) : r * (q + 1) + (xcd - r) * q) + off; }
        int e = ehint;
        while (e < 31 && __builtin_amdgcn_readfirstlane(ts[e + 1]) * nN <= wgid) ++e;
        const int t0 = __builtin_amdgcn_readfirstlane(ts[e]), T = __builtin_amdgcn_readfirstlane(ts[e + 1]) - t0, local = wgid - t0 * nN;
        u.e = e; u.pn = local / T; u.mt = local % T; u.pm = t0 + u.mt; return true;
    }
    __device__ __forceinline__ const char* bptr(const Unit& u) const { return Bt + ((size_t)u.e * nrows_b + (size_t)u.pn * BM) * ldb; }
    __device__ __forceinline__ int arow(const Unit& u, int r) const {
        if (!GATHER) return u.pm * BM + r;
        const int p = u.mt * BM + r; return (p < cnts[u.e]) ? list[u.e * MT + p] : 0;
    }
};

__device__ __forceinline__ unsigned cvt_pk_bf16(float lo, float hi) { unsigned r; asm volatile("v_cvt_pk_bf16_f32 %0, %1, %2" : "=v"(r) : "v"(lo), "v"(hi)); return r; }
__device__ __forceinline__ u32x4 pack8(const f32x4& a, const f32x4& b) { u32x4 w; w.x = cvt_pk_bf16(a[0], a[1]); w.y = cvt_pk_bf16(a[2], a[3]); w.z = cvt_pk_bf16(b[0], b[1]); w.w = cvt_pk_bf16(b[2], b[3]); return w; }

template <class Epi, class Sched, bool ALIGN_EPI, bool FP8 = false>
__device__ __forceinline__ void gemm_phase(LAS unsigned char* lds, const void* A, int lda, int kbytes, const Sched& S, const Epi& E, int wid) {
    const int lane = fresh_lane(), tid = wid * 64 + lane, wr = wid >> 2, wc = wid & 3, fr = lane & 15, fq = lane >> 4;
    const int nt = kbytes / 128; const int ldb = S.ldb;
    constexpr bool GA = Sched::GATHER;
    unsigned voffB[2], voffA[2]; int RA[2]; unsigned CA[2];
#pragma unroll
    for (int i = 0; i < 2; ++i) { int R, C; stage_rc(tid * 16 + i * 8192, R, C); const int Rb = (R & ~31) + perm32(R & 31);
        RA[i] = R; CA[i] = (unsigned)C * 2u; voffA[i] = (unsigned)(R * lda) + (unsigned)C * 2u; voffB[i] = (unsigned)(Rb * ldb) + (unsigned)C * 2u; }
    const size_t hstepA = (size_t)HALF * lda;
    const size_t kstep = (size_t)(BK * 2);
    const size_t hstepB = (size_t)HALF * ldb;
    const unsigned ldsw = (unsigned)wid * 1024u;
    const int aoff = lds_byte(wr * 64 + fr, fq * 8), boff = lds_byte(wc * 32 + fr, fq * 8);
#define PG8_SA(b, h) (((b) * 2 + (h)) * HTB)
#define PG8_SB(b, h) ((4 + (b) * 2 + (h)) * HTB)
#define PG8_STAGE(bufoff, gbase, voff) do { _Pragma("unroll") for (int _i = 0; _i < 2; ++_i) \
        __builtin_amdgcn_global_load_lds((const unsigned*)((const char*)(gbase) + (voff)[_i]), (LAS unsigned*)(lds + (bufoff) + ldsw + _i * 8192), 16, 0, 0); } while (0)
#define PG8_LDA(dst, b, h) do { _Pragma("unroll") for (int m = 0; m < 4; ++m) _Pragma("unroll") for (int k = 0; k < 2; ++k) dst[m][k] = *(const LAS bf16x8*)(lds + PG8_SA(b, h) + aoff + m * 2048 + k * 1024); } while (0)
#define PG8_LDB(dst, b, h) do { _Pragma("unroll") for (int n = 0; n < 2; ++n) _Pragma("unroll") for (int k = 0; k < 2; ++k) dst[n][k] = *(const LAS bf16x8*)(lds + PG8_SB(b, h) + boff + n * 2048 + k * 1024); } while (0)
#define PG8_MMA(ai, bj, At, Bt) do { __builtin_amdgcn_s_setprio(1); \
        if constexpr (FP8) { _Pragma("unroll") for (int m = 0; m < 4; ++m) _Pragma("unroll") for (int n = 0; n < 2; ++n) { \
            const i32x8 bb_ = __builtin_shufflevector(__builtin_bit_cast(i32x4, Bt[n][0]), __builtin_bit_cast(i32x4, Bt[n][1]), 0, 1, 2, 3, 4, 5, 6, 7); \
            const i32x8 aa_ = __builtin_shufflevector(__builtin_bit_cast(i32x4, At[m][0]), __builtin_bit_cast(i32x4, At[m][1]), 0, 1, 2, 3, 4, 5, 6, 7); \
            asm volatile("v_mfma_scale_f32_16x16x128_f8f6f4 %0, %1, %2, %0, %3, %3 op_sel_hi:[0,0,0]" : "+v"(acc[ai][bj][m][n]) : "v"(bb_), "v"(aa_), "v"(sc1_)); } } \
        else { _Pragma("unroll") for (int m = 0; m < 4; ++m) _Pragma("unroll") for (int n = 0; n < 2; ++n) _Pragma("unroll") for (int k = 0; k < 2; ++k) \
            acc[ai][bj][m][n] = __builtin_amdgcn_mfma_f32_16x16x32_bf16(Bt[n][k], At[m][k], acc[ai][bj][m][n], 0, 0, 0); } \
        __builtin_amdgcn_s_setprio(0); } while (0)
#define PG8_WAIT_V(n) asm volatile("s_waitcnt vmcnt(" #n ")" ::: "memory")
#define PG8_WAIT_L(n) asm volatile("s_waitcnt lgkmcnt(" #n ")" ::: "memory")
#define PG8_BAR __builtin_amdgcn_s_barrier()
#define PG8_SCHED __builtin_amdgcn_sched_barrier(0)
#define PG8_STA(bufoff, nx, h, kb) do { if constexpr (GA) { unsigned _w[2]; _Pragma("unroll") for (int _i = 0; _i < 2; ++_i) _w[_i] = (nx) ? vN[h][_i] : vA[h][_i]; PG8_STAGE(bufoff, Ab + (kb), _w); } \
        else { PG8_STAGE(bufoff, ((nx) ? nA : cA) + (h) * hstepA + (kb), voffA); } } while (0)
#define PG8_AOFF(dst, u) do { _Pragma("unroll") for (int _h = 0; _h < 2; ++_h) _Pragma("unroll") for (int _i = 0; _i < 2; ++_i) \
        dst[_h][_i] = (unsigned)S.arow(u, _h * HALF + RA[_i]) * (unsigned)lda + CA[_i]; } while (0)
#define PG8_AROW(dst, u) do { _Pragma("unroll") for (int _h = 0; _h < 2; ++_h) _Pragma("unroll") for (int _i = 0; _i < 2; ++_i) \
        dst[_h][_i] = (unsigned)S.arow(u, _h * HALF + RA[_i]); } while (0)
    Unit cur, nxt; int ui = 0;
    if (!S.next(0, cur)) return;
    f32x4 acc[2][2][4][2];
#pragma unroll
    for (int a = 0; a < 2; ++a)
#pragma unroll
        for (int b = 0; b < 2; ++b)
#pragma unroll
            for (int m = 0; m < 4; ++m)
#pragma unroll
                for (int n = 0; n < 2; ++n) acc[a][b][m][n] = (f32x4){0.f, 0.f, 0.f, 0.f};
    bf16x8 At[4][2], B0[2][2], B1[2][2];
    int sc1_ = 0x7f7f7f7f; asm volatile("" : "+v"(sc1_));
    unsigned vA[2][2], vN[2][2];
    if constexpr (GA) { PG8_AOFF(vA, cur); }
    const char* Ab = (const char*)A;
    const char* cA = Ab + (size_t)S.arow(cur, 0) * lda; const char* nA = cA;
    const char* cB = S.bptr(cur);
    PG8_STAGE(PG8_SB(0, 0), cB, voffB); PG8_STAGE(PG8_SB(0, 1), cB + hstepB, voffB); PG8_STA(PG8_SA(0, 0), false, 0, 0); PG8_STA(PG8_SA(0, 1), false, 1, 0);
    if (wr == 1) PG8_BAR;
    PG8_WAIT_V(2); PG8_BAR;
    PG8_STAGE(PG8_SB(1, 0), cB + kstep, voffB); PG8_STA(PG8_SA(1, 0), false, 0, kstep); PG8_STAGE(PG8_SB(1, 1), cB + hstepB + kstep, voffB);
    PG8_WAIT_V(6); PG8_BAR;
    for (;;) {
        const bool has_next = S.next(ui + 1, nxt, cur.e);
        if constexpr (GA) { if (has_next) { PG8_AROW(vN, nxt); } else {
#pragma unroll
            for (int _h = 0; _h < 2; ++_h)
#pragma unroll
                for (int _i = 0; _i < 2; ++_i) vN[_h][_i] = vA[_h][_i]; } }
        else { nA = has_next ? Ab + (size_t)S.arow(nxt, 0) * lda : cA; }
        const char* nB = has_next ? S.bptr(nxt) : cB;
#pragma unroll 1
        for (int t = 0; t < nt; t += 2) {
            const bool last = (t == nt - 2);
            if constexpr (GA) { if (last && has_next) {
#pragma unroll
                for (int _h = 0; _h < 2; ++_h)
#pragma unroll
                    for (int _i = 0; _i < 2; ++_i) vN[_h][_i] = vN[_h][_i] * (unsigned)lda + CA[_i]; } }
            const size_t k1 = (size_t)(t + 1) * kstep, k2 = last ? 0 : (size_t)(t + 2) * kstep, k3 = k2 + kstep;
            const char* b2 = last ? nB : cB + (size_t)(t + 2) * kstep; const char* b3 = b2 + kstep;
            PG8_LDB(B0, 0, 0); PG8_LDB(B1, 0, 1); PG8_SCHED; PG8_LDA(At, 0, 0); PG8_STA(PG8_SA(1, 1), false, 1, k1);
            PG8_WAIT_V(8); PG8_WAIT_L(0); PG8_BAR; PG8_MMA(0, 0, At, B0); PG8_MMA(0, 1, At, B1); PG8_BAR; PG8_SCHED;
            PG8_LDA(At, 0, 1); PG8_STAGE(PG8_SB(0, 0), b2, voffB); PG8_STAGE(PG8_SB(0, 1), b2 + hstepB, voffB); PG8_STA(PG8_SA(0, 0), last, 0, k2);
            PG8_WAIT_V(8); PG8_WAIT_L(0); PG8_BAR; PG8_MMA(1, 0, At, B0); PG8_MMA(1, 1, At, B1); PG8_BAR; PG8_SCHED;
            PG8_LDB(B0, 1, 0); PG8_LDB(B1, 1, 1); PG8_SCHED; PG8_LDA(At, 1, 0); PG8_STA(PG8_SA(0, 1), last, 1, k2);
            PG8_WAIT_V(8); PG8_WAIT_L(0); PG8_BAR; PG8_MMA(0, 0, At, B0); PG8_MMA(0, 1, At, B1); PG8_BAR; PG8_SCHED;
            PG8_LDA(At, 1, 1); PG8_STAGE(PG8_SB(1, 0), b3, voffB); PG8_STAGE(PG8_SB(1, 1), b3 + hstepB, voffB); PG8_STA(PG8_SA(1, 0), last, 0, k3);
            PG8_WAIT_V(8); PG8_WAIT_L(0); PG8_BAR; PG8_MMA(1, 0, At, B0); PG8_MMA(1, 1, At, B1); PG8_BAR; PG8_SCHED;
        }
        if constexpr (ALIGN_EPI) { if (wr == 0) PG8_BAR; }
        if constexpr (FP8) asm volatile("s_nop 15\n\ts_nop 7" ::: "memory");
        E(acc, cur, wr, wc, fr, fq);
        if (!has_next) break;
#pragma unroll
        for (int a = 0; a < 2; ++a)
#pragma unroll
            for (int b = 0; b < 2; ++b)
#pragma unroll
                for (int m = 0; m < 4; ++m)
#pragma unroll
                    for (int n = 0; n < 2; ++n) acc[a][b][m][n] = (f32x4){0.f, 0.f, 0.f, 0.f};
        cur = nxt; cB = nB; cA = nA; ++ui;
        if constexpr (GA) {
#pragma unroll
        for (int _h = 0; _h < 2; ++_h)
#pragma unroll
            for (int _i = 0; _i < 2; ++_i) vA[_h][_i] = vN[_h][_i]; }
        if constexpr (ALIGN_EPI) { if (wr == 1) PG8_BAR; }
    }
    PG8_WAIT_V(0);
    if constexpr (!ALIGN_EPI) { if (wr == 0) PG8_BAR; }
    PG8_BAR;
#undef PG8_SA
#undef PG8_SB
#undef PG8_STAGE
#undef PG8_LDA
#undef PG8_LDB
#undef PG8_MMA
#undef PG8_WAIT_V
#undef PG8_WAIT_L
#undef PG8_BAR
#undef PG8_SCHED
#undef PG8_AOFF
#undef PG8_AROW
#undef PG8_STA
}

struct EpiPlain {
    bf16_t* O; int ldc; float scale;
    __device__ __forceinline__ void operator()(const f32x4 (&acc)[2][2][4][2], const Unit& u, int wr, int wc, int fr_, int fq_) const {
        int ln_ = __builtin_amdgcn_mbcnt_hi(~0u, __builtin_amdgcn_mbcnt_lo(~0u, 0u)); asm volatile("" : "+v"(ln_)); const int fr = ln_ & 15, fq = ln_ >> 4;
        const int row0 = u.pm * BM + wr * 64 + fr, col0 = u.pn * BM + wc * 32 + 8 * fq;
#pragma unroll
        for (int ai = 0; ai < 2; ++ai)
#pragma unroll
            for (int m = 0; m < 4; ++m) { bf16_t* rowp = O + (size_t)(row0 + ai * HALF + m * 16) * ldc + col0;
#pragma unroll
                for (int bj = 0; bj < 2; ++bj) *(u32x4*)(rowp + bj * HALF) = pack8(acc[ai][bj][m][0] * scale, acc[ai][bj][m][1] * scale); }
    }
};

struct EpiInProj {
    bf16_t* proj; float* ssq_q; float* ssq_kv; bf16_t* Km; bf16_t* Vtd; const float* rcos; const float* rsin;
    __device__ __forceinline__ void operator()(const f32x4 (&acc)[2][2][4][2], const Unit& u, int wr, int wc, int fr_, int fq_) const {
        int ln_ = __builtin_amdgcn_mbcnt_hi(~0u, __builtin_amdgcn_mbcnt_lo(~0u, 0u)); asm volatile("" : "+v"(ln_)); const int fr = ln_ & 15, fq = ln_ >> 4;
        const int row0 = u.pm * BM + wr * 64 + fr, col0 = u.pn * BM + wc * 32 + 8 * fq;
        const int pn = u.pn;
#pragma unroll
        for (int ai = 0; ai < 2; ++ai)
#pragma unroll
            for (int m = 0; m < 4; ++m) {
                const int row = row0 + ai * HALF + m * 16;
                bf16_t* rowp = proj + (size_t)row * NPROJ + col0;
                float sq = 0.f;
#pragma unroll
                for (int bj = 0; bj < 2; ++bj) {
                    const f32x4 v0 = acc[ai][bj][m][0], v1 = acc[ai][bj][m][1];
                    *(u32x4*)(rowp + bj * HALF) = pack8(v0, v1);
                    if (pn == 0 || (pn == 1 && bj == 0)) sq += (v0[0] * v0[0] + v0[1] * v0[1]) + (v0[2] * v0[2] + v0[3] * v0[3]) + (v1[0] * v1[0] + v1[1] * v1[1]) + (v1[2] * v1[2] + v1[3] * v1[3]);
                    if (pn == 1 && bj == 1 && wc == 0) {
                        const int i0 = 8 * (fq & 1);
                        const f32x4 c0 = *(const f32x4*)(rcos + (size_t)row * 16 + i0), c1 = *(const f32x4*)(rcos + (size_t)row * 16 + i0 + 4);
                        const f32x4 s0 = *(const f32x4*)(rsin + (size_t)row * 16 + i0), s1 = *(const f32x4*)(rsin + (size_t)row * 16 + i0 + 4);
                        f32x4 o0, o1; const float sg = (fq < 2) ? -1.f : 1.f;
#pragma unroll
                        for (int j = 0; j < 4; ++j) { const float p0 = __shfl_xor(v0[j], 32), p1 = __shfl_xor(v1[j], 32);
                            o0[j] = v0[j] * c0[j] + sg * p0 * s0[j]; o1[j] = v1[j] * c1[j] + sg * p1 * s1[j]; }
                        const u32x4 w = pack8(o0, o1);
#pragma unroll
                        for (int h = 0; h < 8; ++h) *(u32x4*)(Km + (size_t)row * 768 + h * 96 + 64 + 8 * fq) = w;
                    }
                    if (pn == 4 && bj == 1) {
                        const int b = row >> 11, s = row & 2047, cv0 = wc * 32 + 8 * fq;
#pragma unroll
                        for (int j = 0; j < 8; ++j) { const int cv = cv0 + j; const float val = (j < 4) ? v0[j & 3] : v1[j & 3];
                            Vtd[((size_t)(b * 2 + (cv >> 6)) * 64 + (cv & 63)) * SEQ + s] = (bf16_t)f2bf(val); }
                    }
                }
                if (pn <= 1) { sq += __shfl_xor(sq, 16); sq += __shfl_xor(sq, 32); if (fq == 0) (pn == 0 ? ssq_q : ssq_kv)[(size_t)row * 4 + wc] = sq; }
            }
    }
};

struct EpiQb {
    bf16_t* Qm; const float* ssq_q; const float* rcos; const float* rsin; float c2;
    __device__ __forceinline__ void operator()(const f32x4 (&acc)[2][2][4][2], const Unit& u, int wr, int wc, int fr_, int fq_) const {
        int ln_ = __builtin_amdgcn_mbcnt_hi(~0u, __builtin_amdgcn_mbcnt_lo(~0u, 0u)); asm volatile("" : "+v"(ln_)); const int fr = ln_ & 15, fq = ln_ >> 4;
        const int row0 = u.pm * BM + wr * 64 + fr, col0 = u.pn * BM + wc * 32 + 8 * fq;
#pragma unroll
        for (int ai = 0; ai < 2; ++ai)
#pragma unroll
            for (int m = 0; m < 4; ++m) {
                const int row = row0 + ai * HALF + m * 16;
                const f32x4 rs = *(const f32x4*)(ssq_q + (size_t)row * 4);
                const float rstd = rsqrtf(((rs[0] + rs[1]) + (rs[2] + rs[3])) * (1.f / 256.f) + EPS) * c2;
#pragma unroll
                for (int bj = 0; bj < 2; ++bj) {
                    f32x4 v0 = acc[ai][bj][m][0] * rstd, v1 = acc[ai][bj][m][1] * rstd;
                    const int G = 8 * u.pn + 4 * bj + wc;
                    if (G % 3 == 2) {
                        const int i0 = 8 * (fq & 1);
                        const f32x4 c0 = *(const f32x4*)(rcos + (size_t)row * 16 + i0), c1 = *(const f32x4*)(rcos + (size_t)row * 16 + i0 + 4);
                        const f32x4 s0 = *(const f32x4*)(rsin + (size_t)row * 16 + i0), s1 = *(const f32x4*)(rsin + (size_t)row * 16 + i0 + 4);
                        f32x4 o0, o1; const float sg = (fq < 2) ? -1.f : 1.f;
#pragma unroll
                        for (int j = 0; j < 4; ++j) { const float p0 = __shfl_xor(v0[j], 32), p1 = __shfl_xor(v1[j], 32);
                            o0[j] = v0[j] * c0[j] + sg * p0 * s0[j]; o1[j] = v1[j] * c1[j] + sg * p1 * s1[j]; }
                        v0 = o0; v1 = o1;
                    }
                    *(u32x4*)(Qm + (size_t)row * 768 + col0 + bj * HALF) = pack8(v0, v1);
                }
                asm volatile("" ::: "memory");
            }
    }
};

struct EpiKvb {
    bf16_t* Km; bf16_t* Vtm; const float* ssq_kv;
    __device__ __forceinline__ void operator()(const f32x4 (&acc)[2][2][4][2], const Unit& u, int wr, int wc, int fr_, int fq_) const {
        int ln_ = __builtin_amdgcn_mbcnt_hi(~0u, __builtin_amdgcn_mbcnt_lo(~0u, 0u)); asm volatile("" : "+v"(ln_)); const int fr = ln_ & 15, fq = ln_ >> 4;
        const int row0 = u.pm * BM + wr * 64 + fr, col0 = u.pn * BM + wc * 32 + 8 * fq;
#pragma unroll
        for (int ai = 0; ai < 2; ++ai)
#pragma unroll
            for (int m = 0; m < 4; ++m) {
                const int row = row0 + ai * HALF + m * 16;
                const f32x4 rs = *(const f32x4*)(ssq_kv + (size_t)row * 4);
                const float rstd = rsqrtf(((rs[0] + rs[1]) + (rs[2] + rs[3])) * (1.f / 128.f) + EPS);
#pragma unroll
                for (int bj = 0; bj < 2; ++bj) {
                    const f32x4 v0 = acc[ai][bj][m][0] * rstd, v1 = acc[ai][bj][m][1] * rstd;
                    const int col = col0 + bj * HALF;
                    if (u.pn < 2) { const int h = col >> 6, d = col & 63; *(u32x4*)(Km + (size_t)row * 768 + h * 96 + d) = pack8(v0, v1); }
                    else { const int cv = col - 512, h = cv >> 6, d0 = cv & 63, b = row >> 11, s = row & 2047;
#pragma unroll
                        for (int j = 0; j < 8; ++j) { const float val = (j < 4) ? v0[j & 3] : v1[j & 3];
                            Vtm[((size_t)(b * 8 + h) * 64 + d0 + j) * SEQ + s] = (bf16_t)f2bf(val); } }
                }
            }
    }
};

constexpr float W8_SCALE = 64.f, W8_INV = 1.f / 64.f;
struct EpiMoe1 {
    unsigned char* act; const float* b1;
    __device__ __forceinline__ void operator()(const f32x4 (&acc)[2][2][4][2], const Unit& u, int wr, int wc, int fr_, int fq_) const {
        int ln_ = __builtin_amdgcn_mbcnt_hi(~0u, __builtin_amdgcn_mbcnt_lo(~0u, 0u)); asm volatile("" : "+v"(ln_)); const int fr = ln_ & 15, fq = ln_ >> 4;
        const int row0 = u.pm * BM + wr * 64 + fr, col0 = u.pn * BM + wc * 32 + 8 * fq;
        f32x4 bv[2][2];
#pragma unroll
        for (int bj = 0; bj < 2; ++bj)
#pragma unroll
            for (int n = 0; n < 2; ++n) bv[bj][n] = *(const f32x4*)(b1 + (size_t)u.e * 2048 + col0 + bj * HALF + 4 * n);
#pragma unroll
        for (int ai = 0; ai < 2; ++ai)
#pragma unroll
            for (int m = 0; m < 4; ++m) {
                unsigned char* rowp = act + (size_t)(row0 + ai * HALF + m * 16) * FE + (col0 >> 1);
#pragma unroll
                for (int bj = 0; bj < 2; ++bj) {
                    const f32x4 v0 = acc[ai][bj][m][0] * W8_INV + bv[bj][0], v1 = acc[ai][bj][m][1] * W8_INV + bv[bj][1];
                    float o[4];
#pragma unroll
                    for (int p = 0; p < 4; ++p) { const float g = fminf((p < 2) ? v0[2 * (p & 1)] : v1[2 * (p & 1)], 7.f);
                        const float l = fminf(fmaxf((p < 2) ? v0[2 * (p & 1) + 1] : v1[2 * (p & 1) + 1], -7.f), 7.f);
                        const float sg = __builtin_amdgcn_rcpf(1.f + __builtin_amdgcn_exp2f(-1.702f * LOG2E * g));
                        o[p] = g * sg * (l + 1.f); }
                    int w = 0; w = __builtin_amdgcn_cvt_pk_fp8_f32(o[0], o[1], w, false); w = __builtin_amdgcn_cvt_pk_fp8_f32(o[2], o[3], w, true);
                    *(int*)(rowp + bj * (HALF / 2)) = w;
                }
            }
    }
};

struct EpiMoe2 {
    unsigned char* yb; const float* b2;
    __device__ __forceinline__ void operator()(const f32x4 (&acc)[2][2][4][2], const Unit& u, int wr, int wc, int fr_, int fq_) const {
        int ln_ = __builtin_amdgcn_mbcnt_hi(~0u, __builtin_amdgcn_mbcnt_lo(~0u, 0u)); asm volatile("" : "+v"(ln_)); const int fr = ln_ & 15, fq = ln_ >> 4;
        const int row0 = u.pm * BM + wr * 64 + fr, col0 = u.pn * BM + wc * 32 + 8 * fq;
        f32x4 bv[2][2];
#pragma unroll
        for (int bj = 0; bj < 2; ++bj)
#pragma unroll
            for (int n = 0; n < 2; ++n) bv[bj][n] = *(const f32x4*)(b2 + (size_t)u.e * 1024 + col0 + bj * HALF + 4 * n);
#pragma unroll
        for (int ai = 0; ai < 2; ++ai)
#pragma unroll
            for (int m = 0; m < 4; ++m) { unsigned char* rowp = yb + (size_t)(row0 + ai * HALF + m * 16) * FE + col0;
#pragma unroll
                for (int bj = 0; bj < 2; ++bj) { const f32x4 v0 = acc[ai][bj][m][0] * W8_INV + bv[bj][0], v1 = acc[ai][bj][m][1] * W8_INV + bv[bj][1];
                    int w0 = 0, w1 = 0; w0 = __builtin_amdgcn_cvt_pk_fp8_f32(v0[0], v0[1], w0, false); w0 = __builtin_amdgcn_cvt_pk_fp8_f32(v0[2], v0[3], w0, true);
                    w1 = __builtin_amdgcn_cvt_pk_fp8_f32(v1[0], v1[1], w1, false); w1 = __builtin_amdgcn_cvt_pk_fp8_f32(v1[2], v1[3], w1, true);
                    *(u32x2*)(rowp + bj * HALF) = (u32x2){(unsigned)w0, (unsigned)w1}; } }
    }
};
}

struct Args {
    const float* x; const float* c; const int* pos; const float* w_ada; const float* b_ada;
    const float* g_pre_mix; const float* g_post_mix; const float* g_pre_ffn; const float* g_post_ffn;
    const float* w_in; const float* g_q_a; const float* g_kv_a; const float* w_q_b; const float* w_kv_b; const float* w_o;
    const float* w_router; const float* b_router; const float* w_mlp1; const float* b_mlp1; const float* w_mlp2; const float* b_mlp2;
    float* out; unsigned char* ws; int ph_lo, ph_hi;
};

__device__ __forceinline__ unsigned cvt_pk_bf16_(float lo, float hi) { unsigned r; asm volatile("v_cvt_pk_bf16_f32 %0, %1, %2" : "=v"(r) : "v"(lo), "v"(hi)); return r; }
template <bool FP8>
__device__ __forceinline__ void transpose_item(const float* W, int ldw, int srccol0, int nvalid, bool kvalid, const float* kscale, float cscale,
                                               void* WT, int ldk, int dstrow0, int k0, LAS float* scr, int lane) {
    const int kr = lane >> 3, n4 = (lane & 7) * 4;
#pragma unroll
    for (int i = 0; i < 8; ++i) { const int kk = kr + 8 * i;
        f32x4 v = (f32x4){0.f, 0.f, 0.f, 0.f};
        if (kvalid && n4 < nvalid) { v = *(const f32x4*)(W + (size_t)(k0 + kk) * ldw + srccol0 + n4); float sc = cscale; if (kscale) sc *= kscale[k0 + kk]; v = v * sc; }
        *(LAS f32x4*)(scr + kk * 36 + n4) = v; }
    LDS_WAIT(); asm volatile("" ::: "memory");
    const int n = lane & 31, kh = lane >> 5;
    const LAS float* sp = scr + (32 * kh) * 36 + n;
    if constexpr (FP8) {
        int w[8];
#pragma unroll
        for (int q = 0; q < 8; ++q) { float f0 = sp[(4 * q) * 36], f1 = sp[(4 * q + 1) * 36], f2 = sp[(4 * q + 2) * 36], f3 = sp[(4 * q + 3) * 36];
            f0 = fminf(fmaxf(f0, -448.f), 448.f); f1 = fminf(fmaxf(f1, -448.f), 448.f); f2 = fminf(fmaxf(f2, -448.f), 448.f); f3 = fminf(fmaxf(f3, -448.f), 448.f);
            int t = 0; t = __builtin_amdgcn_cvt_pk_fp8_f32(f0, f1, t, false); t = __builtin_amdgcn_cvt_pk_fp8_f32(f2, f3, t, true); w[q] = t; }
        unsigned char* dst = (unsigned char*)WT + (size_t)(dstrow0 + n) * ldk + k0 + 32 * kh;
        *(i32x4*)dst = (i32x4){w[0], w[1], w[2], w[3]}; *(i32x4*)(dst + 16) = (i32x4){w[4], w[5], w[6], w[7]};
    } else {
        unsigned w[16];
#pragma unroll
        for (int q = 0; q < 16; ++q) w[q] = cvt_pk_bf16_(sp[(2 * q) * 36], sp[(2 * q + 1) * 36]);
        bf16_t* dst = (bf16_t*)WT + (size_t)(dstrow0 + n) * ldk + k0 + 32 * kh;
#pragma unroll
        for (int q = 0; q < 4; ++q) *(u32x4*)(dst + 8 * q) = (u32x4){w[4 * q], w[4 * q + 1], w[4 * q + 2], w[4 * q + 3]};
    }
    LDS_WAIT(); asm volatile("" ::: "memory");
}

__device__ __forceinline__ void moe_item_decode(const Args& a, int r, const float*& W, int& ldw, unsigned char*& WT, int& srccol, int& k0) {
    constexpr int I_M1 = 32 * 16 * 64;
    if (r < I_M1) { const int e = r / 1024, q = r % 1024, kb = q / 64, nb = q % 64; W = a.w_mlp1 + (size_t)e * 1024 * 2048; ldw = 2048; WT = a.ws + WS_W1T + (size_t)e * 2048 * 1024; srccol = 32 * nb; k0 = 64 * kb; }
    else { r -= I_M1; const int e = r / 512, q = r % 512, kb = q / 32, nb = q % 32; W = a.w_mlp2 + (size_t)e * 1024 * 1024; ldw = 1024; WT = a.ws + WS_W2T + (size_t)e * 1024 * 1024; srccol = 32 * nb; k0 = 64 * kb; }
}
__device__ __forceinline__ void moe_item_load(const Args& a, int r, f32x4 (&v)[8], int lane) {
    const float* W; int ldw, srccol, k0; unsigned char* WT; moe_item_decode(a, r, W, ldw, WT, srccol, k0);
    const int kr = lane >> 3, n4 = (lane & 7) * 4;
#pragma unroll
    for (int i = 0; i < 8; ++i) v[i] = __builtin_nontemporal_load((const f32x4*)(W + (size_t)(k0 + kr + 8 * i) * ldw + srccol + n4));
}
__device__ __forceinline__ void moe_item_finish(const Args& a, int r, const f32x4 (&v)[8], LAS float* scr, int lane) {
    const float* W; int ldw, srccol, k0; unsigned char* WT; moe_item_decode(a, r, W, ldw, WT, srccol, k0);
    const int kr = lane >> 3, n4 = (lane & 7) * 4;
#pragma unroll
    for (int i = 0; i < 8; ++i) *(LAS f32x4*)(scr + (kr + 8 * i) * 36 + n4) = v[i] * pg8::W8_SCALE;
    LDS_WAIT(); asm volatile("" ::: "memory");
    const int n = lane & 31, kh = lane >> 5;
    const LAS float* sp = scr + (32 * kh) * 36 + n;
    int w[8];
#pragma unroll
    for (int q = 0; q < 8; ++q) { float f0 = sp[(4 * q) * 36], f1 = sp[(4 * q + 1) * 36], f2 = sp[(4 * q + 2) * 36], f3 = sp[(4 * q + 3) * 36];
        f0 = fminf(fmaxf(f0, -448.f), 448.f); f1 = fminf(fmaxf(f1, -448.f), 448.f); f2 = fminf(fmaxf(f2, -448.f), 448.f); f3 = fminf(fmaxf(f3, -448.f), 448.f);
        int t = 0; t = __builtin_amdgcn_cvt_pk_fp8_f32(f0, f1, t, false); t = __builtin_amdgcn_cvt_pk_fp8_f32(f2, f3, t, true); w[q] = t; }
    unsigned char* dst = WT + (size_t)(srccol + n) * 1024 + k0 + 32 * kh;
    *(i32x4*)dst = (i32x4){w[0], w[1], w[2], w[3]}; *(i32x4*)(dst + 16) = (i32x4){w[4], w[5], w[6], w[7]};
    LDS_WAIT(); asm volatile("" ::: "memory");
}

__device__ __forceinline__ void p0_prologue(const Args& a, LAS unsigned char* lds, int tid, int wave, int lane) {
    unsigned char* ws = a.ws;
    LAS float* scr = (LAS float*)(lds + wave * 9216);
    LAS float* cond = (LAS float*)(lds + 8 * 9216);
    for (int i = tid; i < NB * DM; i += 512) { const float v = a.c[i]; cond[i] = v / (1.f + __expf(-v)); }
    __syncthreads();
    const int gw = blockIdx.x * 8 + wave, NGW = gridDim.x * 8;
    constexpr int I_ADA = 8 * 192, I_IN = 16 * 48, I_QB = 4 * 24, I_KVB = 4 * 32, I_O = 16 * 32, I_M1 = 32 * 16 * 64, I_M2 = 32 * 16 * 32;
    constexpr int NITEMS = I_ADA + I_IN + I_QB + I_KVB + I_O;
    float* modp = (float*)(ws + WS_MODP);
    for (int it = gw; it < NITEMS; it += NGW) {
        int r = it;
        if (r < I_ADA) {
            const int kc = r / 192, cc = r % 192, k0 = 128 * kc + (lane >> 3), c0 = 32 * cc + 4 * (lane & 7);
            f32x4 acc[8];
#pragma unroll
            for (int b = 0; b < 8; ++b) acc[b] = (f32x4){0.f, 0.f, 0.f, 0.f};
#pragma unroll 8
            for (int i = 0; i < 16; ++i) { const int k = k0 + 8 * i;
                const f32x4 w = __builtin_nontemporal_load((const f32x4*)(a.w_ada + (size_t)k * 6144 + c0));
#pragma unroll
                for (int b = 0; b < 8; ++b) acc[b] += w * cond[b * DM + k]; }
#pragma unroll
            for (int b = 0; b < 8; ++b) {
#pragma unroll
                for (int j = 0; j < 4; ++j) { float v = acc[b][j]; v += __shfl_xor(v, 8); v += __shfl_xor(v, 16); v += __shfl_xor(v, 32); acc[b][j] = v; }
                if (lane < 8) *(f32x4*)(modp + (size_t)(kc * 8 + b) * 6144 + c0) = acc[b]; }
            continue;
        }
        r -= I_ADA;
        if (r < I_IN) {
            const int kb = r / 48, nb = r % 48, j = 32 * nb; int src, nv = 32; float cs = 1.f;
            if (j < 416) src = j;
            else if (j < 448) src = 1440 + (j - 416);
            else if (j < 480) { src = 1472; nv = 8; cs = 0.35355339059327373f; }
            else if (j < 512) { src = 0; nv = 0; }
            else if (j < 1024) { src = 416 + (j - 512); cs = 0.125f * LOG2E; }
            else if (j < 1152) src = 928 + (j - 1024);
            else if (j < 1280) src = 1056 + (j - 1152);
            else { src = 1184 + (j - 1280); cs = 0.17677669529663687f; }
            transpose_item<false>(a.w_in, 1480, src, nv, true, nullptr, cs, (bf16_t*)(ws + WS_WIN), 1024, j, 64 * kb, scr, lane); continue;
        }
        r -= I_IN;
        if (r < I_QB) { const int kb = r / 24, nb = r % 24;
            transpose_item<false>(a.w_q_b, 768, 32 * nb, 32, true, a.g_q_a, 1.f, (bf16_t*)(ws + WS_WQB), 256, 32 * nb, 64 * kb, scr, lane); continue; }
        r -= I_QB;
        if (r < I_KVB) { const int kb = r / 32, nb = r % 32, j = 32 * nb; int src;
            if (j < 512) src = (j >> 6) * 128 + (j & 63); else { const int jj = j - 512; src = (jj >> 6) * 128 + 64 + (jj & 63); }
            transpose_item<false>(a.w_kv_b, 1024, src, 32, kb < 2, a.g_kv_a, 1.f, (bf16_t*)(ws + WS_WKVB), 256, j, 64 * kb, scr, lane); continue; }
        r -= I_KVB;
        if (r < I_O) { const int kb = r / 32, nb = r % 32;
            transpose_item<true>(a.w_o, 1024, 32 * nb, 32, true, nullptr, pg8::W8_SCALE, ws + WS_WO, 1024, 32 * nb, 64 * kb, scr, lane); continue; }
    }
}

__device__ __forceinline__ void moe_weights_phase(const Args& a, LAS unsigned char* lds, int wave, int lane, int r0, int r1, int gw, int NGW) {
    LAS float* scr = (LAS float*)(lds + wave * 9216);
    constexpr int I_M1 = 32 * 16 * 64, I_M2 = 32 * 16 * 32;
    {
        const int NM = r1;
        f32x4 va[8], vb[8];
        int r = r0 + gw;
        if (r < NM) moe_item_load(a, r, va, lane);
#pragma unroll 1
        while (r < NM) {
            int r2 = r + NGW; if (r2 < NM) moe_item_load(a, r2, vb, lane);
            moe_item_finish(a, r, va, scr, lane);
            r = r2; if (r >= NM) break;
            r2 = r + NGW; if (r2 < NM) moe_item_load(a, r2, va, lane);
            moe_item_finish(a, r, vb, scr, lane);
            r = r2;
        }
    }
}

__device__ __forceinline__ float mod_at(const Args& a, int b, int j) {
    const float* modp = (const float*)(a.ws + WS_MODP);
    float s = a.b_ada[j];
#pragma unroll
    for (int kc = 0; kc < 8; ++kc) s += modp[(size_t)(kc * 8 + b) * 6144 + j];
    return s;
}

__device__ __forceinline__ void p1_rows(const Args& a, LAS unsigned char* lds, int tid, int wave, int lane) {
    LAS float* Amul = (LAS float*)lds; LAS float* Badd = Amul + DM;
    bf16_t* hb = (bf16_t*)(a.ws + WS_HB);
    float* rcos = (float*)(a.ws + WS_ROPE); float* rsin = rcos + (size_t)MT * 16;
    for (int blk = blockIdx.x; blk < MT / 64; blk += gridDim.x) {
        const int b = blk / 32;
        __syncthreads();
        for (int j = tid; j < DM; j += 512) { const float sh = mod_at(a, b, j), sc = mod_at(a, b, 1024 + j); Amul[j] = a.g_pre_mix[j] * (1.f + sc); Badd[j] = sh; }
        __syncthreads();
#pragma unroll 1
        for (int r0 = wave; r0 < 64; r0 += 32) {
            f32x4 v[4][4];
#pragma unroll
            for (int q = 0; q < 4; ++q) { const f32x4* xr = (const f32x4*)(a.x + (size_t)(blk * 64 + r0 + 8 * q) * DM) + lane;
#pragma unroll
                for (int j = 0; j < 4; ++j) v[q][j] = __builtin_nontemporal_load(xr + 64 * j); }
#pragma unroll
            for (int q = 0; q < 4; ++q) {
                const int row = blk * 64 + r0 + 8 * q;
                float ss = 0.f;
#pragma unroll
                for (int j = 0; j < 4; ++j) ss += (v[q][j][0] * v[q][j][0] + v[q][j][1] * v[q][j][1]) + (v[q][j][2] * v[q][j][2] + v[q][j][3] * v[q][j][3]);
                const float rstd = rsqrtf(wave_sum(ss) * (1.f / DM) + EPS);
                unsigned long long* o8 = (unsigned long long*)(hb + (size_t)row * DM) + lane;
#pragma unroll
                for (int j = 0; j < 4; ++j) { const f32x4 am = *(const LAS f32x4*)(Amul + 4 * lane + 256 * j), bd = *(const LAS f32x4*)(Badd + 4 * lane + 256 * j);
                    const f32x4 h = v[q][j] * rstd * am + bd;
                    o8[64 * j] = (unsigned long long)pk2(h[0], h[1]) | ((unsigned long long)pk2(h[2], h[3]) << 32); }
                if (lane < 16) { const float fr = powf(10000.f, -(float)lane / 16.f); const float ang = (float)a.pos[row] * fr; float sn, cs; sincosf(ang, &sn, &cs);
                    rcos[(size_t)row * 16 + lane] = cs; rsin[(size_t)row * 16 + lane] = sn; }
            }
        }
    }
}

__device__ __forceinline__ unsigned sortable(float v) { const unsigned u = __builtin_bit_cast(unsigned, v + 0.0f); return (u & 0x80000000u) ? ~u : (u | 0x80000000u); }

__device__ __forceinline__ unsigned wave_max_u(unsigned v) {
#pragma unroll
    for (int o = 1; o < 64; o <<= 1) { const unsigned w = (unsigned)__shfl_xor((int)v, o); v = v > w ? v : w; }
    return v; }
__device__ __forceinline__ unsigned wave_min_u(unsigned v) {
#pragma unroll
    for (int o = 1; o < 64; o <<= 1) { const unsigned w = (unsigned)__shfl_xor((int)v, o); v = v < w ? v : w; }
    return v; }

template <int NR>
__device__ __forceinline__ void idx_item(LAS unsigned char* lds, const bf16_t* proj, unsigned* bitmap, int b, int tg, int wave, int lane) {
    constexpr int SCS = 2052;
    LAS float* sc = (LAS float*)lds;
    LAS unsigned* cbuf = (LAS unsigned*)(lds + 16 * SCS * 4) + wave * 64;
    const int t0 = tg * 16, nkt = tg + 1;
    const int n = lane & 15, kq = lane >> 4;
    const size_t rowq = (size_t)(b * SEQ + t0 + n);
    bf16x8 qf[8];
#pragma unroll
    for (int h = 0; h < 8; ++h) qf[h] = *(const bf16x8*)(proj + rowq * NPROJ + PC_QIDX + h * 32 + 8 * kq);
    const u32x4 wraw = *(const u32x4*)(proj + rowq * NPROJ + PC_WIDX);
    float w[8]; w[0] = bflo(wraw.x); w[1] = bfhi(wraw.x); w[2] = bflo(wraw.y); w[3] = bfhi(wraw.y); w[4] = bflo(wraw.z); w[5] = bfhi(wraw.z); w[6] = bflo(wraw.w); w[7] = bfhi(wraw.w);
#pragma unroll 1
    for (int base = wave; base < nkt; base += 64) {
        bf16x8 kf[8];
#pragma unroll
        for (int i = 0; i < 8; ++i) { const int kt = base + 8 * i; if (kt < nkt) kf[i] = *(const bf16x8*)(proj + (size_t)(b * SEQ + 16 * kt + n) * NPROJ + PC_KIDX + 8 * kq); }
#pragma unroll
        for (int i = 0; i < 8; ++i) { const int kt = base + 8 * i;
            if (kt < nkt) {
                f32x4 s = (f32x4){0.f, 0.f, 0.f, 0.f};
#pragma unroll
                for (int h = 0; h < 8; ++h) { const f32x4 d = __builtin_amdgcn_mfma_f32_16x16x32_bf16(kf[i], qf[h], (f32x4){0.f, 0.f, 0.f, 0.f}, 0, 0, 0);
#pragma unroll
                    for (int j = 0; j < 4; ++j) s[j] = fmaf(w[h], fmaxf(d[j], 0.f), s[j]); }
                *(LAS f32x4*)(sc + n * SCS + 16 * kt + 4 * kq) = s;
            } }
    }
    __syncthreads();
#pragma unroll 1
    for (int qq = 0; qq < 2; ++qq) {
        const int q = 2 * wave + qq, t = t0 + q;
        unsigned key[NR];
#pragma unroll
        for (int j = 0; j < NR; ++j) key[j] = __builtin_bit_cast(unsigned, sc[q * SCS + 64 * j + lane]);
#pragma unroll
        for (int j = 0; j < NR; j += 8) asm volatile("" : "+v"(key[j]), "+v"(key[j + 1]), "+v"(key[j + 2]), "+v"(key[j + 3]), "+v"(key[j + 4]), "+v"(key[j + 5]), "+v"(key[j + 6]), "+v"(key[j + 7]));
#pragma unroll
        for (int j = 0; j < NR; ++j) key[j] = (64 * j + lane <= t) ? sortable(__builtin_bit_cast(float, key[j])) : 0u;
        unsigned long long mine = 0ull; int lo_ = lane; asm volatile("" : "+v"(lo_));
        const unsigned long long lt = (1ull << lane) - 1ull;
        if (t + 1 > 256) {
            unsigned mx = key[0], mn = key[0] ? key[0] : 0xffffffffu;
#pragma unroll
            for (int j = 1; j < NR; ++j) { mx = mx > key[j] ? mx : key[j]; const unsigned kk = key[j] ? key[j] : 0xffffffffu; mn = mn < kk ? mn : kk; }
            mx = wave_max_u(mx); mn = wave_min_u(mn);
            mx = (unsigned)__builtin_amdgcn_readfirstlane((int)mx); mn = (unsigned)__builtin_amdgcn_readfirstlane((int)mn);
            unsigned T = mx; int hiCnt = 0, ngt = 0, neq = 0; bool have = false;
            const unsigned diff = mx ^ mn;
            if (diff != 0u) {
                int bit = 31 - __builtin_clz(diff);
                T = mx & ~(((2u << bit) - 1u));
                int cntT = t + 1;
#pragma unroll 1
                while (bit >= 0 && cntT - hiCnt > 64) {
                    const unsigned cand = T | (1u << bit); unsigned cl = 0u;
#pragma unroll
                    for (int j = 0; j < NR; ++j) cl += (key[j] >= cand) ? 1u : 0u;
                    int c = 0;
#pragma unroll
                    for (int bb = 0; bb < 6; ++bb) c += __popcll(__ballot((cl >> bb) & 1u)) << bb;
                    if (c >= 256) { T = cand; cntT = c; } else hiCnt = c;
                    --bit;
                }
                if (bit >= 0) {
                    const unsigned span = (2u << bit) - 1u; int run = 0;
#pragma unroll
                    for (int j = 0; j < NR; ++j) { const bool in = (key[j] != 0u) && ((key[j] - T) <= span); const unsigned long long m = __ballot(in);
                        if (in) cbuf[run + __popcll(m & lt)] = key[j]; run += __popcll(m); if ((j & 3) == 3) __builtin_amdgcn_sched_barrier(0); }
                    LDS_WAIT();
                    const unsigned ck = (lane < run) ? cbuf[lane] : 0u;
#pragma unroll 1
                    for (; bit >= 0; --bit) { const unsigned cand = T | (1u << bit); const int c = __popcll(__ballot(ck >= cand)); if (hiCnt + c >= 256) T = cand; }
                    ngt = hiCnt + __popcll(__ballot(ck > T)); neq = __popcll(__ballot(ck == T)); have = true;
                }
            }
            if (!have) {
#pragma unroll
                for (int j = 0; j < NR; ++j) { ngt += __popcll(__ballot(key[j] > T)); neq += __popcll(__ballot(key[j] == T)); if ((j & 3) == 3) __builtin_amdgcn_sched_barrier(0); }
            }
            const int need = 256 - ngt;
            asm volatile("" : "+s"(T));
            if (neq == need) {
#pragma unroll
                for (int j = 0; j < NR; ++j) { const unsigned long long mk = __ballot(key[j] >= T); mine = (lo_ == j) ? mk : mine; if ((j & 3) == 3) __builtin_amdgcn_sched_barrier(0); }
            } else {
                int run = 0;
#pragma unroll
                for (int j = 0; j < NR; ++j) { const bool eq = key[j] == T; const unsigned long long em = __ballot(eq); const int rank = run + __popcll(em & lt);
                    const unsigned long long mk = __ballot(key[j] > T || (eq && rank < need)); mine = (lo_ == j) ? mk : mine; run += __popcll(em); if ((j & 3) == 3) __builtin_amdgcn_sched_barrier(0); }
            }
        } else {
#pragma unroll
            for (int j = 0; j < 4; ++j) { const unsigned long long mk = __ballot(64 * j + lo_ <= t); mine = (lo_ == j) ? mk : mine; }
        }
        if (lane < 32) ((unsigned long long*)bitmap)[(size_t)(b * SEQ + t) * 32 + lane] = mine;
    }
    __syncthreads();
}

__device__ __forceinline__ int crow(int r, int hi) { return (r & 3) + 8 * (r >> 2) + 4 * hi; }
typedef float f32x2_t __attribute__((ext_vector_type(2))); typedef __bf16 bf16x2_t __attribute__((ext_vector_type(2)));
__device__ __forceinline__ unsigned cvtpk(float lo, float hi) { f32x2_t v = {lo, hi}; bf16x2_t b = __builtin_convertvector(v, bf16x2_t); return __builtin_bit_cast(unsigned, b); }

template <int DQK, bool DSA>
__device__ __forceinline__ void attn_unit(LAS unsigned char* lds, int b, int qt,
                                          const bf16_t* Qp, int ldq, const bf16_t* Kp, int ldk, const bf16_t* Vt, unsigned char* Yp,
                                          const unsigned* bitmap, const int* pos, float c1, float aslope, int tid, int wave, int lane, LAS unsigned* tctr, unsigned& tgen) {
    constexpr int KSTR = DQK * 2 + 16, KBYTES = 64 * KSTR, VSTR = 136, VBYTES = 64 * VSTR, BUF = KBYTES + VBYTES + 256, NKS = DQK / 16, CPR = DQK / 8, NCH = 64 * CPR;
    const int hi = lane >> 5, l31 = lane & 31;
    const int NT = 2 * (qt + 1);
    const int qw0 = 128 * qt + 32 * wave, tq = qw0 + l31;
    const size_t rowq = (size_t)(b * SEQ + tq);
    bf16x8 qf[NKS];
#pragma unroll
    for (int ks = 0; ks < NKS; ++ks) qf[ks] = *(const bf16x8*)(Qp + rowq * ldq + 16 * ks + 8 * hi);
    float ptq = 0.f; if (DSA) ptq = (float)pos[b * SEQ + tq];
    constexpr float THR = 4.0f;
    float mref = 0.f, lrun = 0.f; bool seen = false; f32x16 o[2], negm;
#pragma unroll
    for (int r = 0; r < 16; ++r) { o[0][r] = 0.f; o[1][r] = 0.f; negm[r] = 0.f; }
    u32x4 kreg[NCH / 256], vreg[2]; int preg = 0;
#define TEAM_BAR() do { asm volatile("s_waitcnt lgkmcnt(0)" ::: "memory"); tgen += 4u; \
        if (lane == 0) (void)__hip_atomic_fetch_add(tctr, 1u, __ATOMIC_RELAXED, __HIP_MEMORY_SCOPE_WORKGROUP); \
        while ((unsigned)__builtin_amdgcn_readfirstlane((int)__hip_atomic_load(tctr, __ATOMIC_RELAXED, __HIP_MEMORY_SCOPE_WORKGROUP)) < tgen) __builtin_amdgcn_s_sleep(0); \
        asm volatile("" ::: "memory"); } while (0)
#define ATT_LOAD(t) do { const size_t kb_ = (size_t)(b * SEQ + 64 * (t)); \
        _Pragma("unroll") for (int i_ = 0; i_ < NCH / 256; ++i_) { const int c_ = tid + 256 * i_; kreg[i_] = *(const u32x4*)(Kp + (kb_ + c_ / CPR) * ldk + 8 * (c_ % CPR)); } \
        _Pragma("unroll") for (int i_ = 0; i_ < 2; ++i_) { const int c_ = tid + 256 * i_; vreg[i_] = *(const u32x4*)(Vt + (size_t)(c_ >> 3) * SEQ + 64 * (t) + 8 * (c_ & 7)); } \
        if (DSA && tid < 64) preg = pos[b * SEQ + 64 * (t) + tid]; } while (0)
#define ATT_WRITE(bufi) do { LAS unsigned char* bb_ = lds + (bufi) * BUF; \
        _Pragma("unroll") for (int i_ = 0; i_ < NCH / 256; ++i_) { const int c_ = tid + 256 * i_; *(LAS u32x4*)(bb_ + (c_ / CPR) * KSTR + 16 * (c_ % CPR)) = kreg[i_]; } \
        _Pragma("unroll") for (int i_ = 0; i_ < 2; ++i_) { const int c_ = tid + 256 * i_; \
            *(LAS u32x2*)(bb_ + KBYTES + (c_ >> 3) * VSTR + 16 * (c_ & 7)) = (u32x2){vreg[i_].x, vreg[i_].y}; *(LAS u32x2*)(bb_ + KBYTES + (c_ >> 3) * VSTR + 16 * (c_ & 7) + 8) = (u32x2){vreg[i_].z, vreg[i_].w}; } \
        if (DSA && tid < 64) *(LAS float*)(bb_ + KBYTES + VBYTES + 4 * tid) = (float)preg; } while (0)
    u32x2 bwn = (u32x2){0u, 0u}; if (DSA) bwn = *(const u32x2*)(bitmap + rowq * 64);
    ATT_LOAD(0); ATT_WRITE(0); TEAM_BAR();
    for (int t = 0; t < NT; ++t) {
        const u32x2 bw = bwn; if (DSA && t + 1 < NT) bwn = *(const u32x2*)(bitmap + rowq * 64 + 2 * (t + 1));
        if (t + 1 < NT) ATT_LOAD(t + 1);
        if (64 * t <= qw0 + 31) {
            const LAS unsigned char* bb = lds + (t & 1) * BUF;
            f32x16 s0 = negm, s1 = negm;
            bf16x8 kfa[NKS], kfb[NKS];
#pragma unroll
            for (int ks = 0; ks < NKS; ++ks) { kfa[ks] = *(const LAS bf16x8*)(bb + l31 * KSTR + 32 * ks + 16 * hi); kfb[ks] = *(const LAS bf16x8*)(bb + (32 + l31) * KSTR + 32 * ks + 16 * hi); }
            __builtin_amdgcn_sched_barrier(0);
#pragma unroll
            for (int ks = 0; ks < NKS; ++ks) {
                s0 = __builtin_amdgcn_mfma_f32_32x32x16_bf16(kfa[ks], qf[ks], s0, 0, 0, 0);
                s1 = __builtin_amdgcn_mfma_f32_32x32x16_bf16(kfb[ks], qf[ks], s1, 0, 0, 0);
            }
            __builtin_amdgcn_sched_barrier(0);
            const LAS unsigned char* vb = bb + KBYTES;
            u32x2 vlo[8], vhi[8];
#pragma unroll
            for (int kk = 0; kk < 2; ++kk)
#pragma unroll
                for (int s = 0; s < 2; ++s)
#pragma unroll
                    for (int db = 0; db < 2; ++db) { const LAS unsigned char* va = vb + (32 * db + l31) * VSTR + (32 * kk + 16 * s + 4 * hi) * 2;
                        vlo[(kk * 2 + s) * 2 + db] = *(const LAS u32x2*)va; vhi[(kk * 2 + s) * 2 + db] = *(const LAS u32x2*)(va + 16); }
            __builtin_amdgcn_sched_barrier(0);
            if (DSA) {
                asm volatile("s_nop 15\n\ts_nop 3" ::: "memory");
                __builtin_amdgcn_sched_barrier(0);
                const unsigned w0 = bw.x >> (4 * hi), w1 = bw.y >> (4 * hi);
                const LAS float* pp = (const LAS float*)(bb + KBYTES + VBYTES);
                const float nega = -aslope; const unsigned ninf = 0xff800000u;
#define DSA_EL(S, PK, W, BIT) do { float t_, v_; unsigned m_, r_; \
                    asm("v_sub_f32 %0, %1, %2" : "=v"(t_) : "v"(ptq), "v"(PK)); \
                    asm("v_fma_f32 %0, %1, |%2|, %3" : "=v"(v_) : "s"(nega), "v"(t_), "v"(S)); \
                    asm("v_bfe_i32 %0, %1, %2, 1" : "=v"(m_) : "v"(W), "n"(BIT)); \
                    asm("v_bfi_b32 %0, %1, %2, %3" : "=v"(r_) : "v"(m_), "v"(v_), "s"(ninf)); \
                    S = __builtin_bit_cast(float, r_); } while (0)
#pragma unroll
                for (int g = 0; g < 4; ++g) {
                    const f32x4 p0 = *(const LAS f32x4*)(pp + 8 * g + 4 * hi), p1 = *(const LAS f32x4*)(pp + 32 + 8 * g + 4 * hi);
                    DSA_EL(s0[4 * g + 0], p0[0], w0, 8 * g + 0); DSA_EL(s0[4 * g + 1], p0[1], w0, 8 * g + 1); DSA_EL(s0[4 * g + 2], p0[2], w0, 8 * g + 2); DSA_EL(s0[4 * g + 3], p0[3], w0, 8 * g + 3);
                    DSA_EL(s1[4 * g + 0], p1[0], w1, 8 * g + 0); DSA_EL(s1[4 * g + 1], p1[1], w1, 8 * g + 1); DSA_EL(s1[4 * g + 2], p1[2], w1, 8 * g + 2); DSA_EL(s1[4 * g + 3], p1[3], w1, 8 * g + 3);
                }
#undef DSA_EL
            } else {
                if (64 * t + 63 > qw0) {
#pragma unroll
                    for (int r = 0; r < 16; ++r) { const int key = 64 * t + crow(r, hi); if (key > tq) s0[r] = -INFINITY; if (key + 32 > tq) s1[r] = -INFINITY; }
                }
            }
            float mx;
            { float m0 = fmaxf(fmaxf(s0[0], s0[1]), s0[2]), m1 = fmaxf(fmaxf(s0[3], s0[4]), s0[5]), m2 = fmaxf(fmaxf(s1[0], s1[1]), s1[2]), m3 = fmaxf(fmaxf(s1[3], s1[4]), s1[5]);
              m0 = fmaxf(fmaxf(m0, s0[6]), s0[7]); m1 = fmaxf(fmaxf(m1, s0[8]), s0[9]); m2 = fmaxf(fmaxf(m2, s1[6]), s1[7]); m3 = fmaxf(fmaxf(m3, s1[8]), s1[9]);
              m0 = fmaxf(fmaxf(m0, s0[10]), s0[11]); m1 = fmaxf(fmaxf(m1, s0[12]), s0[13]); m2 = fmaxf(fmaxf(m2, s1[10]), s1[11]); m3 = fmaxf(fmaxf(m3, s1[12]), s1[13]);
              m0 = fmaxf(fmaxf(m0, s0[14]), s0[15]); m2 = fmaxf(fmaxf(m2, s1[14]), s1[15]);
              mx = fmaxf(fmaxf(m0, m1), fmaxf(m2, m3)); }
            { float ma = mx, mb = mx; asm volatile("s_nop 1\n\tv_permlane32_swap_b32 %0, %1" : "+v"(ma), "+v"(mb)); mx = fmaxf(ma, mb); }
            {
                const bool fin = mx > -INFINITY, first = fin && !seen, upd = first || (mx > THR);
                if (__any(upd)) {
                    const float dl = upd ? mx : 0.f;
                    const float alpha = first ? 1.f : __builtin_amdgcn_exp2f(-dl);
                    mref += dl; lrun *= alpha;
#pragma unroll
                    for (int r = 0; r < 16; ++r) { s0[r] -= dl; s1[r] -= dl; o[0][r] *= alpha; o[1][r] *= alpha; negm[r] = -mref; }
                }
                seen = seen || fin;
            }
            float psum = 0.f;
#pragma unroll
            for (int r = 0; r < 16; ++r) { s0[r] = __builtin_amdgcn_exp2f(s0[r]); s1[r] = __builtin_amdgcn_exp2f(s1[r]); }
            { float q0 = 0.f, q1 = 0.f, q2 = 0.f, q3 = 0.f;
#pragma unroll
              for (int r = 0; r < 16; r += 4) { q0 += s0[r] + s1[r]; q1 += s0[r + 1] + s1[r + 1]; q2 += s0[r + 2] + s1[r + 2]; q3 += s0[r + 3] + s1[r + 3]; }
              psum = (q0 + q1) + (q2 + q3); }
            lrun += psum;
            unsigned pb0[8], pb1[8];
#pragma unroll
            for (int i = 0; i < 8; ++i) { pb0[i] = cvtpk(s0[2 * i], s0[2 * i + 1]); pb1[i] = cvtpk(s1[2 * i], s1[2 * i + 1]); }
            __builtin_amdgcn_sched_barrier(0);
#pragma unroll
            for (int kk = 0; kk < 2; ++kk)
#pragma unroll
                for (int s = 0; s < 2; ++s) {
                    u32x4 pf; if (kk == 0) pf = (u32x4){pb0[4 * s], pb0[4 * s + 1], pb0[4 * s + 2], pb0[4 * s + 3]}; else pf = (u32x4){pb1[4 * s], pb1[4 * s + 1], pb1[4 * s + 2], pb1[4 * s + 3]};
                    const bf16x8 pfr = __builtin_bit_cast(bf16x8, pf);
#pragma unroll
                    for (int db = 0; db < 2; ++db) { const int fi = (kk * 2 + s) * 2 + db;
                        const bf16x8 vf = __builtin_bit_cast(bf16x8, (u32x4){vlo[fi].x, vlo[fi].y, vhi[fi].x, vhi[fi].y});
                        o[db] = __builtin_amdgcn_mfma_f32_32x32x16_bf16(vf, pfr, o[db], 0, 0, 0); }
                }
        }
        if (t + 1 < NT) ATT_WRITE((t + 1) & 1);
        TEAM_BAR();
    }
#undef ATT_LOAD
#undef ATT_WRITE
#undef TEAM_BAR
    const float lt = lrun + __shfl_xor(lrun, 32);
    const float inv = 1.f / lt;
#pragma unroll
    for (int db = 0; db < 2; ++db)
#pragma unroll
        for (int g = 0; g < 4; ++g) { int w = 0; w = __builtin_amdgcn_cvt_pk_fp8_f32(o[db][4 * g] * inv, o[db][4 * g + 1] * inv, w, false); w = __builtin_amdgcn_cvt_pk_fp8_f32(o[db][4 * g + 2] * inv, o[db][4 * g + 3] * inv, w, true);
            *(int*)(Yp + rowq * DM + 32 * db + 8 * g + 4 * hi) = w; }
}

typedef float f32x2v __attribute__((ext_vector_type(2)));
__device__ __forceinline__ void p6_front(const Args& a, const bf16_t* mix, unsigned char* hb8, const LAS float* GT1, const LAS float* A2, const LAS float* B2, int row, int lane, f32x4 (&xv)[4]) {
    const u32x2* mr = (const u32x2*)(mix + (size_t)row * DM) + lane;
    const f32x4* xr = (const f32x4*)(a.x + (size_t)row * DM) + lane;
    f32x4 mv[4]; float ss = 0.f;
#pragma unroll
    for (int j = 0; j < 4; ++j) { const u32x2 q = __builtin_nontemporal_load(mr + 64 * j); mv[j] = (f32x4){bflo(q.x), bfhi(q.x), bflo(q.y), bfhi(q.y)}; xv[j] = __builtin_nontemporal_load(xr + 64 * j);
        ss += (mv[j][0] * mv[j][0] + mv[j][1] * mv[j][1]) + (mv[j][2] * mv[j][2] + mv[j][3] * mv[j][3]); }
    const float rstd1 = rsqrtf(wave_sum(ss) * (1.f / DM) + EPS);
    float ss2 = 0.f;
    f32x4* orow = (f32x4*)(a.out + (size_t)row * DM) + lane;
#pragma unroll
    for (int j = 0; j < 4; ++j) { const f32x4 g1 = *(const LAS f32x4*)(GT1 + 4 * lane + 256 * j);
        xv[j] = xv[j] + g1 * (mv[j] * rstd1); orow[64 * j] = xv[j];
        ss2 += (xv[j][0] * xv[j][0] + xv[j][1] * xv[j][1]) + (xv[j][2] * xv[j][2] + xv[j][3] * xv[j][3]); }
    const float rstd2 = rsqrtf(wave_sum(ss2) * (1.f / DM) + EPS);
    int* o4 = (int*)(hb8 + (size_t)row * DM) + lane;
#pragma unroll
    for (int j = 0; j < 4; ++j) { const f32x4 am = *(const LAS f32x4*)(A2 + 4 * lane + 256 * j), bd = *(const LAS f32x4*)(B2 + 4 * lane + 256 * j);
        xv[j] = xv[j] * rstd2 * am + bd;
        int w = 0; w = __builtin_amdgcn_cvt_pk_fp8_f32(xv[j][0], xv[j][1], w, false); w = __builtin_amdgcn_cvt_pk_fp8_f32(xv[j][2], xv[j][3], w, true);
        o4[64 * j] = w; }
}
__device__ __forceinline__ void p6_route(const Args& a, float (&pe)[32], LAS int* lcnt, LAS int* info, int r, int lane) {
    { const bool b5 = (lane & 32) != 0, b4 = (lane & 16) != 0, b3 = (lane & 8) != 0, b2 = (lane & 4) != 0, b1 = (lane & 2) != 0;
#pragma unroll
      for (int i = 0; i < 16; ++i) { const float keep = b5 ? pe[16 + i] : pe[i], send = b5 ? pe[i] : pe[16 + i]; pe[i] = keep + __shfl_xor(send, 32); }
#pragma unroll
      for (int i = 0; i < 8; ++i) { const float keep = b4 ? pe[8 + i] : pe[i], send = b4 ? pe[i] : pe[8 + i]; pe[i] = keep + __shfl_xor(send, 16); }
#pragma unroll
      for (int i = 0; i < 4; ++i) { const float keep = b3 ? pe[4 + i] : pe[i], send = b3 ? pe[i] : pe[4 + i]; pe[i] = keep + __shfl_xor(send, 8); }
#pragma unroll
      for (int i = 0; i < 2; ++i) { const float keep = b2 ? pe[2 + i] : pe[i], send = b2 ? pe[i] : pe[2 + i]; pe[i] = keep + __shfl_xor(send, 4); }
      { const float keep = b1 ? pe[1] : pe[0], send = b1 ? pe[0] : pe[1]; pe[0] = keep + __shfl_xor(send, 2); }
      pe[0] += __shfl_xor(pe[0], 1); }
    const int myexp = lane >> 1;
    const float mylg = pe[0] + a.b_router[myexp];
    int rank = 0;
#pragma unroll
    for (int j = 0; j < 32; ++j) { const float vj = __builtin_bit_cast(float, __builtin_amdgcn_readlane(__builtin_bit_cast(int, mylg), 2 * j));
        rank += (vj > mylg || (vj == mylg && j < myexp)) ? 1 : 0; }
    float tv[4]; int ti[4];
#pragma unroll
    for (int p = 0; p < 4; ++p) { const unsigned long long bm = __ballot(rank == p && !(lane & 1)); const int bi = __builtin_ctzll(bm);
        ti[p] = bi >> 1; tv[p] = __builtin_bit_cast(float, __builtin_amdgcn_readlane(__builtin_bit_cast(int, mylg), bi)); }
    float ex[4], es = 0.f;
#pragma unroll
    for (int p = 0; p < 4; ++p) { ex[p] = __expf(tv[p] - tv[0]); es += ex[p]; }
    if (lane < 4) {
        const int e = lane == 0 ? ti[0] : lane == 1 ? ti[1] : lane == 2 ? ti[2] : ti[3];
        const float g = (lane == 0 ? ex[0] : lane == 1 ? ex[1] : lane == 2 ? ex[2] : ex[3]) / es;
        const int lr = __hip_atomic_fetch_add(&lcnt[e], 1, __ATOMIC_RELAXED, __HIP_MEMORY_SCOPE_WORKGROUP);
        info[(r * 4 + lane) * 3 + 0] = e; info[(r * 4 + lane) * 3 + 1] = lr; info[(r * 4 + lane) * 3 + 2] = __builtin_bit_cast(int, g);
    }
}

__device__ __forceinline__ void p6_rows(const Args& a, LAS unsigned char* lds, int tid, int wave, int lane) {
    constexpr int WTS = 1028;
    LAS float* WT = (LAS float*)lds;
    LAS float* GT1 = WT + 32 * WTS; LAS float* A2 = GT1 + DM; LAS float* B2 = A2 + DM;
    LAS int* lcnt = (LAS int*)(B2 + DM); LAS int* lbase = lcnt + 32; LAS int* info = lbase + 32;
    unsigned char* ws = a.ws;
    const bf16_t* mix = (const bf16_t*)(ws + WS_MIX); unsigned char* hb8 = ws + WS_HB;
    int* cnt = (int*)(ws + WS_CTL) + CW_CNT; int* list = (int*)(ws + WS_LIST);
    int* route_e = (int*)(ws + WS_ROUTE); int* route_pos = route_e + MT * 4; float* gate = (float*)(route_pos + MT * 4);
    for (int i = tid; i < DM * NE; i += 512) WT[(i & 31) * WTS + (i >> 5)] = a.w_router[i];
    if (tid < 32) lcnt[tid] = 0;
    for (int blk = blockIdx.x; blk < MT / 64; blk += gridDim.x) {
        const int b = blk / 32;
        __syncthreads();
        for (int j = tid; j < DM; j += 512) { GT1[j] = mod_at(a, b, 2048 + j) * a.g_post_mix[j]; A2[j] = a.g_pre_ffn[j] * (1.f + mod_at(a, b, 4096 + j)); B2[j] = mod_at(a, b, 3072 + j); }
        __syncthreads();
#pragma unroll 1
        for (int it = 0; it < 4; ++it) {
            const int rA = wave + 16 * it, rB = rA + 8;
            const int ln = fresh_lane();
            f32x4 xa[4], xb[4];
            p6_front(a, mix, hb8, GT1, A2, B2, blk * 64 + rA, ln, xa);
            p6_front(a, mix, hb8, GT1, A2, B2, blk * 64 + rB, ln, xb);
            float pa[32], pb[32];
#pragma unroll
            for (int e = 0; e < 32; ++e) { f32x2v accA = (f32x2v){0.f, 0.f}, accB = (f32x2v){0.f, 0.f};
#pragma unroll
                for (int j = 0; j < 4; ++j) { const f32x4 wv = *(const LAS f32x4*)(WT + e * WTS + 4 * ln + 256 * j);
                    const f32x2v w01 = (f32x2v){wv[0], wv[1]}, w23 = (f32x2v){wv[2], wv[3]};
                    accA = __builtin_elementwise_fma((f32x2v){xa[j][0], xa[j][1]}, w01, accA); accA = __builtin_elementwise_fma((f32x2v){xa[j][2], xa[j][3]}, w23, accA);
                    accB = __builtin_elementwise_fma((f32x2v){xb[j][0], xb[j][1]}, w01, accB); accB = __builtin_elementwise_fma((f32x2v){xb[j][2], xb[j][3]}, w23, accB); }
                pa[e] = accA.x + accA.y; pb[e] = accB.x + accB.y; if ((e & 3) == 3) __builtin_amdgcn_sched_barrier(0); }
#pragma unroll 1
            for (int rr = 0; rr < 2; ++rr) {
                const int ln2 = fresh_lane();
                p6_route(a, pa, lcnt, info, rr ? rB : rA, ln2);
#pragma unroll
                for (int e = 0; e < 32; ++e) pa[e] = pb[e];
            }
        }
        __syncthreads();
        if (tid < 32) lbase[tid] = atomicAdd(cnt + CNT_STRIDE * tid, lcnt[tid]);
        __syncthreads();
        if (tid < 256) { const int e = info[tid * 3 + 0], p = lbase[e] + info[tid * 3 + 1]; const int row = blk * 64 + (tid >> 2);
            list[e * MT + p] = row; route_e[row * 4 + (tid & 3)] = e; route_pos[row * 4 + (tid & 3)] = p; gate[row * 4 + (tid & 3)] = __builtin_bit_cast(float, info[tid * 3 + 2]); }
        __syncthreads();
        if (tid < 32) lcnt[tid] = 0;
    }
}

__device__ __forceinline__ void p9_rows(const Args& a, LAS unsigned char* lds, const LAS int* ts, int tid, int wave, int lane) {
    LAS float* GT2 = (LAS float*)lds;
    unsigned char* ws = a.ws;
    const unsigned char* yb = ws + WS_YB;
    const int* route_e = (const int*)(ws + WS_ROUTE); const int* route_pos = route_e + MT * 4; const float* gate = (const float*)(route_pos + MT * 4);
    for (int blk = blockIdx.x; blk < MT / 64; blk += gridDim.x) {
        const int b = blk / 32;
        __syncthreads();
        for (int j = tid; j < DM; j += 512) GT2[j] = mod_at(a, b, 5120 + j) * a.g_post_ffn[j];
        __syncthreads();
#pragma unroll 1
        for (int r0 = wave; r0 < 64; r0 += 16) {
            i32x4 re[2], rp[2]; f32x4 gg[2];
#pragma unroll
            for (int q = 0; q < 2; ++q) { const int row = blk * 64 + r0 + 8 * q; re[q] = *(const i32x4*)(route_e + row * 4); rp[q] = *(const i32x4*)(route_pos + row * 4); gg[q] = *(const f32x4*)(gate + row * 4); }
            int yv[2][4][4]; f32x4 xo[2][4];
#pragma unroll
            for (int q = 0; q < 2; ++q) { const int row = blk * 64 + r0 + 8 * q;
#pragma unroll
                for (int k = 0; k < 4; ++k) { const int slot = ts[re[q][k]] * 256 + rp[q][k]; const int* yr = (const int*)(yb + (size_t)slot * FE) + lane;
#pragma unroll
                    for (int j = 0; j < 4; ++j) yv[q][k][j] = __builtin_nontemporal_load(yr + 64 * j); }
                const f32x4* orow = (const f32x4*)(a.out + (size_t)row * DM) + lane;
#pragma unroll
                for (int j = 0; j < 4; ++j) xo[q][j] = __builtin_nontemporal_load(orow + 64 * j); }
#pragma unroll
            for (int q = 0; q < 2; ++q) { const int row = blk * 64 + r0 + 8 * q;
                f32x4 f[4];
#pragma unroll
                for (int j = 0; j < 4; ++j) f[j] = (f32x4){0.f, 0.f, 0.f, 0.f};
#pragma unroll
                for (int k = 0; k < 4; ++k) { const float g = gg[q][k];
#pragma unroll
                    for (int j = 0; j < 4; ++j) { const int w = yv[q][k][j]; const f32x2v lo = __builtin_amdgcn_cvt_pk_f32_fp8(w, false), hi2 = __builtin_amdgcn_cvt_pk_f32_fp8(w, true); f[j] += (f32x4){lo.x, lo.y, hi2.x, hi2.y} * g; } }
                float ss = 0.f;
#pragma unroll
                for (int j = 0; j < 4; ++j) ss += (f[j][0] * f[j][0] + f[j][1] * f[j][1]) + (f[j][2] * f[j][2] + f[j][3] * f[j][3]);
                const float rstd = rsqrtf(wave_sum(ss) * (1.f / DM) + EPS);
                f32x4* orow = (f32x4*)(a.out + (size_t)row * DM) + lane;
#pragma unroll
                for (int j = 0; j < 4; ++j) { const f32x4 g2 = *(const LAS f32x4*)(GT2 + 4 * lane + 256 * j); __builtin_nontemporal_store(xo[q][j] + g2 * (f[j] * rstd), orow + 64 * j); }
            }
        }
    }
}

#define XB_TMO      128
#define XB_XCNT(j)  (256  + 64 * (j))
#define XB_XSUB(j)  (1280 + 64 * (j))
#define XB_XGEN(j)  (2304 + 64 * (j))
#define XB_TOP      3328
#define XB_TOPGEN   3392
#define XCD_BAR_WORDS 3456
#define XB_SPIN_CAP (1u << 22)
__device__ __forceinline__ unsigned xb_ld(unsigned* p)              { return __hip_atomic_load(p, __ATOMIC_RELAXED, __HIP_MEMORY_SCOPE_AGENT); }
__device__ __forceinline__ unsigned xb_add(unsigned* p, unsigned v) { return __hip_atomic_fetch_add(p, v, __ATOMIC_RELAXED, __HIP_MEMORY_SCOPE_AGENT); }
__device__ __forceinline__ unsigned xb_xcc_id() { return (unsigned)__builtin_amdgcn_s_getreg((3 << 11) | 20) & 0xFu; }
#define XB_SPIN(cond, bar) do { unsigned _sp = 0; while (cond) { __builtin_amdgcn_s_sleep(1); \
    if ((++_sp & 255u) == 0u) { if (xb_ld(&(bar)[XB_TMO])) break; if (_sp > XB_SPIN_CAP) { atomicAdd(&(bar)[XB_TMO], 1u); break; } } } } while (0)
struct XcdBarrier { unsigned* bar; unsigned x; volatile LAS unsigned* st; };
__device__ __forceinline__ void xcd_barrier_complete(unsigned* bar, unsigned x, unsigned& nloc, unsigned& nx) {
    const unsigned G = gridDim.x;
    unsigned sum, cnt, mine, sp = 0u;
    for (;;) {
        sum = 0u; cnt = 0u; mine = 0u;
#pragma unroll
        for (unsigned j = 0; j < 16; ++j) { const unsigned c = xb_ld(&bar[XB_XCNT(j)]); sum += c; cnt += (c > 0u) ? 1u : 0u; mine = (j == x) ? c : mine; }
        if (sum == G) break;
        __builtin_amdgcn_s_sleep(1);
        if ((++sp & 255u) == 0u) { if (xb_ld(&bar[XB_TMO])) break; if (sp > XB_SPIN_CAP) { atomicAdd(&bar[XB_TMO], 1u); break; } }
    }
    nloc = mine > 0u ? mine : 1u; nx = cnt > 0u ? cnt : 1u;
}
__device__ __forceinline__ void xcd_barrier(const XcdBarrier& b, bool leader_thread) {
    asm volatile("s_waitcnt vmcnt(0)" ::: "memory");
    __syncthreads();
    if (leader_thread) {
        unsigned* bar = b.bar;
        __builtin_amdgcn_s_waitcnt(0);
        unsigned nloc = b.st[0], nx = b.st[1];
        if (nloc == 0u) { xcd_barrier_complete(bar, b.x, nloc, nx); b.st[0] = nloc; b.st[1] = nx; }
        const unsigned old = xb_add(&bar[XB_XSUB(b.x)], 1u);
        const unsigned gen = old / nloc;
        if (old + 1u == (gen + 1u) * nloc) {
            __builtin_amdgcn_fence(__ATOMIC_RELEASE, "agent");
            asm volatile("s_waitcnt vmcnt(0)" ::: "memory");
            const unsigned og = xb_add(&bar[XB_TOP], 1u);
            const unsigned tg = og / nx;
            if (og + 1u == (tg + 1u) * nx) xb_add(&bar[XB_TOPGEN], 1u);
            else XB_SPIN(xb_ld(&bar[XB_TOPGEN]) == tg, bar);
            __builtin_amdgcn_fence(__ATOMIC_ACQUIRE, "agent");
            xb_add(&bar[XB_XGEN(b.x)], 1u);
            asm volatile("s_waitcnt vmcnt(0)" ::: "memory");
        } else {
            XB_SPIN(xb_ld(&bar[XB_XGEN(b.x)]) == gen, bar);
            __builtin_amdgcn_fence(__ATOMIC_ACQUIRE, "agent");
            asm volatile("s_waitcnt vmcnt(0)" ::: "memory");
        }
    }
    __syncthreads();
}

constexpr int N_PHASES = 10;
constexpr int CONV_EARLY = 5376;
__global__ void __launch_bounds__(512, 2) mk_fwd(Args a) {
    extern __shared__ __attribute__((aligned(16))) unsigned char lds_raw[];
    LAS unsigned char* lds = (LAS unsigned char*)lds_raw;
    const int wave = __builtin_amdgcn_readfirstlane(threadIdx.x >> 6);
    int lane, tid;
#define FRESH() do { lane = fresh_lane(); tid = wave * 64 + lane; } while (0)
    unsigned char* ws = a.ws;
    LAS int* ts = (LAS int*)(lds + LDS_CTRL);
    LAS int* cnts = ts + 40;
    const int lo = a.ph_lo, hi = a.ph_hi;
#ifndef PHASE_MASK
#define PHASE_MASK 0xFFFF
#endif
#define IN(k) (((PHASE_MASK >> (k)) & 1) && lo <= (k) && (k) < hi)
#define SEAM(k) do { if (IN(k) && IN((k) + 1)) { FRESH(); xcd_barrier(xb, tid == 0); } } while (0)
    XcdBarrier xb; xb.bar = (unsigned*)(ws + WS_CTL) + CW_BAR; xb.x = xb_xcc_id(); xb.st = (volatile LAS unsigned*)(lds + LDS_CTRL + 320);
    if (hi - lo > 1) {
        if (threadIdx.x == 0) { xb.st[0] = 0u; xb.st[1] = 0u; (void)xb_add(&xb.bar[XB_XCNT(xb.x)], 1u); }
        __syncthreads();
    }

    if (IN(0)) { FRESH(); p0_prologue(a, lds, tid, wave, lane); }
    SEAM(0);
    if (IN(1)) { FRESH(); p1_rows(a, lds, tid, wave, lane); }
    SEAM(1);
    if (IN(2)) {
        pg8::StaticOrder S; S.init(MT, NPROJ, gridDim.x, blockIdx.x, ws + WS_WIN, 2048);
        float* rcos = (float*)(ws + WS_ROPE);
        pg8::EpiInProj E{(bf16_t*)(ws + WS_PROJ), (float*)(ws + WS_SSQ), (float*)(ws + WS_SSQ) + MT * 4, (bf16_t*)(ws + WS_KM), (bf16_t*)(ws + WS_VTD), rcos, rcos + (size_t)MT * 16};
        __syncthreads();
        pg8::gemm_phase<pg8::EpiInProj, pg8::StaticOrder, true>(lds, ws + WS_HB, 2048, 2048, S, E, wave);
        if (gridDim.x == 256 && blockIdx.x >= 128) { __syncthreads(); FRESH(); moe_weights_phase(a, lds, wave, lane, 0, CONV_EARLY, (blockIdx.x - 128) * 8 + wave, 128 * 8); }
        else if (gridDim.x != 256 && blockIdx.x == 0) { __syncthreads(); FRESH(); moe_weights_phase(a, lds, wave, lane, 0, CONV_EARLY, wave, 8); }
    }
    SEAM(2);
    if (IN(3)) {
        float* rcos = (float*)(ws + WS_ROPE);
        __syncthreads();
#ifndef SUB3
#define SUB3 7
#endif
        if (SUB3 & 1) { pg8::StaticOrder S; S.init(MT, 768, gridDim.x, blockIdx.x, ws + WS_WQB, 512);
          pg8::EpiQb E{(bf16_t*)(ws + WS_QM), (const float*)(ws + WS_SSQ), rcos, rcos + (size_t)MT * 16, 0.10206207261596575f * LOG2E};
          pg8::gemm_phase<pg8::EpiQb, pg8::StaticOrder, true>(lds, (const bf16_t*)(ws + WS_PROJ) + PC_CQ, NPROJ * 2, 512, S, E, wave); }
        __syncthreads();
        if (SUB3 & 2) { pg8::StaticOrder S; S.init(MT, 1024, gridDim.x, blockIdx.x, ws + WS_WKVB, 512);
          pg8::EpiKvb E{(bf16_t*)(ws + WS_KM), (bf16_t*)(ws + WS_VTM), (const float*)(ws + WS_SSQ) + MT * 4};
          pg8::gemm_phase<pg8::EpiKvb, pg8::StaticOrder, true>(lds, (const bf16_t*)(ws + WS_PROJ) + PC_CKV, NPROJ * 2, 512, S, E, wave); }
        __syncthreads();
        FRESH();
        if (SUB3 & 4) for (int v = blockIdx.x; v < 256; v += gridDim.x) {
            const int b = v & 7, aa = v >> 3;
            idx_item<8>(lds, (const bf16_t*)(ws + WS_PROJ), (unsigned*)(ws + WS_BITMAP), b, aa, wave, lane);
            FRESH(); idx_item<16>(lds, (const bf16_t*)(ws + WS_PROJ), (unsigned*)(ws + WS_BITMAP), b, 63 - aa, wave, lane);
            FRESH(); idx_item<24>(lds, (const bf16_t*)(ws + WS_PROJ), (unsigned*)(ws + WS_BITMAP), b, 64 + aa, wave, lane);
            FRESH(); idx_item<32>(lds, (const bf16_t*)(ws + WS_PROJ), (unsigned*)(ws + WS_BITMAP), b, 127 - aa, wave, lane);
        }
    }
    SEAM(3);
    if (IN(4)) {
        __syncthreads(); FRESH();
        LAS unsigned* tc = (LAS unsigned*)(lds + LDS_CTRL + 336);
        if (tid < 2) tc[tid] = 0u;
        __syncthreads();
        const int team = wave >> 2, wt = wave & 3;
        LAS unsigned char* tl = lds + team * (2 * 22272);
        unsigned tgen = 0u;
        for (int v0_ = blockIdx.x; v0_ < 256; v0_ += gridDim.x) {
            const int v = (gridDim.x == 256) ? ((v0_ & 7) * 32 + (v0_ >> 3)) : v0_;
            const int T = 2 * v + team, bh = T >> 3, b = bh >> 3, h = bh & 7, s2 = T & 7, kvh = h >> 2;
#pragma unroll 1
            for (int i = 0; i < 4; ++i) {
                const int qt = (i & 1) ? 15 - s2 : s2; const bool mla = ((i >> 1) == team);
                const int ln = fresh_lane(), tt = wt * 64 + ln;
                if (mla) attn_unit<96, false>(tl, b, qt, (const bf16_t*)(ws + WS_QM) + h * 96, 768, (const bf16_t*)(ws + WS_KM) + h * 96, 768,
                                              (const bf16_t*)(ws + WS_VTM) + (size_t)(b * 8 + h) * 64 * SEQ, (unsigned char*)(ws + WS_Y) + h * 64, nullptr, nullptr, 0.f, 0.f, tt, wt, ln, tc + team, tgen);
                else attn_unit<64, true>(tl, b, qt, (const bf16_t*)(ws + WS_PROJ) + PC_QD + h * 64, NPROJ, (const bf16_t*)(ws + WS_PROJ) + PC_KD + kvh * 64, NPROJ,
                                         (const bf16_t*)(ws + WS_VTD) + (size_t)(b * 2 + kvh) * 64 * SEQ, (unsigned char*)(ws + WS_Y) + 512 + h * 64, (const unsigned*)(ws + WS_BITMAP), a.pos,
                                         0.125f * LOG2E, exp2f(-(float)(h + 1)) * LOG2E, tt, wt, ln, tc + team, tgen);
            }
        }
    }
    SEAM(4);
    if (IN(5)) {
        pg8::StaticOrder S; S.init(MT, DM, gridDim.x, blockIdx.x, ws + WS_WO, 1024);
        pg8::EpiPlain E{(bf16_t*)(ws + WS_MIX), DM, 1.f / 64.f};
        __syncthreads();
        pg8::gemm_phase<pg8::EpiPlain, pg8::StaticOrder, true, true>(lds, ws + WS_Y, 1024, 1024, S, E, wave);
    }
    SEAM(5);
    if (IN(6)) { __syncthreads(); FRESH(); p6_rows(a, lds, tid, wave, lane); __syncthreads(); FRESH(); moe_weights_phase(a, lds, wave, lane, CONV_EARLY, 32 * 16 * 96, blockIdx.x * 8 + wave, gridDim.x * 8); }
    SEAM(6);
    if (IN(7) || IN(8) || IN(9)) {
        __syncthreads(); FRESH();
        if (tid == 0) { const int* cnt = (const int*)(ws + WS_CTL) + CW_CNT; int acc = 0;
            for (int e = 0; e < 32; ++e) { const int c = cnt[CNT_STRIDE * e]; ts[e] = acc; cnts[e] = c; acc += (c + 255) >> 8; }
            ts[32] = acc; }
        __syncthreads();
    }
    if (IN(7)) {
        pg8::MoeOrder<true> S; S.init(ts, cnts, (const int*)(ws + WS_LIST), ws + WS_W1T, 2048, 1024, 8, gridDim.x, blockIdx.x);
        pg8::EpiMoe1 E{ws + WS_ACT, a.b_mlp1};
        pg8::gemm_phase<pg8::EpiMoe1, pg8::MoeOrder<true>, true, true>(lds, ws + WS_HB, 1024, 1024, S, E, wave);
    }
    SEAM(7);
    if (IN(8)) {
        pg8::MoeOrder<false> S; S.init(ts, cnts, (const int*)(ws + WS_LIST), ws + WS_W2T, 1024, 1024, 4, gridDim.x, blockIdx.x);
        pg8::EpiMoe2 E{ws + WS_YB, a.b_mlp2};
        __syncthreads();
        pg8::gemm_phase<pg8::EpiMoe2, pg8::MoeOrder<false>, true, true>(lds, ws + WS_ACT, 1024, 1024, S, E, wave);
    }
    SEAM(8);
    if (IN(9)) { __syncthreads(); FRESH(); p9_rows(a, lds, ts, tid, wave, lane); }
#undef IN
#undef SEAM
}

extern "C" void kernel_launch(void* const* d_in, const int* in_sizes, int n_in, void* d_out, int out_size, void* d_ws, size_t ws_size, hipStream_t stream) {
    static int grid = 0;
    if (grid == 0) {
        if (n_in != 21 || out_size != MT * DM || ws_size < WS_END) { fprintf(stderr, "kernel_launch: unexpected shapes (n_in %d out %d ws %zu)\n", n_in, out_size, ws_size); grid = -1; return; }
        int dev = 0, cus = 0, per_cu = 0;
        hipGetDevice(&dev); hipDeviceGetAttribute(&cus, hipDeviceAttributeMultiprocessorCount, dev);
        if (hipFuncSetAttribute((const void*)mk_fwd, hipFuncAttributeMaxDynamicSharedMemorySize, LDS_BYTES) != hipSuccess) { fprintf(stderr, "kernel_launch: hipFuncSetAttribute failed\n"); grid = -1; return; }
        if (hipOccupancyMaxActiveBlocksPerMultiprocessor(&per_cu, (const void*)mk_fwd, 512, LDS_BYTES) != hipSuccess || per_cu < 1) { fprintf(stderr, "kernel_launch: occupancy query says %d\n", per_cu); per_cu = 1; }
        (void)hipGetLastError();
        grid = cus;
    }
    if (grid < 0) return;
    hipMemsetAsync((char*)d_ws + WS_CTL, 0, CTL_BYTES, stream);
    Args a{};
    a.x = (const float*)d_in[0]; a.c = (const float*)d_in[1]; a.pos = (const int*)d_in[2]; a.w_ada = (const float*)d_in[3]; a.b_ada = (const float*)d_in[4];
    a.g_pre_mix = (const float*)d_in[5]; a.g_post_mix = (const float*)d_in[6]; a.g_pre_ffn = (const float*)d_in[7]; a.g_post_ffn = (const float*)d_in[8];
    a.w_in = (const float*)d_in[9]; a.g_q_a = (const float*)d_in[10]; a.g_kv_a = (const float*)d_in[11]; a.w_q_b = (const float*)d_in[12]; a.w_kv_b = (const float*)d_in[13]; a.w_o = (const float*)d_in[14];
    a.w_router = (const float*)d_in[15]; a.b_router = (const float*)d_in[16]; a.w_mlp1 = (const float*)d_in[17]; a.b_mlp1 = (const float*)d_in[18]; a.w_mlp2 = (const float*)d_in[19]; a.b_mlp2 = (const float*)d_in[20];
    a.out = (float*)d_out; a.ws = (unsigned char*)d_ws;
#if MK_N_LAUNCHES == 1
    a.ph_lo = 0; a.ph_hi = N_PHASES;
    hipLaunchKernelGGL(mk_fwd, dim3(grid), dim3(512), LDS_BYTES, stream, a);
#else
    for (int p = 0; p < N_PHASES; ++p) { a.ph_lo = p; a.ph_hi = p + 1; hipLaunchKernelGGL(mk_fwd, dim3(grid), dim3(512), LDS_BYTES, stream, a); }
#endif
}
```

```cpp
#include <hip/hip_runtime.h>
#include <cstdio>
#include <cstdint>

#ifndef MK_N_LAUNCHES
#define MK_N_LAUNCHES 1
#endif

#define LAS __attribute__((address_space(3)))
typedef unsigned short bf16_t;
typedef short bf16x8 __attribute__((ext_vector_type(8)));
typedef float f32x4 __attribute__((ext_vector_type(4)));
typedef float f32x16 __attribute__((ext_vector_type(16)));
typedef unsigned u32x4 __attribute__((ext_vector_type(4)));
typedef unsigned u32x2 __attribute__((ext_vector_type(2)));
typedef int i32x4 __attribute__((ext_vector_type(4)));
typedef int i32x8 __attribute__((ext_vector_type(8)));

constexpr int NB = 8, SEQ = 2048, DM = 1024, MT = NB * SEQ;
constexpr int NE = 32, FE = 1024;
constexpr int NPROJ = 1536;
constexpr int PC_CQ = 0, PC_CKV = 256, PC_KROPE = 384, PC_KIDX = 416, PC_WIDX = 448, PC_QD = 512, PC_KD = 1024, PC_VD = 1152, PC_QIDX = 1280;
constexpr float EPS = 1e-6f;
constexpr float LOG2E = 1.4426950408889634f;
constexpr int MAXTILES = 288;
constexpr int NSLOT = MAXTILES * 256;

constexpr size_t MiB = 1u << 20;
constexpr size_t WS_CTL = 0, CTL_BYTES = 64 * 1024;
constexpr size_t WS_MODP = 1 * MiB;
constexpr size_t WS_MODS = 2 * MiB + 512 * 1024;
constexpr size_t WS_ROPE = 3 * MiB;
constexpr size_t WS_SSQ = 5 * MiB;
constexpr size_t WS_ROUTE = 6 * MiB;
constexpr size_t WS_LIST = 7 * MiB;
constexpr size_t WS_WIN = 9 * MiB;
constexpr size_t WS_WQB = 12 * MiB;
constexpr size_t WS_WKVB = 13 * MiB;
constexpr size_t WS_WO = 14 * MiB;
constexpr size_t WS_BITMAP = 16 * MiB;
constexpr size_t WS_VTM = 20 * MiB;
constexpr size_t WS_VTD = 36 * MiB;
constexpr size_t WS_HB = 40 * MiB;
constexpr size_t WS_PROJ = 72 * MiB;
constexpr size_t WS_QM = 120 * MiB;
constexpr size_t WS_KM = 144 * MiB;
constexpr size_t WS_Y = 168 * MiB;
constexpr size_t WS_MIX = 200 * MiB;
constexpr size_t WS_W1T = 232 * MiB;
constexpr size_t WS_W2T = 360 * MiB;
constexpr size_t WS_ACT = 424 * MiB;
constexpr size_t WS_YB = 568 * MiB;
constexpr size_t WS_END = 712 * MiB;
constexpr int CW_CNT = 64, CNT_STRIDE = 64;
constexpr int CW_ATTQ = 4096;
constexpr int CW_BAR = 8192;

constexpr int LDS_BYTES = 163840;
constexpr int MOE_RL_OFF = 131072, MOE_RL_UNITS = 30;
constexpr int LDS_CTRL = 163328;

__device__ __forceinline__ unsigned f2bf(float f) { unsigned u = __builtin_bit_cast(unsigned, f); return (u + 0x7fffu + ((u >> 16) & 1u)) >> 16; }
__device__ __forceinline__ unsigned pk2(float lo, float hi) { return f2bf(lo) | (f2bf(hi) << 16); }
__device__ __forceinline__ float bflo(unsigned u) { return __builtin_bit_cast(float, u << 16); }
__device__ __forceinline__ float bfhi(unsigned u) { return __builtin_bit_cast(float, u & 0xffff0000u); }
template <int CTRL> __device__ __forceinline__ float dppf(float v) { return __builtin_bit_cast(float, __builtin_amdgcn_update_dpp(0, __builtin_bit_cast(int, v), CTRL, 0xf, 0xf, true)); }
template <int CTRL> __device__ __forceinline__ unsigned dppu(unsigned v) { return (unsigned)__builtin_amdgcn_update_dpp(0, (int)v, CTRL, 0xf, 0xf, true); }
#define SWAP32(a, b) asm volatile("s_nop 1\n\tv_permlane32_swap_b32 %0, %1\n\ts_nop 1" : "+v"(a), "+v"(b))
#define SWAP16(a, b) asm volatile("s_nop 1\n\tv_permlane16_swap_b32 %0, %1\n\ts_nop 1" : "+v"(a), "+v"(b))
template <int M> __device__ __forceinline__ float xshfl(float v, int lane) {
    if constexpr (M == 1) return dppf<0xB1>(v);
    else if constexpr (M == 2) return dppf<0x4E>(v);
    else if constexpr (M == 4) return dppf<0x141>(dppf<0x1B>(v));
    else if constexpr (M == 8) return dppf<0x128>(v);
    else if constexpr (M == 16) { float a = v, b = v; SWAP16(a, b); return (lane & 16) ? a : b; }
    else { float a = v, b = v; SWAP32(a, b); return (lane & 32) ? a : b; }
}
__device__ __forceinline__ float fold16(float v) { float a = v, b = v; SWAP16(a, b); return a + b; }
__device__ __forceinline__ float fold32(float v) { float a = v, b = v; SWAP32(a, b); return a + b; }
__device__ __forceinline__ float wave_sum(float v) {
    v += dppf<0xB1>(v); v += dppf<0x4E>(v); v += dppf<0x124>(v); v += dppf<0x128>(v);
    return fold32(fold16(v));
}
#define LDS_WAIT() asm volatile("s_waitcnt lgkmcnt(0)" ::: "memory")
__device__ __forceinline__ int fresh_lane() { int l = __builtin_amdgcn_mbcnt_hi(~0u, __builtin_amdgcn_mbcnt_lo(~0u, 0u)); asm volatile("" : "+v"(l)); return l; }

namespace pg8 {
constexpr int BM = 256, BK = 64, HALF = 128, HTB = HALF * BK * 2, STAGE_BYTES = 8 * HTB, NXCD = 8, WGM = 8;
__host__ __device__ __forceinline__ int lds_byte(int r, int c) { const int st = (r >> 4) * 2 + (c >> 5), rr = r & 15, cc = c & 31, ob = rr * 64 + cc * 2; return st * 1024 + (ob ^ (((ob >> 9) & 1) << 5)); }
__host__ __device__ __forceinline__ void stage_rc(int b, int& R, int& C) { const int st = b / 1024, sb = b % 1024, swz = sb ^ (((sb >> 9) & 1) << 5); R = (st >> 1) * 16 + swz / 64; C = (st & 1) * 32 + (swz % 64) / 2; }
__host__ __device__ __forceinline__ int perm32(int rho) { const int n = rho >> 4, i = rho & 15; return 8 * (i >> 2) + 4 * n + (i & 3); }

struct Unit { int pm, pn, e, mt; };

struct StaticOrder {
    static constexpr bool GATHER = false;
    int nM, nN, nwg, G, c; const char* Bt; int ldb;
    __device__ void init(int M, int N, int G_, int c_, const void* Bt_, int ldb_bytes) { nM = M / BM; nN = N / BM; nwg = nM * nN; G = G_; c = c_; Bt = (const char*)Bt_; ldb = ldb_bytes; }
    __device__ __forceinline__ bool next(int i, Unit& u, int ehint = 0) const {
        const long L = (long)i * G + c; if (L >= nwg) return false;
        int wgid = (int)L; { const int q = nwg / NXCD, r = nwg % NXCD, xcd = wgid % NXCD, off = wgid / NXCD; wgid = (xcd < r ? xcd * (q + 1) : r * (q + 1) + (xcd - r) * q) + off; }
        const int nig = WGM * nN, gid = wgid / nig, fm = gid * WGM, gsz = (nM - fm) < WGM ? (nM - fm) : WGM;
        u.pm = fm + ((wgid % nig) % gsz); u.pn = (wgid % nig) / gsz; u.e = 0; u.mt = 0; return true;
    }
    __device__ __forceinline__ const char* bptr(const Unit& u) const { return Bt + (size_t)u.pn * BM * ldb; }
    __device__ __forceinline__ int arow(const Unit& u, int r, int ord) const { return u.pm * BM + r; }
    __device__ __forceinline__ int acol(const Unit& u) const { return 0; }
};

struct QbKvbOrder {
    static constexpr bool GATHER = false;
    int G, c; const char* Bq; const char* Bkv; int ldb, acq, ackv;
    __device__ void init(int G_, int c_, const void* Bq_, const void* Bkv_, int ldb_bytes, int acq_bytes, int ackv_bytes) { G = G_; c = c_; Bq = (const char*)Bq_; Bkv = (const char*)Bkv_; ldb = ldb_bytes; acq = acq_bytes; ackv = ackv_bytes; }
    __device__ __forceinline__ bool next(int i, Unit& u, int ehint = 0) const {
        const long L = (long)i * G + c; if (L >= 192 + 256) return false;
        const int l = (int)L; const int t = l < 192 ? 0 : 1, ll = l - 192 * t;
        u.e = t; u.pn = ll >> 6; u.pm = ll & 63; u.mt = 0; return true;
    }
    __device__ __forceinline__ const char* bptr(const Unit& u) const { return (u.e == 0 ? Bq : Bkv) + (size_t)u.pn * BM * ldb; }
    __device__ __forceinline__ int arow(const Unit& u, int r, int ord) const { return u.pm * BM + r; }
    __device__ __forceinline__ int acol(const Unit& u) const { return u.e == 0 ? acq : ackv; }
};

template <bool GATHER_> struct MoeOrder {
    static constexpr bool GATHER = GATHER_;
    const LAS int* ts;
    const LAS int* cnts;
    const int* list;
    const LAS int* rl;
    const char* Bt; int nrows_b  , ldb  , nN, G, c, nwg;
    __device__ void init(const LAS int* ts_, const LAS int* cnts_, const int* list_, const void* Bt_, int nrows_b_, int ldb_, int nN_, int G_, int c_) {
        ts = ts_; cnts = cnts_; list = list_; Bt = (const char*)Bt_; nrows_b = nrows_b_; ldb = ldb_; nN = nN_; G = G_; c = c_; nwg = __builtin_amdgcn_readfirstlane(ts_[32]) * nN_; }
    __device__ __forceinline__ bool next(int i, Unit& u, int ehint = 0) const {
        const long L = (long)i * G + c; if (L >= nwg) return false;
        int wgid = (int)L; { const int q = nwg / NXCD, r = nwg % NXCD, xcd = wgid % NXCD, off = wgid / NXCD; wgid = (xcd < r ? xcd * (q + 1) : r * (q + 1) + (xcd - r) * q) + off; }
        int e = ehint;
        while (e < 31 && __builtin_amdgcn_readfirstlane(ts[e + 1]) * nN <= wgid) ++e;
        const int t0 = __builtin_amdgcn_readfirstlane(ts[e]), T = __builtin_amdgcn_readfirstlane(ts[e + 1]) - t0, local = wgid - t0 * nN;
        u.e = e; u.pn = local / T; u.mt = local % T; u.pm = t0 + u.mt; return true;
    }
    __device__ __forceinline__ const char* bptr(const Unit& u) const { return Bt + ((size_t)u.e * nrows_b + (size_t)u.pn * BM) * ldb; }
    __device__ __forceinline__ int arow(const Unit& u, int r, int ord) const {
        if (!GATHER) return u.pm * BM + r;
        return rl[ord * BM + r];
    }
    __device__ __forceinline__ int acol(const Unit& u) const { return 0; }
};

__device__ __forceinline__ unsigned cvt_pk_bf16(float lo, float hi) { unsigned r; asm volatile("v_cvt_pk_bf16_f32 %0, %1, %2" : "=v"(r) : "v"(lo), "v"(hi)); return r; }
__device__ __forceinline__ u32x4 pack8(const f32x4& a, const f32x4& b) { u32x4 w; w.x = cvt_pk_bf16(a[0], a[1]); w.y = cvt_pk_bf16(a[2], a[3]); w.z = cvt_pk_bf16(b[0], b[1]); w.w = cvt_pk_bf16(b[2], b[3]); return w; }

template <class Epi, class Sched, bool ALIGN_EPI, bool FP8 = false>
__device__ __forceinline__ void gemm_phase(LAS unsigned char* lds, const void* A, int lda, int kbytes, const Sched& S, const Epi& E, int wid) {
    const int lane = fresh_lane(), tid = wid * 64 + lane, wr = wid >> 2, wc = wid & 3, fr = lane & 15, fq = lane >> 4;
    const int nt = kbytes / 128; const int ldb = S.ldb;
    constexpr bool GA = Sched::GATHER;
    unsigned voffB[2], voffA[2]; int RA[2]; unsigned CA[2];
#pragma unroll
    for (int i = 0; i < 2; ++i) { int R, C; stage_rc(tid * 16 + i * 8192, R, C); const int Rb = (R & ~31) + perm32(R & 31);
        RA[i] = R; CA[i] = (unsigned)C * 2u; voffA[i] = (unsigned)(R * lda) + (unsigned)C * 2u; voffB[i] = (unsigned)(Rb * ldb) + (unsigned)C * 2u; }
    const size_t hstepA = (size_t)HALF * lda;
    const size_t kstep = (size_t)(BK * 2);
    const size_t hstepB = (size_t)HALF * ldb;
    const unsigned ldsw = (unsigned)wid * 1024u;
    const int aoff = lds_byte(wr * 64 + fr, fq * 8), boff = lds_byte(wc * 32 + fr, fq * 8);
#define PG8_SA(b, h) (((b) * 2 + (h)) * HTB)
#define PG8_SB(b, h) ((4 + (b) * 2 + (h)) * HTB)
#define PG8_STAGE(bufoff, gbase, voff) do { _Pragma("unroll") for (int _i = 0; _i < 2; ++_i) \
        __builtin_amdgcn_global_load_lds((const unsigned*)((const char*)(gbase) + (voff)[_i]), (LAS unsigned*)(lds + (bufoff) + ldsw + _i * 8192), 16, 0, 0); } while (0)
#define PG8_LDA(dst, b, h) do { _Pragma("unroll") for (int m = 0; m < 4; ++m) _Pragma("unroll") for (int k = 0; k < 2; ++k) dst[m][k] = *(const LAS bf16x8*)(lds + PG8_SA(b, h) + aoff + m * 2048 + k * 1024); } while (0)
#define PG8_LDB(dst, b, h) do { _Pragma("unroll") for (int n = 0; n < 2; ++n) _Pragma("unroll") for (int k = 0; k < 2; ++k) dst[n][k] = *(const LAS bf16x8*)(lds + PG8_SB(b, h) + boff + n * 2048 + k * 1024); } while (0)
#define PG8_MMA(ai, bj, At, Bt) do { __builtin_amdgcn_s_setprio(1); \
        if constexpr (FP8) { _Pragma("unroll") for (int m = 0; m < 4; ++m) _Pragma("unroll") for (int n = 0; n < 2; ++n) { \
            const i32x8 bb_ = __builtin_shufflevector(__builtin_bit_cast(i32x4, Bt[n][0]), __builtin_bit_cast(i32x4, Bt[n][1]), 0, 1, 2, 3, 4, 5, 6, 7); \
            const i32x8 aa_ = __builtin_shufflevector(__builtin_bit_cast(i32x4, At[m][0]), __builtin_bit_cast(i32x4, At[m][1]), 0, 1, 2, 3, 4, 5, 6, 7); \
            asm volatile("v_mfma_scale_f32_16x16x128_f8f6f4 %0, %1, %2, %0, %3, %3 op_sel_hi:[0,0,0]" : "+v"(acc[ai][bj][m][n]) : "v"(bb_), "v"(aa_), "v"(sc1_)); } } \
        else { _Pragma("unroll") for (int m = 0; m < 4; ++m) _Pragma("unroll") for (int n = 0; n < 2; ++n) _Pragma("unroll") for (int k = 0; k < 2; ++k) \
            acc[ai][bj][m][n] = __builtin_amdgcn_mfma_f32_16x16x32_bf16(Bt[n][k], At[m][k], acc[ai][bj][m][n], 0, 0, 0); } \
        __builtin_amdgcn_s_setprio(0); } while (0)
#define PG8_WAIT_V(n) asm volatile("s_waitcnt vmcnt(" #n ")" ::: "memory")
#define PG8_WAIT_L(n) asm volatile("s_waitcnt lgkmcnt(" #n ")" ::: "memory")
#define PG8_BAR __builtin_amdgcn_s_barrier()
#define PG8_SCHED __builtin_amdgcn_sched_barrier(0)
#define PG8_STA(bufoff, nx, h, kb) do { if constexpr (GA) { unsigned _w[2]; _Pragma("unroll") for (int _i = 0; _i < 2; ++_i) _w[_i] = (nx) ? vN[h][_i] : vA[h][_i]; PG8_STAGE(bufoff, Ab + (kb), _w); } \
        else { PG8_STAGE(bufoff, ((nx) ? nA : cA) + (h) * hstepA + (kb), voffA); } } while (0)
#define PG8_AOFF(dst, u, ord) do { _Pragma("unroll") for (int _h = 0; _h < 2; ++_h) _Pragma("unroll") for (int _i = 0; _i < 2; ++_i) \
        dst[_h][_i] = (unsigned)S.arow(u, _h * HALF + RA[_i], ord) * (unsigned)lda + CA[_i]; } while (0)
#define PG8_AROW(dst, u, ord) do { _Pragma("unroll") for (int _h = 0; _h < 2; ++_h) _Pragma("unroll") for (int _i = 0; _i < 2; ++_i) \
        dst[_h][_i] = (unsigned)S.arow(u, _h * HALF + RA[_i], ord); } while (0)
    Unit cur, nxt; int ui = 0;
    if (!S.next(0, cur)) return;
    f32x4 acc[2][2][4][2];
#pragma unroll
    for (int a = 0; a < 2; ++a)
#pragma unroll
        for (int b = 0; b < 2; ++b)
#pragma unroll
            for (int m = 0; m < 4; ++m)
#pragma unroll
                for (int n = 0; n < 2; ++n) acc[a][b][m][n] = (f32x4){0.f, 0.f, 0.f, 0.f};
    bf16x8 At[4][2], B0[2][2], B1[2][2];
    int sc1_ = 0x7f7f7f7f; asm volatile("" : "+v"(sc1_));
    unsigned vA[2][2], vN[2][2];
    if constexpr (GA) { PG8_AOFF(vA, cur, 0); }
    const char* Ab = (const char*)A;
    const char* cA = Ab; if constexpr (!GA) cA = Ab + (size_t)S.arow(cur, 0, 0) * lda + S.acol(cur);
    const char* nA = cA;
    const char* cB = S.bptr(cur);
    PG8_STAGE(PG8_SB(0, 0), cB, voffB); PG8_STAGE(PG8_SB(0, 1), cB + hstepB, voffB); PG8_STA(PG8_SA(0, 0), false, 0, 0); PG8_STA(PG8_SA(0, 1), false, 1, 0);
    if (wr == 1) PG8_BAR;
    PG8_WAIT_V(2); PG8_BAR;
    PG8_STAGE(PG8_SB(1, 0), cB + kstep, voffB); PG8_STA(PG8_SA(1, 0), false, 0, kstep); PG8_STAGE(PG8_SB(1, 1), cB + hstepB + kstep, voffB);
    PG8_WAIT_V(6); PG8_BAR;
    for (;;) {
        const bool has_next = S.next(ui + 1, nxt, cur.e);
        if constexpr (GA) { if (has_next) { PG8_AROW(vN, nxt, ui + 1); } else {
#pragma unroll
            for (int _h = 0; _h < 2; ++_h)
#pragma unroll
                for (int _i = 0; _i < 2; ++_i) vN[_h][_i] = vA[_h][_i]; } }
        else { nA = has_next ? Ab + (size_t)S.arow(nxt, 0, 0) * lda + S.acol(nxt) : cA; }
        const char* nB = has_next ? S.bptr(nxt) : cB;
        f32x4 bq4[4];
        if constexpr (Epi::PREBIAS) { int l_ = fresh_lane(); const float* bp_ = E.bias_ptr(cur, wc, l_ >> 4);
            asm volatile("global_load_dwordx4 %0, %4, off\n\tglobal_load_dwordx4 %1, %4, off offset:16\n\tglobal_load_dwordx4 %2, %4, off offset:32\n\tglobal_load_dwordx4 %3, %4, off offset:48"
                         : "=&v"(bq4[0]), "=&v"(bq4[1]), "=&v"(bq4[2]), "=&v"(bq4[3]) : "v"(bp_) : "memory"); }
#pragma unroll 1
        for (int t = 0; t < nt; t += 2) {
            const bool last = (t == nt - 2);
            if constexpr (GA) { if (last && has_next) {
#pragma unroll
                for (int _h = 0; _h < 2; ++_h)
#pragma unroll
                    for (int _i = 0; _i < 2; ++_i) vN[_h][_i] = vN[_h][_i] * (unsigned)lda + CA[_i]; } }
            const size_t k1 = (size_t)(t + 1) * kstep, k2 = last ? 0 : (size_t)(t + 2) * kstep, k3 = k2 + kstep;
            const char* b2 = last ? nB : cB + (size_t)(t + 2) * kstep; const char* b3 = b2 + kstep;
            PG8_LDB(B0, 0, 0); PG8_LDB(B1, 0, 1); PG8_SCHED; PG8_LDA(At, 0, 0); PG8_STA(PG8_SA(1, 1), false, 1, k1);
            PG8_WAIT_V(8); PG8_WAIT_L(0); PG8_BAR; PG8_MMA(0, 0, At, B0); PG8_MMA(0, 1, At, B1); PG8_BAR; PG8_SCHED;
            PG8_LDA(At, 0, 1); PG8_STAGE(PG8_SB(0, 0), b2, voffB); PG8_STAGE(PG8_SB(0, 1), b2 + hstepB, voffB); PG8_STA(PG8_SA(0, 0), last, 0, k2);
            PG8_WAIT_V(8); PG8_WAIT_L(0); PG8_BAR; PG8_MMA(1, 0, At, B0); PG8_MMA(1, 1, At, B1); PG8_BAR; PG8_SCHED;
            PG8_LDB(B0, 1, 0); PG8_LDB(B1, 1, 1); PG8_SCHED; PG8_LDA(At, 1, 0); PG8_STA(PG8_SA(0, 1), last, 1, k2);
            PG8_WAIT_V(8); PG8_WAIT_L(0); PG8_BAR; PG8_MMA(0, 0, At, B0); PG8_MMA(0, 1, At, B1); PG8_BAR; PG8_SCHED;
            PG8_LDA(At, 1, 1); PG8_STAGE(PG8_SB(1, 0), b3, voffB); PG8_STAGE(PG8_SB(1, 1), b3 + hstepB, voffB); PG8_STA(PG8_SA(1, 0), last, 0, k3);
            PG8_WAIT_V(8); PG8_WAIT_L(0); PG8_BAR; PG8_MMA(1, 0, At, B0); PG8_MMA(1, 1, At, B1); PG8_BAR; PG8_SCHED;
        }
        if constexpr (ALIGN_EPI) { if (wr == 0) PG8_BAR; }
        if constexpr (FP8) asm volatile("s_nop 15\n\ts_nop 7" ::: "memory");
        if constexpr (Epi::PREBIAS) E(acc, cur, wr, wc, fr, fq, bq4); else E(acc, cur, wr, wc, fr, fq);
        if (!has_next) break;
#pragma unroll
        for (int a = 0; a < 2; ++a)
#pragma unroll
            for (int b = 0; b < 2; ++b)
#pragma unroll
                for (int m = 0; m < 4; ++m)
#pragma unroll
                    for (int n = 0; n < 2; ++n) acc[a][b][m][n] = (f32x4){0.f, 0.f, 0.f, 0.f};
        cur = nxt; cB = nB; cA = nA; ++ui;
        if constexpr (GA) {
#pragma unroll
        for (int _h = 0; _h < 2; ++_h)
#pragma unroll
            for (int _i = 0; _i < 2; ++_i) vA[_h][_i] = vN[_h][_i]; }
        if constexpr (ALIGN_EPI) { if (wr == 1) PG8_BAR; }
    }
    PG8_WAIT_V(0);
    if constexpr (!ALIGN_EPI) { if (wr == 0) PG8_BAR; }
    PG8_BAR;
#undef PG8_SA
#undef PG8_SB
#undef PG8_STAGE
#undef PG8_LDA
#undef PG8_LDB
#undef PG8_MMA
#undef PG8_WAIT_V
#undef PG8_WAIT_L
#undef PG8_BAR
#undef PG8_SCHED
#undef PG8_AOFF
#undef PG8_AROW
#undef PG8_STA
}

struct EpiPlain {
    static constexpr bool PREBIAS = false;
    bf16_t* O; int ldc; float scale;
    __device__ __forceinline__ void operator()(const f32x4 (&acc)[2][2][4][2], const Unit& u, int wr, int wc, int fr_, int fq_) const {
        int ln_ = __builtin_amdgcn_mbcnt_hi(~0u, __builtin_amdgcn_mbcnt_lo(~0u, 0u)); asm volatile("" : "+v"(ln_)); const int fr = ln_ & 15, fq = ln_ >> 4;
        const int row0 = u.pm * BM + wr * 64 + fr, col0 = u.pn * BM + wc * 32 + 8 * fq;
#pragma unroll
        for (int ai = 0; ai < 2; ++ai)
#pragma unroll
            for (int m = 0; m < 4; ++m) { bf16_t* rowp = O + (size_t)(row0 + ai * HALF + m * 16) * ldc + col0;
#pragma unroll
                for (int bj = 0; bj < 2; ++bj) *(u32x4*)(rowp + bj * HALF) = pack8(acc[ai][bj][m][0] * scale, acc[ai][bj][m][1] * scale); }
    }
};

struct EpiInProj {
    static constexpr bool PREBIAS = false;
    bf16_t* proj; float* ssq_q; float* ssq_kv; bf16_t* Km; bf16_t* Vtd; const float* rcos; const float* rsin;
    __device__ __forceinline__ void operator()(const f32x4 (&acc)[2][2][4][2], const Unit& u, int wr, int wc, int fr_, int fq_) const {
        int ln_ = __builtin_amdgcn_mbcnt_hi(~0u, __builtin_amdgcn_mbcnt_lo(~0u, 0u)); asm volatile("" : "+v"(ln_)); const int fr = ln_ & 15, fq = ln_ >> 4;
        const int row0 = u.pm * BM + wr * 64 + fr, col0 = u.pn * BM + wc * 32 + 8 * fq;
        const int pn = u.pn;
        const bool krope = (pn == 1 && wc == 0);
        const int i0 = 8 * (fq & 1); const float sg = (fq < 2) ? -1.f : 1.f;
#pragma unroll
        for (int ai = 0; ai < 2; ++ai)
#pragma unroll
          for (int mh = 0; mh < 4; mh += 2) {
            f32x4 cr[2][4];
            if (krope) {
#pragma unroll
                for (int m2 = 0; m2 < 2; ++m2) { const size_t ro = (size_t)(row0 + ai * HALF + (mh + m2) * 16) * 16 + i0;
                    cr[m2][0] = *(const f32x4*)(rcos + ro); cr[m2][1] = *(const f32x4*)(rcos + ro + 4); cr[m2][2] = *(const f32x4*)(rsin + ro); cr[m2][3] = *(const f32x4*)(rsin + ro + 4); }
                asm volatile("" ::: "memory");
            }
#pragma unroll
            for (int m = mh; m < mh + 2; ++m) {
                const int row = row0 + ai * HALF + m * 16;
                bf16_t* rowp = proj + (size_t)row * NPROJ + col0;
                float sq = 0.f;
#pragma unroll
                for (int bj = 0; bj < 2; ++bj) {
                    const f32x4 v0 = acc[ai][bj][m][0], v1 = acc[ai][bj][m][1];
                    *(u32x4*)(rowp + bj * HALF) = pack8(v0, v1);
                    if (pn == 0 || (pn == 1 && bj == 0)) sq += (v0[0] * v0[0] + v0[1] * v0[1]) + (v0[2] * v0[2] + v0[3] * v0[3]) + (v1[0] * v1[0] + v1[1] * v1[1]) + (v1[2] * v1[2] + v1[3] * v1[3]);
                    if (krope && bj == 1) {
                        const f32x4 c0 = cr[m - mh][0], c1 = cr[m - mh][1], s0 = cr[m - mh][2], s1 = cr[m - mh][3];
                        f32x4 o0, o1;
#pragma unroll
                        for (int j = 0; j < 4; ++j) { const float p0 = xshfl<32>(v0[j], fq << 4), p1 = xshfl<32>(v1[j], fq << 4);
                            o0[j] = v0[j] * c0[j] + sg * p0 * s0[j]; o1[j] = v1[j] * c1[j] + sg * p1 * s1[j]; }
                        const u32x4 w = pack8(o0, o1);
#pragma unroll
                        for (int h = 0; h < 8; ++h) *(u32x4*)(Km + (size_t)row * 768 + h * 96 + 64 + 8 * fq) = w;
                    }
                    if (pn == 4 && bj == 1) {
                        const int b = row >> 11, s = row & 2047, cv0 = wc * 32 + 8 * fq;
#pragma unroll
                        for (int jj = 0; jj < 4; ++jj) {
                            const float va = (jj < 2) ? v0[2 * jj] : v1[2 * jj - 4], vc = (jj < 2) ? v0[2 * jj + 1] : v1[2 * jj - 3];
                            const bool odd = (fr & 1) != 0; const float recv = dppf<0xB1>(odd ? va : vc), keepv = odd ? vc : va;
                            const int cv = cv0 + 2 * jj + (odd ? 1 : 0);
                            *(unsigned*)(Vtd + ((size_t)(b * 2 + (cv >> 6)) * 64 + (cv & 63)) * SEQ + (s - (odd ? 1 : 0))) = pk2(odd ? recv : keepv, odd ? keepv : recv); }
                    }
                }
                if (pn <= 1) { sq = fold32(fold16(sq)); if (fq == 0) (pn == 0 ? ssq_q : ssq_kv)[(size_t)row * 4 + wc] = sq; }
            }
          }
    }
};

struct EpiQb {
    static constexpr bool PREBIAS = false;
    bf16_t* Qm; const float* ssq_q; const float* rcos; const float* rsin; float c2;
    template <int RBJ>
    __device__ __forceinline__ void rows(const f32x4 (&acc)[2][2][4][2], int row0, int col0, int fq) const {
        float rstd8[8];
        { f32x4 rs8[8];
#pragma unroll
          for (int i = 0; i < 8; ++i) rs8[i] = *(const f32x4*)(ssq_q + (size_t)(row0 + (i >> 2) * HALF + (i & 3) * 16) * 4);
#pragma unroll
          for (int i = 0; i < 8; ++i) rstd8[i] = rsqrtf(((rs8[i][0] + rs8[i][1]) + (rs8[i][2] + rs8[i][3])) * (1.f / 256.f) + EPS) * c2;
          asm volatile("" : "+v"(rstd8[0]), "+v"(rstd8[1]), "+v"(rstd8[2]), "+v"(rstd8[3]), "+v"(rstd8[4]), "+v"(rstd8[5]), "+v"(rstd8[6]), "+v"(rstd8[7])); }
        const int i0 = 8 * (fq & 1); const float sg = (fq < 2) ? -1.f : 1.f;
#pragma unroll
        for (int ai = 0; ai < 2; ++ai)
#pragma unroll
          for (int mh = 0; mh < 4; mh += 2) {
            f32x4 cr[4][4];
            if (RBJ >= 0) {
#pragma unroll
                for (int m = mh; m < mh + 2; ++m) { const size_t ro = (size_t)(row0 + ai * HALF + m * 16) * 16 + i0;
                    cr[m][0] = *(const f32x4*)(rcos + ro); cr[m][1] = *(const f32x4*)(rcos + ro + 4); cr[m][2] = *(const f32x4*)(rsin + ro); cr[m][3] = *(const f32x4*)(rsin + ro + 4); }
                asm volatile("" ::: "memory");
            }
#pragma unroll
            for (int m = mh; m < mh + 2; ++m) {
                const int row = row0 + ai * HALF + m * 16;
                const float rstd = rstd8[ai * 4 + m];
#pragma unroll
                for (int bj = 0; bj < 2; ++bj) {
                    f32x4 v0 = acc[ai][bj][m][0] * rstd, v1 = acc[ai][bj][m][1] * rstd;
                    if (bj == RBJ) {
                        f32x4 o0, o1;
#pragma unroll
                        for (int j = 0; j < 4; ++j) { const float p0 = xshfl<32>(v0[j], fq << 4), p1 = xshfl<32>(v1[j], fq << 4);
                            o0[j] = v0[j] * cr[m][0][j] + sg * p0 * cr[m][2][j]; o1[j] = v1[j] * cr[m][1][j] + sg * p1 * cr[m][3][j]; }
                        v0 = o0; v1 = o1;
                    }
                    *(u32x4*)(Qm + (size_t)row * 768 + col0 + bj * HALF) = pack8(v0, v1);
                }
            }
        }
    }
    __device__ __forceinline__ void operator()(const f32x4 (&acc)[2][2][4][2], const Unit& u, int wr, int wc, int fr_, int fq_) const {
        int ln_ = __builtin_amdgcn_mbcnt_hi(~0u, __builtin_amdgcn_mbcnt_lo(~0u, 0u)); asm volatile("" : "+v"(ln_)); const int fr = ln_ & 15, fq = ln_ >> 4;
        const int row0 = u.pm * BM + wr * 64 + fr, col0 = u.pn * BM + wc * 32 + 8 * fq;
        const int g0 = (8 * u.pn + wc) % 3;
        (void)g0; rows<-1>(acc, row0, col0, fq);
    }
};

struct EpiKvb {
    static constexpr bool PREBIAS = false;
    bf16_t* Km; bf16_t* Vtm; const float* ssq_kv;
    __device__ __forceinline__ void operator()(const f32x4 (&acc)[2][2][4][2], const Unit& u, int wr, int wc, int fr_, int fq_) const {
        int ln_ = __builtin_amdgcn_mbcnt_hi(~0u, __builtin_amdgcn_mbcnt_lo(~0u, 0u)); asm volatile("" : "+v"(ln_)); const int fr = ln_ & 15, fq = ln_ >> 4;
        const int row0 = u.pm * BM + wr * 64 + fr, col0 = u.pn * BM + wc * 32 + 8 * fq;
        f32x4 rs8[8];
#pragma unroll
        for (int i = 0; i < 8; ++i) rs8[i] = *(const f32x4*)(ssq_kv + (size_t)(row0 + (i >> 2) * HALF + (i & 3) * 16) * 4);
#pragma unroll
        for (int ai = 0; ai < 2; ++ai)
#pragma unroll
            for (int m = 0; m < 4; ++m) {
                const int row = row0 + ai * HALF + m * 16;
                const f32x4 rs = rs8[ai * 4 + m];
                const float rstd = rsqrtf(((rs[0] + rs[1]) + (rs[2] + rs[3])) * (1.f / 128.f) + EPS);
#pragma unroll
                for (int bj = 0; bj < 2; ++bj) {
                    const f32x4 v0 = acc[ai][bj][m][0] * rstd, v1 = acc[ai][bj][m][1] * rstd;
                    const int col = col0 + bj * HALF;
                    if (u.pn < 2) { const int h = col >> 6, d = col & 63; *(u32x4*)(Km + (size_t)row * 768 + h * 96 + d) = pack8(v0, v1); }
                    else { const int cv = col - 512, h = cv >> 6, d0 = cv & 63, b = row >> 11, s = row & 2047;
#pragma unroll
                        for (int jj = 0; jj < 4; ++jj) {
                            const float va = (jj < 2) ? v0[2 * jj] : v1[2 * jj - 4], vc = (jj < 2) ? v0[2 * jj + 1] : v1[2 * jj - 3];
                            const bool odd = (fr & 1) != 0; const float recv = dppf<0xB1>(odd ? va : vc), keepv = odd ? vc : va;
                            *(unsigned*)(Vtm + ((size_t)(b * 8 + h) * 64 + d0 + 2 * jj + (odd ? 1 : 0)) * SEQ + (s - (odd ? 1 : 0))) = pk2(odd ? recv : keepv, odd ? keepv : recv); } }
                }
            }
    }
};

struct EpiQbKvb {
    static constexpr bool PREBIAS = false;
    EpiQb q; EpiKvb k;
    __device__ __forceinline__ void operator()(const f32x4 (&acc)[2][2][4][2], const Unit& u, int wr, int wc, int fr_, int fq_) const { if (u.e == 0) q(acc, u, wr, wc, fr_, fq_); else k(acc, u, wr, wc, fr_, fq_); }
};

constexpr float W8_SCALE = 64.f, W8_INV = 1.f / 64.f;
struct EpiMoe1 {
    static constexpr bool PREBIAS = true;
    unsigned char* act; const float* b1;
    __device__ __forceinline__ const float* bias_ptr(const Unit& u, int wc, int fq) const { return b1 + (size_t)u.e * 2048 + u.pn * BM + wc * 64 + 16 * fq; }
    __device__ __forceinline__ void operator()(const f32x4 (&acc)[2][2][4][2], const Unit& u, int wr, int wc, int fr_, int fq_, const f32x4 (&bq4)[4]) const {
        int ln_ = __builtin_amdgcn_mbcnt_hi(~0u, __builtin_amdgcn_mbcnt_lo(~0u, 0u)); asm volatile("" : "+v"(ln_)); const int fr = ln_ & 15, fq = ln_ >> 4;
        const int row0 = u.pm * BM + wr * 64 + fr, col0 = u.pn * BM + wc * 64 + 16 * fq;
        constexpr float KS = 1.702f * LOG2E;
        typedef float f2 __attribute__((ext_vector_type(2)));
        f2 bu[2][2], bl[2][2];
#pragma unroll
        for (int bj = 0; bj < 2; ++bj)
#pragma unroll
            for (int n = 0; n < 2; ++n) { const f32x4 bq = bq4[2 * bj + n]; bu[bj][n] = (f2){-KS * bq[0], -KS * bq[2]}; bl[bj][n] = (f2){bq[1], bq[3]}; }
#pragma unroll
        for (int ai = 0; ai < 2; ++ai)
#pragma unroll
            for (int m = 0; m < 4; ++m) {
                unsigned char* rowp = act + (size_t)(row0 + ai * HALF + m * 16) * FE + (col0 >> 1);
                int w2[2];
#pragma unroll
                for (int bj = 0; bj < 2; ++bj) {
                    f2 o[2];
#pragma unroll
                    for (int n = 0; n < 2; ++n) { const f32x4 q = acc[ai][bj][m][n];
                        f2 U = (f2){q[0], q[1]} * (f2){-KS * W8_INV, -KS * W8_INV} + bu[bj][n], L = (f2){q[2], q[3]} * (f2){W8_INV, W8_INV} + bl[bj][n];
                        U = (f2){fmaxf(U.x, -7.f * KS), fmaxf(U.y, -7.f * KS)};
                        L = (f2){fminf(fmaxf(L.x, -7.f), 7.f), fminf(fmaxf(L.y, -7.f), 7.f)};
                        const f2 D = (f2){__builtin_amdgcn_exp2f(U.x), __builtin_amdgcn_exp2f(U.y)} + (f2){1.f, 1.f};
                        const f2 A = U * (f2){__builtin_amdgcn_rcpf(D.x), __builtin_amdgcn_rcpf(D.y)};
                        o[n] = A * (L * (f2){-1.f / KS, -1.f / KS} + (f2){-1.f / KS, -1.f / KS}); }
                    int w = 0; w = __builtin_amdgcn_cvt_pk_fp8_f32(o[0].x, o[0].y, w, false); w = __builtin_amdgcn_cvt_pk_fp8_f32(o[1].x, o[1].y, w, true);
                    w2[bj] = w;
                }
                *(u32x2*)rowp = (u32x2){(unsigned)w2[0], (unsigned)w2[1]};
            }
    }
};

struct EpiMoe2 {
    static constexpr bool PREBIAS = true;
    unsigned char* yb; const float* b2;
    __device__ __forceinline__ const float* bias_ptr(const Unit& u, int wc, int fq) const { return b2 + (size_t)u.e * 1024 + u.pn * BM + wc * 64 + 16 * fq; }
    __device__ __forceinline__ void operator()(const f32x4 (&acc)[2][2][4][2], const Unit& u, int wr, int wc, int fr_, int fq_, const f32x4 (&bq4)[4]) const {
        int ln_ = __builtin_amdgcn_mbcnt_hi(~0u, __builtin_amdgcn_mbcnt_lo(~0u, 0u)); asm volatile("" : "+v"(ln_)); const int fr = ln_ & 15, fq = ln_ >> 4;
        const int row0 = u.pm * BM + wr * 64 + fr, col0 = u.pn * BM + wc * 64 + 16 * fq;
        f32x4 bv[2][2];
#pragma unroll
        for (int bj = 0; bj < 2; ++bj)
#pragma unroll
            for (int n = 0; n < 2; ++n) bv[bj][n] = bq4[2 * bj + n];
#pragma unroll
        for (int ai = 0; ai < 2; ++ai)
#pragma unroll
            for (int m = 0; m < 4; ++m) { unsigned char* rowp = yb + (size_t)(row0 + ai * HALF + m * 16) * FE + col0;
                int w4[4];
#pragma unroll
                for (int bj = 0; bj < 2; ++bj) { const f32x4 v0 = acc[ai][bj][m][0] * W8_INV + bv[bj][0], v1 = acc[ai][bj][m][1] * W8_INV + bv[bj][1];
                    int w0 = 0, w1 = 0; w0 = __builtin_amdgcn_cvt_pk_fp8_f32(v0[0], v0[1], w0, false); w0 = __builtin_amdgcn_cvt_pk_fp8_f32(v0[2], v0[3], w0, true);
                    w1 = __builtin_amdgcn_cvt_pk_fp8_f32(v1[0], v1[1], w1, false); w1 = __builtin_amdgcn_cvt_pk_fp8_f32(v1[2], v1[3], w1, true);
                    w4[2 * bj] = w0; w4[2 * bj + 1] = w1; }
                *(u32x4*)rowp = (u32x4){(unsigned)w4[0], (unsigned)w4[1], (unsigned)w4[2], (unsigned)w4[3]}; }
    }
};
}

struct Args {
    const float* x; const float* c; const int* pos; const float* w_ada; const float* b_ada;
    const float* g_pre_mix; const float* g_post_mix; const float* g_pre_ffn; const float* g_post_ffn;
    const float* w_in; const float* g_q_a; const float* g_kv_a; const float* w_q_b; const float* w_kv_b; const float* w_o;
    const float* w_router; const float* b_router; const float* w_mlp1; const float* b_mlp1; const float* w_mlp2; const float* b_mlp2;
    float* out; unsigned char* ws; int ph_lo, ph_hi;
};

__device__ __forceinline__ unsigned cvt_pk_bf16_(float lo, float hi) { unsigned r; asm volatile("v_cvt_pk_bf16_f32 %0, %1, %2" : "=v"(r) : "v"(lo), "v"(hi)); return r; }
template <bool FP8>
__device__ __forceinline__ void transpose_item(const float* W, int ldw, int srccol0, int nvalid, bool kvalid, const float* kscale, float cscale,
                                               void* WT, int ldk, int dstrow0, int k0, LAS float* scr, int lane) {
    const int kr = lane >> 3, n4 = (lane & 7) * 4;
#pragma unroll
    for (int i = 0; i < 8; ++i) { const int kk = kr + 8 * i;
        f32x4 v = (f32x4){0.f, 0.f, 0.f, 0.f};
        if (kvalid && n4 < nvalid) { v = *(const f32x4*)(W + (size_t)(k0 + kk) * ldw + srccol0 + n4); float sc = cscale; if (kscale) sc *= kscale[k0 + kk]; v = v * sc; }
        *(LAS f32x4*)(scr + kk * 36 + n4) = v; }
    LDS_WAIT(); asm volatile("" ::: "memory");
    const int n = lane & 31, kh = lane >> 5;
    const LAS float* sp = scr + (32 * kh) * 36 + n;
    if constexpr (FP8) {
        int w[8];
#pragma unroll
        for (int q = 0; q < 8; ++q) { float f0 = sp[(4 * q) * 36], f1 = sp[(4 * q + 1) * 36], f2 = sp[(4 * q + 2) * 36], f3 = sp[(4 * q + 3) * 36];
            f0 = fminf(fmaxf(f0, -448.f), 448.f); f1 = fminf(fmaxf(f1, -448.f), 448.f); f2 = fminf(fmaxf(f2, -448.f), 448.f); f3 = fminf(fmaxf(f3, -448.f), 448.f);
            int t = 0; t = __builtin_amdgcn_cvt_pk_fp8_f32(f0, f1, t, false); t = __builtin_amdgcn_cvt_pk_fp8_f32(f2, f3, t, true); w[q] = t; }
        unsigned char* dst = (unsigned char*)WT + (size_t)(dstrow0 + n) * ldk + k0 + 32 * kh;
        *(i32x4*)dst = (i32x4){w[0], w[1], w[2], w[3]}; *(i32x4*)(dst + 16) = (i32x4){w[4], w[5], w[6], w[7]};
    } else {
        unsigned w[16];
#pragma unroll
        for (int q = 0; q < 16; ++q) w[q] = cvt_pk_bf16_(sp[(2 * q) * 36], sp[(2 * q + 1) * 36]);
        bf16_t* dst = (bf16_t*)WT + (size_t)(dstrow0 + n) * ldk + k0 + 32 * kh;
#pragma unroll
        for (int q = 0; q < 4; ++q) *(u32x4*)(dst + 8 * q) = (u32x4){w[4 * q], w[4 * q + 1], w[4 * q + 2], w[4 * q + 3]};
    }
    LDS_WAIT(); asm volatile("" ::: "memory");
}

__device__ __forceinline__ void moe_item_decode(const Args& a, int r, const float*& W, int& ldw, unsigned char*& WT, int& srccol, int& k0) {
    constexpr int I_M1 = 32 * 16 * 64;
    if (r < I_M1) { const int e = r / 1024, q = r % 1024, kb = q / 64, nb = q % 64; W = a.w_mlp1 + (size_t)e * 1024 * 2048; ldw = 2048; WT = a.ws + WS_W1T + (size_t)e * 2048 * 1024; srccol = 32 * nb; k0 = 64 * kb; }
    else { r -= I_M1; const int e = r / 512, q = r % 512, kb = q / 32, nb = q % 32; W = a.w_mlp2 + (size_t)e * 1024 * 1024; ldw = 1024; WT = a.ws + WS_W2T + (size_t)e * 1024 * 1024; srccol = 32 * nb; k0 = 64 * kb; }
}
__device__ __forceinline__ void moe_item_load(const Args& a, int r, f32x4 (&v)[8], int lane) {
    const float* W; int ldw, srccol, k0; unsigned char* WT; moe_item_decode(a, r, W, ldw, WT, srccol, k0);
    const int kq = lane >> 3, n4 = (lane & 7) * 4;
    const float* src = W + (size_t)(k0 + 8 * kq) * ldw + srccol + n4;
#pragma unroll
    for (int i = 0; i < 8; ++i) v[i] = __builtin_nontemporal_load((const f32x4*)(src + (size_t)i * ldw));
}
__device__ __forceinline__ void moe_item_finish(const Args& a, int r, const f32x4 (&v)[8], int lane) {
    const float* W; int ldw, srccol, k0; unsigned char* WT; moe_item_decode(a, r, W, ldw, WT, srccol, k0);
    const int kq = lane >> 3, n4 = (lane & 7) * 4;
    const int c_ = srccol + n4;
    unsigned char* dst = WT + (size_t)((c_ & ~255) + 128 * ((c_ >> 3) & 1) + 32 * ((c_ >> 6) & 3) + 8 * ((c_ >> 4) & 3) + (c_ & 7)) * 1024 + k0 + 8 * kq;
#pragma unroll
    for (int j = 0; j < 4; ++j) { float f[8];
#pragma unroll
        for (int i = 0; i < 8; ++i) f[i] = fminf(fmaxf(v[i][j] * pg8::W8_SCALE, -448.f), 448.f);
        int d0 = 0, d1 = 0;
        d0 = __builtin_amdgcn_cvt_pk_fp8_f32(f[0], f[1], d0, false); d0 = __builtin_amdgcn_cvt_pk_fp8_f32(f[2], f[3], d0, true);
        d1 = __builtin_amdgcn_cvt_pk_fp8_f32(f[4], f[5], d1, false); d1 = __builtin_amdgcn_cvt_pk_fp8_f32(f[6], f[7], d1, true);
        const int jm = (r < 32 * 16 * 64) ? (((j & 1) << 1) | (j >> 1)) : j;
        *(u32x2*)(dst + (size_t)jm * 1024) = (u32x2){(unsigned)d0, (unsigned)d1}; }
}

__device__ __forceinline__ void p0_prologue(const Args& a, LAS unsigned char* lds, int tid, int wave, int lane) {
    unsigned char* ws = a.ws;
    LAS float* scr = (LAS float*)(lds + wave * 9216);
    const int gw = blockIdx.x * 8 + wave, NGW = gridDim.x * 8;
    constexpr int I_ADA = 8 * 192, I_IN = 16 * 48, I_QB = 4 * 24, I_KVB = 4 * 32, I_O = 16 * 32, I_M1 = 32 * 16 * 64, I_M2 = 32 * 16 * 32;
    constexpr int NITEMS = I_ADA + I_IN;
    float* modp = (float*)(ws + WS_MODP);
    for (int it = gw; it < NITEMS; it += NGW) {
        int r = it;
        if (r < I_ADA) {
            const int kc = r / 192, cc = r % 192, k0 = 128 * kc + (lane >> 3), c0 = 32 * cc + 4 * (lane & 7);
#pragma unroll 4
            for (int i = 0; i < 16; ++i) { const int idx = lane + 64 * i; const float cvv = a.c[(idx >> 7) * DM + 128 * kc + (idx & 127)]; scr[idx] = cvv / (1.f + __expf(-cvv)); }
            LDS_WAIT(); asm volatile("" ::: "memory");
            f32x4 acc[8];
#pragma unroll
            for (int b = 0; b < 8; ++b) acc[b] = (f32x4){0.f, 0.f, 0.f, 0.f};
#pragma unroll 8
            for (int i = 0; i < 16; ++i) { const int k = k0 + 8 * i;
                const f32x4 w = __builtin_nontemporal_load((const f32x4*)(a.w_ada + (size_t)k * 6144 + c0));
#pragma unroll
                for (int b = 0; b < 8; ++b) acc[b] += w * scr[b * 128 + (lane >> 3) + 8 * i]; }
            LDS_WAIT(); asm volatile("" ::: "memory");
#pragma unroll
            for (int b = 0; b < 8; ++b) {
#pragma unroll
                for (int j = 0; j < 4; ++j) { float v = acc[b][j]; v += dppf<0x128>(v); v = fold32(fold16(v)); acc[b][j] = v; }
                if (lane < 8) *(f32x4*)(modp + (size_t)(kc * 8 + b) * 6144 + c0) = acc[b]; }
            continue;
        }
        r -= I_ADA;
        if (r < I_IN) {
            const int kb = r / 48, nb = r % 48, j = 32 * nb; int src, nv = 32; float cs = 1.f;
            if (j < 416) src = j;
            else if (j < 448) src = 1440 + (j - 416);
            else if (j < 480) { src = 1472; nv = 8; cs = 0.35355339059327373f; }
            else if (j < 512) { src = 0; nv = 0; }
            else if (j < 1024) { src = 416 + (j - 512); cs = 0.125f * LOG2E; }
            else if (j < 1152) src = 928 + (j - 1024);
            else if (j < 1280) src = 1056 + (j - 1152);
            else { src = 1184 + (j - 1280); cs = 0.17677669529663687f; }
            transpose_item<false>(a.w_in, 1480, src, nv, true, nullptr, cs, (bf16_t*)(ws + WS_WIN), 1024, j, 64 * kb, scr, lane); continue;
        }
    }
}
__device__ __forceinline__ void small_weights_late(const Args& a, LAS unsigned char* lds, int wave, int lane, int gw, int NGW) {
    unsigned char* ws = a.ws;
    LAS float* scr = (LAS float*)(lds + wave * 9216);
    constexpr int I_QB = 4 * 24, I_KVB = 4 * 32, I_O = 16 * 32;
    for (int it = gw; it < I_QB + I_KVB + I_O; it += NGW) {
        int r = it;
        if (r < I_QB) { const int kb = r / 24, nb = r % 24;
            transpose_item<false>(a.w_q_b, 768, 32 * nb, 32, true, a.g_q_a, 1.f, (bf16_t*)(ws + WS_WQB), 256, 32 * nb, 64 * kb, scr, lane); continue; }
        r -= I_QB;
        if (r < I_KVB) { const int kb = r / 32, nb = r % 32, j = 32 * nb; int src;
            if (j < 512) src = (j >> 6) * 128 + (j & 63); else { const int jj = j - 512; src = (jj >> 6) * 128 + 64 + (jj & 63); }
            transpose_item<false>(a.w_kv_b, 1024, src, 32, kb < 2, a.g_kv_a, 1.f, (bf16_t*)(ws + WS_WKVB), 256, j, 64 * kb, scr, lane); continue; }
        r -= I_KVB;
        if (r < I_O) { const int kb = r / 32, nb = r % 32;
            transpose_item<true>(a.w_o, 1024, 32 * nb, 32, true, nullptr, pg8::W8_SCALE, ws + WS_WO, 1024, 32 * nb, 64 * kb, scr, lane); continue; }
    }
}

template <int D, int NAP = 0>
__device__ __forceinline__ void moe_weights_phase(const Args& a, int lane, int r0, int r1, int gw, int NGW) {
    const int NM = r1;
    f32x4 v[D][8];
    int r = r0 + gw;
    if (r >= NM) return;
#pragma unroll
    for (int d = 0; d < D - 1; ++d) { const int rr = r + d * NGW; moe_item_load(a, rr < NM ? rr : NM - 1, v[d], lane); }
#pragma unroll 1
    for (;;) {
        bool done = false;
#pragma unroll
        for (int d = 0; d < D; ++d) {
            if (!done) { const int rr = r + (D - 1) * NGW; moe_item_load(a, rr < NM ? rr : NM - 1, v[(d + D - 1) % D], lane);
                moe_item_finish(a, r, v[d], lane);
                if (NAP > 0) __builtin_amdgcn_s_sleep(NAP);
                r += NGW; done = (r >= NM); }
        }
        if (done) break;
    }
}

__device__ __forceinline__ float mod_at(const Args& a, int b, int j) {
    const float* modp = (const float*)(a.ws + WS_MODP);
    float s = a.b_ada[j];
#pragma unroll
    for (int kc = 0; kc < 8; ++kc) s += modp[(size_t)(kc * 8 + b) * 6144 + j];
    return s;
}

__device__ __forceinline__ void p1_rows(const Args& a, LAS unsigned char* lds, int tid, int wave, int lane) {
    LAS float* Amul = (LAS float*)lds; LAS float* Badd = Amul + DM;
    bf16_t* hb = (bf16_t*)(a.ws + WS_HB);
    float* rcos = (float*)(a.ws + WS_ROPE); float* rsin = rcos + (size_t)MT * 16;
    { float* mods = (float*)(a.ws + WS_MODS); for (int i = blockIdx.x * 512 + tid; i < NB * 6144; i += gridDim.x * 512) mods[i] = mod_at(a, i / 6144, i % 6144); }
    for (int blk = blockIdx.x; blk < MT / 64; blk += gridDim.x) {
        const int b = blk / 32;
        __syncthreads();
        for (int j = tid; j < DM; j += 512) { const float sh = mod_at(a, b, j), sc = mod_at(a, b, 1024 + j); Amul[j] = a.g_pre_mix[j] * (1.f + sc); Badd[j] = sh; }
        __syncthreads();
#pragma unroll 1
        for (int r0 = wave; r0 < 64; r0 += 32) {
            f32x4 v[4][4];
#pragma unroll
            for (int q = 0; q < 4; ++q) { const f32x4* xr = (const f32x4*)(a.x + (size_t)(blk * 64 + r0 + 8 * q) * DM) + lane;
#pragma unroll
                for (int j = 0; j < 4; ++j) v[q][j] = __builtin_nontemporal_load(xr + 64 * j); }
#pragma unroll
            for (int q = 0; q < 4; ++q) {
                const int row = blk * 64 + r0 + 8 * q;
                float ss = 0.f;
#pragma unroll
                for (int j = 0; j < 4; ++j) ss += (v[q][j][0] * v[q][j][0] + v[q][j][1] * v[q][j][1]) + (v[q][j][2] * v[q][j][2] + v[q][j][3] * v[q][j][3]);
                const float rstd = rsqrtf(wave_sum(ss) * (1.f / DM) + EPS);
                unsigned long long* o8 = (unsigned long long*)(hb + (size_t)row * DM) + lane;
#pragma unroll
                for (int j = 0; j < 4; ++j) { const f32x4 am = *(const LAS f32x4*)(Amul + 4 * lane + 256 * j), bd = *(const LAS f32x4*)(Badd + 4 * lane + 256 * j);
                    const f32x4 h = v[q][j] * rstd * am + bd;
                    o8[64 * j] = (unsigned long long)pk2(h[0], h[1]) | ((unsigned long long)pk2(h[2], h[3]) << 32); }
            }
            {
                const int qv = lane >> 4, iv = lane & 15, rowv = blk * 64 + r0 + 8 * qv;
                const float fr = powf(10000.f, -(float)iv / 16.f); const float ang = (float)a.pos[rowv] * fr; float sn, cs; sincosf(ang, &sn, &cs);
                rcos[(size_t)rowv * 16 + iv] = cs; rsin[(size_t)rowv * 16 + iv] = sn; }
        }
    }
}

__device__ __forceinline__ unsigned sortable(float v) { const unsigned u = __builtin_bit_cast(unsigned, v + 0.0f); return (u & 0x80000000u) ? ~u : (u | 0x80000000u); }

__device__ __forceinline__ unsigned wave_max_u(unsigned v) {
    { unsigned w; w = dppu<0xB1>(v); v = v > w ? v : w; w = dppu<0x4E>(v); v = v > w ? v : w; w = dppu<0x124>(v); v = v > w ? v : w; w = dppu<0x128>(v); v = v > w ? v : w;
      unsigned a = v, b = v; SWAP16(a, b); v = a > b ? a : b; a = v; b = v; SWAP32(a, b); v = a > b ? a : b; }
    return v; }
__device__ __forceinline__ unsigned wave_min_u(unsigned v) {
    { unsigned w; w = dppu<0xB1>(v); v = v < w ? v : w; w = dppu<0x4E>(v); v = v < w ? v : w; w = dppu<0x124>(v); v = v < w ? v : w; w = dppu<0x128>(v); v = v < w ? v : w;
      unsigned a = v, b = v; SWAP16(a, b); v = a < b ? a : b; a = v; b = v; SWAP32(a, b); v = a < b ? a : b; }
    return v; }

template <int NR>
__device__ __forceinline__ void idx_item(LAS unsigned char* lds, const bf16_t* proj, unsigned* bitmap, int b, int tg, int wave, int lane) {
    constexpr int SCS = 2052;
    LAS float* sc = (LAS float*)lds;
    LAS unsigned* cbuf = (LAS unsigned*)(lds + 16 * SCS * 4) + wave * 64;
    const int t0 = tg * 16, nkt = tg + 1;
    const int n = lane & 15, kq = lane >> 4;
    const size_t rowq = (size_t)(b * SEQ + t0 + n);
    bf16x8 qf[8];
#pragma unroll
    for (int h = 0; h < 8; ++h) qf[h] = *(const bf16x8*)(proj + rowq * NPROJ + PC_QIDX + h * 32 + 8 * kq);
    const u32x4 wraw = *(const u32x4*)(proj + rowq * NPROJ + PC_WIDX);
    float w[8]; w[0] = bflo(wraw.x); w[1] = bfhi(wraw.x); w[2] = bflo(wraw.y); w[3] = bfhi(wraw.y); w[4] = bflo(wraw.z); w[5] = bfhi(wraw.z); w[6] = bflo(wraw.w); w[7] = bfhi(wraw.w);
#pragma unroll 1
    for (int base = wave; base < nkt; base += 64) {
        bf16x8 kf[8];
#pragma unroll
        for (int i = 0; i < 8; ++i) { const int kt = base + 8 * i; if (kt < nkt) kf[i] = *(const bf16x8*)(proj + (size_t)(b * SEQ + 16 * kt + n) * NPROJ + PC_KIDX + 8 * kq); }
#pragma unroll
        for (int i = 0; i < 8; ++i) { const int kt = base + 8 * i;
            if (kt < nkt) {
                f32x4 s = (f32x4){0.f, 0.f, 0.f, 0.f};
#pragma unroll
                for (int h = 0; h < 8; ++h) { const f32x4 d = __builtin_amdgcn_mfma_f32_16x16x32_bf16(kf[i], qf[h], (f32x4){0.f, 0.f, 0.f, 0.f}, 0, 0, 0);
#pragma unroll
                    for (int j = 0; j < 4; ++j) s[j] = fmaf(w[h], fmaxf(d[j], 0.f), s[j]); }
                *(LAS f32x4*)(sc + n * SCS + 16 * kt + 4 * kq) = s;
            } }
    }
    __syncthreads();
#pragma unroll 1
    for (int qq = 0; qq < 2; ++qq) {
        const int q = 2 * wave + qq, t = t0 + q;
        unsigned key[NR];
#pragma unroll
        for (int j = 0; j < NR; ++j) key[j] = __builtin_bit_cast(unsigned, sc[q * SCS + 64 * j + lane]);
#pragma unroll
        for (int j = 0; j < NR; j += 4) asm volatile("" : "+v"(key[j]), "+v"(key[j + 1]), "+v"(key[j + 2]), "+v"(key[j + 3]));
#pragma unroll
        for (int j = 0; j < NR; ++j) key[j] = (64 * j + lane <= t) ? sortable(__builtin_bit_cast(float, key[j])) : 0u;
        unsigned long long mine = 0ull; int lo_ = lane; asm volatile("" : "+v"(lo_));
        const unsigned long long lt = (1ull << lane) - 1ull;
        if (t + 1 > 256) {
            unsigned mx = key[0], mn = key[0] ? key[0] : 0xffffffffu;
#pragma unroll
            for (int j = 1; j < NR; ++j) { mx = mx > key[j] ? mx : key[j]; const unsigned kk = key[j] ? key[j] : 0xffffffffu; mn = mn < kk ? mn : kk; }
            mx = wave_max_u(mx); mn = wave_min_u(mn);
            mx = (unsigned)__builtin_amdgcn_readfirstlane((int)mx); mn = (unsigned)__builtin_amdgcn_readfirstlane((int)mn);
            unsigned T = mx; int hiCnt = 0, ngt = 0, neq = 0; bool have = false;
            const unsigned diff = mx ^ mn;
            if (diff != 0u) {
                int bit = 31 - __builtin_clz(diff);
                T = mx & ~(((2u << bit) - 1u));
                int cntT = t + 1;
#pragma unroll 1
                while (bit >= 0 && cntT - hiCnt > 64) {
                    const unsigned cand = T | (1u << bit); unsigned cl = 0u;
#pragma unroll
                    for (int j = 0; j < NR; ++j) cl += (key[j] >= cand) ? 1u : 0u;
                    int c = 0;
#pragma unroll
                    for (int bb = 0; bb < 6; ++bb) c += __popcll(__ballot((cl >> bb) & 1u)) << bb;
                    if (c >= 256) { T = cand; cntT = c; } else hiCnt = c;
                    --bit;
                }
                if (bit >= 0) {
                    const unsigned span = (2u << bit) - 1u; int run = 0;
                    const unsigned tsub = T > 1u ? T : 1u, spn = (T | span) - tsub;
#pragma unroll
                    for (int j = 0; j < NR; ++j) { const bool in = (key[j] - tsub) <= spn; const unsigned long long m = __ballot(in);
                        if (in) cbuf[run + (int)__builtin_amdgcn_mbcnt_hi((unsigned)(m >> 32), __builtin_amdgcn_mbcnt_lo((unsigned)m, 0u))] = key[j];
                        run += __popcll(m); if ((j & 3) == 3) __builtin_amdgcn_sched_barrier(0); }
                    LDS_WAIT();
                    const unsigned ck = (lane < run) ? cbuf[lane] : 0u;
#pragma unroll 1
                    for (; bit >= 0; --bit) { const unsigned cand = T | (1u << bit); const int c = __popcll(__ballot(ck >= cand)); if (hiCnt + c >= 256) T = cand; }
                    ngt = hiCnt + __popcll(__ballot(ck > T)); neq = __popcll(__ballot(ck == T)); have = true;
                }
            }
            if (!have) {
#pragma unroll
                for (int j = 0; j < NR; ++j) { ngt += __popcll(__ballot(key[j] > T)); neq += __popcll(__ballot(key[j] == T)); if ((j & 3) == 3) __builtin_amdgcn_sched_barrier(0); }
            }
            const int need = 256 - ngt;
            asm volatile("" : "+s"(T));
            if (neq == need) {
#pragma unroll
                for (int j = 0; j < NR; ++j) { const unsigned long long mk = __ballot(key[j] >= T); mine = (lo_ == j) ? mk : mine; if ((j & 3) == 3) __builtin_amdgcn_sched_barrier(0); }
            } else {
                int run = 0;
#pragma unroll
                for (int j = 0; j < NR; ++j) { const bool eq = key[j] == T; const unsigned long long em = __ballot(eq); const int rank = run + __popcll(em & lt);
                    const unsigned long long mk = __ballot(key[j] > T || (eq && rank < need)); mine = (lo_ == j) ? mk : mine; run += __popcll(em); if ((j & 3) == 3) __builtin_amdgcn_sched_barrier(0); }
            }
        } else {
#pragma unroll
            for (int j = 0; j < 4; ++j) { const unsigned long long mk = __ballot(64 * j + lo_ <= t); mine = (lo_ == j) ? mk : mine; }
        }
        if (lane < 32) ((unsigned long long*)bitmap)[(size_t)(b * SEQ + t) * 32 + lane] = mine;
    }
    __syncthreads();
}

__device__ __forceinline__ int crow(int r, int hi) { return (r & 3) + 8 * (r >> 2) + 4 * hi; }
typedef float f32x2_t __attribute__((ext_vector_type(2))); typedef __bf16 bf16x2_t __attribute__((ext_vector_type(2)));
__device__ __forceinline__ unsigned cvtpk(float lo, float hi) { f32x2_t v = {lo, hi}; bf16x2_t b = __builtin_convertvector(v, bf16x2_t); return __builtin_bit_cast(unsigned, b); }

template <int DQK, bool DSA>
__device__ __forceinline__ void attn_unit(LAS unsigned char* lds, int b, int qt,
                                          const bf16_t* Qp, int ldq, const bf16_t* Kp, int ldk, const bf16_t* Vt, unsigned char* Yp,
                                          const unsigned* bitmap, const int* pos, float c1, float aslope, int tid, int wave, int lane, LAS unsigned* tctr, unsigned& tgen, const float* rcos, const float* rsin) {
    constexpr int KSTR = DQK * 2 + 16, KBYTES = 64 * KSTR, VSTR = 136, VBYTES = 64 * VSTR, BUF = KBYTES + VBYTES + 256, NKS = DQK / 16, CPR = DQK / 8, NCH = 64 * CPR;
    const int hi = lane >> 5, l31 = lane & 31;
    const int NT = 2 * (qt + 1);
    const int qw0 = 128 * qt + 32 * wave, tq = qw0 + l31;
    const size_t rowq = (size_t)(b * SEQ + tq);
    bf16x8 qf[NKS];
#pragma unroll
    for (int ks = 0; ks < NKS; ++ks) qf[ks] = *(const bf16x8*)(Qp + rowq * ldq + 16 * ks + 8 * hi);
    if (!DSA) {
        const f32x4 c0 = *(const f32x4*)(rcos + rowq * 16 + 8 * hi), c1_ = *(const f32x4*)(rcos + rowq * 16 + 8 * hi + 4);
        const f32x4 s0 = *(const f32x4*)(rsin + rowq * 16 + 8 * hi), s1_ = *(const f32x4*)(rsin + rowq * 16 + 8 * hi + 4);
        const u32x4 xa = __builtin_bit_cast(u32x4, qf[NKS - 2]), xb = __builtin_bit_cast(u32x4, qf[NKS - 1]); u32x4 ya, yb_;
#pragma unroll
        for (int w = 0; w < 4; ++w) {
            const float a0 = bflo(xa[w]), a1 = bfhi(xa[w]), b0 = bflo(xb[w]), b1 = bfhi(xb[w]);
            const float cc0 = (w < 2) ? c0[2 * w] : c1_[2 * w - 4], cc1 = (w < 2) ? c0[2 * w + 1] : c1_[2 * w - 3];
            const float ss0 = (w < 2) ? s0[2 * w] : s1_[2 * w - 4], ss1 = (w < 2) ? s0[2 * w + 1] : s1_[2 * w - 3];
            ya[w] = cvtpk(a0 * cc0 - b0 * ss0, a1 * cc1 - b1 * ss1); yb_[w] = cvtpk(b0 * cc0 + a0 * ss0, b1 * cc1 + a1 * ss1); }
        qf[NKS - 2] = __builtin_bit_cast(bf16x8, ya); qf[NKS - 1] = __builtin_bit_cast(bf16x8, yb_);
    }
    float ptq = 0.f; if (DSA) ptq = (float)pos[b * SEQ + tq];
    constexpr float THR = 4.0f;
    float mref = 0.f, lrun = 0.f; bool seen = false; f32x16 o[2], negm;
#pragma unroll
    for (int r = 0; r < 16; ++r) { o[0][r] = 0.f; o[1][r] = 0.f; negm[r] = 0.f; }
    u32x4 kreg[NCH / 256], vreg[2]; int preg = 0;
#define TEAM_BAR() do { asm volatile("s_waitcnt lgkmcnt(0)" ::: "memory"); tgen += 4u; \
        if (lane == 0) (void)__hip_atomic_fetch_add(tctr, 1u, __ATOMIC_RELAXED, __HIP_MEMORY_SCOPE_WORKGROUP); \
        while ((unsigned)__builtin_amdgcn_readfirstlane((int)__hip_atomic_load(tctr, __ATOMIC_RELAXED, __HIP_MEMORY_SCOPE_WORKGROUP)) < tgen) __builtin_amdgcn_s_sleep(0); \
        asm volatile("" ::: "memory"); } while (0)
#define ATT_LOAD(t) do { const size_t kb_ = (size_t)(b * SEQ + 64 * (t)); \
        _Pragma("unroll") for (int i_ = 0; i_ < NCH / 256; ++i_) { const int c_ = tid + 256 * i_; kreg[i_] = *(const u32x4*)(Kp + (kb_ + c_ / CPR) * ldk + 8 * (c_ % CPR)); } \
        _Pragma("unroll") for (int i_ = 0; i_ < 2; ++i_) { const int c_ = tid + 256 * i_; vreg[i_] = *(const u32x4*)(Vt + (size_t)(c_ >> 3) * SEQ + 64 * (t) + 8 * (c_ & 7)); } \
        if (DSA && tid < 64) preg = pos[b * SEQ + 64 * (t) + tid]; } while (0)
#define ATT_WRITE(bufi) do { LAS unsigned char* bb_ = lds + (bufi) * BUF; \
        _Pragma("unroll") for (int i_ = 0; i_ < NCH / 256; ++i_) { const int c_ = tid + 256 * i_; *(LAS u32x4*)(bb_ + (c_ / CPR) * KSTR + 16 * (c_ % CPR)) = kreg[i_]; } \
        _Pragma("unroll") for (int i_ = 0; i_ < 2; ++i_) { const int c_ = tid + 256 * i_; \
            *(LAS u32x2*)(bb_ + KBYTES + (c_ >> 3) * VSTR + 16 * (c_ & 7)) = (u32x2){vreg[i_].x, vreg[i_].y}; *(LAS u32x2*)(bb_ + KBYTES + (c_ >> 3) * VSTR + 16 * (c_ & 7) + 8) = (u32x2){vreg[i_].z, vreg[i_].w}; } \
        if (DSA && tid < 64) *(LAS float*)(bb_ + KBYTES + VBYTES + 4 * tid) = (float)preg; } while (0)
    u32x2 bwn = (u32x2){0u, 0u}; if (DSA) bwn = *(const u32x2*)(bitmap + rowq * 64);
    ATT_LOAD(0); ATT_WRITE(0); TEAM_BAR();
#pragma unroll
    for (int ks = 0; ks < NKS; ++ks) asm volatile("" : "+v"(qf[ks]));
    for (int t = 0; t < NT; ++t) {
        const u32x2 bw = bwn; if (DSA && t + 1 < NT) bwn = *(const u32x2*)(bitmap + rowq * 64 + 2 * (t + 1));
        if (t + 1 < NT) ATT_LOAD(t + 1);
        if (64 * t <= qw0 + 31) {
            const LAS unsigned char* bb = lds + (t & 1) * BUF;
            f32x16 s0 = negm, s1 = negm;
            bf16x8 kfa[NKS], kfb[NKS];
#pragma unroll
            for (int ks = 0; ks < NKS; ++ks) { kfa[ks] = *(const LAS bf16x8*)(bb + l31 * KSTR + 32 * ks + 16 * hi); kfb[ks] = *(const LAS bf16x8*)(bb + (32 + l31) * KSTR + 32 * ks + 16 * hi); }
            __builtin_amdgcn_sched_barrier(0);
#pragma unroll
            for (int ks = 0; ks < NKS; ++ks) {
                s0 = __builtin_amdgcn_mfma_f32_32x32x16_bf16(kfa[ks], qf[ks], s0, 0, 0, 0);
                s1 = __builtin_amdgcn_mfma_f32_32x32x16_bf16(kfb[ks], qf[ks], s1, 0, 0, 0);
            }
            __builtin_amdgcn_sched_barrier(0);
            const LAS unsigned char* vb = bb + KBYTES;
            u32x2 vlo[8], vhi[8];
#pragma unroll
            for (int kk = 0; kk < 2; ++kk)
#pragma unroll
                for (int s = 0; s < 2; ++s)
#pragma unroll
                    for (int db = 0; db < 2; ++db) { const LAS unsigned char* va = vb + (32 * db + l31) * VSTR + (32 * kk + 16 * s + 4 * hi) * 2;
                        vlo[(kk * 2 + s) * 2 + db] = *(const LAS u32x2*)va; vhi[(kk * 2 + s) * 2 + db] = *(const LAS u32x2*)(va + 16); }
            __builtin_amdgcn_sched_barrier(0);
            if (DSA) {
                asm volatile("s_nop 15\n\ts_nop 3" ::: "memory");
                __builtin_amdgcn_sched_barrier(0);
                const unsigned w0 = bw.x >> (4 * hi), w1 = bw.y >> (4 * hi);
                const LAS float* pp = (const LAS float*)(bb + KBYTES + VBYTES);
                const float nega = -aslope; const unsigned ninf = 0xff800000u;
#define DSA_EL(S, PK, W, BIT) do { float t_, v_; unsigned m_, r_; \
                    asm("v_sub_f32 %0, %1, %2" : "=v"(t_) : "v"(ptq), "v"(PK)); \
                    asm("v_fma_f32 %0, %1, |%2|, %3" : "=v"(v_) : "s"(nega), "v"(t_), "v"(S)); \
                    asm("v_bfe_i32 %0, %1, %2, 1" : "=v"(m_) : "v"(W), "n"(BIT)); \
                    asm("v_bfi_b32 %0, %1, %2, %3" : "=v"(r_) : "v"(m_), "v"(v_), "s"(ninf)); \
                    S = __builtin_bit_cast(float, r_); } while (0)
#pragma unroll
                for (int g = 0; g < 4; ++g) {
                    const f32x4 p0 = *(const LAS f32x4*)(pp + 8 * g + 4 * hi), p1 = *(const LAS f32x4*)(pp + 32 + 8 * g + 4 * hi);
                    DSA_EL(s0[4 * g + 0], p0[0], w0, 8 * g + 0); DSA_EL(s0[4 * g + 1], p0[1], w0, 8 * g + 1); DSA_EL(s0[4 * g + 2], p0[2], w0, 8 * g + 2); DSA_EL(s0[4 * g + 3], p0[3], w0, 8 * g + 3);
                    DSA_EL(s1[4 * g + 0], p1[0], w1, 8 * g + 0); DSA_EL(s1[4 * g + 1], p1[1], w1, 8 * g + 1); DSA_EL(s1[4 * g + 2], p1[2], w1, 8 * g + 2); DSA_EL(s1[4 * g + 3], p1[3], w1, 8 * g + 3);
                }
#undef DSA_EL
            } else {
                if (64 * t + 63 > qw0) {
#pragma unroll
                    for (int r = 0; r < 16; ++r) { const int key = 64 * t + crow(r, hi); if (key > tq) s0[r] = -INFINITY; if (key + 32 > tq) s1[r] = -INFINITY; }
                }
            }
            float mx;
            { float m0 = fmaxf(fmaxf(s0[0], s0[1]), s0[2]), m1 = fmaxf(fmaxf(s0[3], s0[4]), s0[5]), m2 = fmaxf(fmaxf(s1[0], s1[1]), s1[2]), m3 = fmaxf(fmaxf(s1[3], s1[4]), s1[5]);
              m0 = fmaxf(fmaxf(m0, s0[6]), s0[7]); m1 = fmaxf(fmaxf(m1, s0[8]), s0[9]); m2 = fmaxf(fmaxf(m2, s1[6]), s1[7]); m3 = fmaxf(fmaxf(m3, s1[8]), s1[9]);
              m0 = fmaxf(fmaxf(m0, s0[10]), s0[11]); m1 = fmaxf(fmaxf(m1, s0[12]), s0[13]); m2 = fmaxf(fmaxf(m2, s1[10]), s1[11]); m3 = fmaxf(fmaxf(m3, s1[12]), s1[13]);
              m0 = fmaxf(fmaxf(m0, s0[14]), s0[15]); m2 = fmaxf(fmaxf(m2, s1[14]), s1[15]);
              mx = fmaxf(fmaxf(m0, m1), fmaxf(m2, m3)); }
            { float ma = mx, mb = mx; asm volatile("s_nop 1\n\tv_permlane32_swap_b32 %0, %1" : "+v"(ma), "+v"(mb)); mx = fmaxf(ma, mb); }
            {
                const bool fin = mx > -INFINITY, first = fin && !seen, upd = first || (mx > THR);
                if (__any(upd)) {
                    const float dl = upd ? mx : 0.f;
                    const float alpha = first ? 1.f : __builtin_amdgcn_exp2f(-dl);
                    mref += dl; lrun *= alpha;
#pragma unroll
                    for (int r = 0; r < 16; ++r) { s0[r] -= dl; s1[r] -= dl; o[0][r] *= alpha; o[1][r] *= alpha; negm[r] = -mref; }
                }
                seen = seen || fin;
            }
            float psum = 0.f;
#pragma unroll
            for (int r = 0; r < 16; ++r) { s0[r] = __builtin_amdgcn_exp2f(s0[r]); s1[r] = __builtin_amdgcn_exp2f(s1[r]); }
            { float q0 = 0.f, q1 = 0.f, q2 = 0.f, q3 = 0.f;
#pragma unroll
              for (int r = 0; r < 16; r += 4) { q0 += s0[r] + s1[r]; q1 += s0[r + 1] + s1[r + 1]; q2 += s0[r + 2] + s1[r + 2]; q3 += s0[r + 3] + s1[r + 3]; }
              psum = (q0 + q1) + (q2 + q3); }
            lrun += psum;
            unsigned pb0[8], pb1[8];
#pragma unroll
            for (int i = 0; i < 8; ++i) { pb0[i] = cvtpk(s0[2 * i], s0[2 * i + 1]); pb1[i] = cvtpk(s1[2 * i], s1[2 * i + 1]); }
            __builtin_amdgcn_sched_barrier(0);
#pragma unroll
            for (int kk = 0; kk < 2; ++kk)
#pragma unroll
                for (int s = 0; s < 2; ++s) {
                    u32x4 pf; if (kk == 0) pf = (u32x4){pb0[4 * s], pb0[4 * s + 1], pb0[4 * s + 2], pb0[4 * s + 3]}; else pf = (u32x4){pb1[4 * s], pb1[4 * s + 1], pb1[4 * s + 2], pb1[4 * s + 3]};
                    const bf16x8 pfr = __builtin_bit_cast(bf16x8, pf);
#pragma unroll
                    for (int db = 0; db < 2; ++db) { const int fi = (kk * 2 + s) * 2 + db;
                        const bf16x8 vf = __builtin_bit_cast(bf16x8, (u32x4){vlo[fi].x, vlo[fi].y, vhi[fi].x, vhi[fi].y});
                        o[db] = __builtin_amdgcn_mfma_f32_32x32x16_bf16(vf, pfr, o[db], 0, 0, 0); }
                }
        }
        if (t + 1 < NT) ATT_WRITE((t + 1) & 1);
        TEAM_BAR();
    }
#undef ATT_LOAD
#undef ATT_WRITE
#undef TEAM_BAR
    const float lt = fold32(lrun);
    const float inv = 1.f / lt;
#pragma unroll
    for (int db = 0; db < 2; ++db)
#pragma unroll
        for (int g = 0; g < 4; ++g) { int w = 0; w = __builtin_amdgcn_cvt_pk_fp8_f32(o[db][4 * g] * inv, o[db][4 * g + 1] * inv, w, false); w = __builtin_amdgcn_cvt_pk_fp8_f32(o[db][4 * g + 2] * inv, o[db][4 * g + 3] * inv, w, true);
            *(int*)(Yp + rowq * DM + 32 * db + 8 * g + 4 * hi) = w; }
}

typedef float f32x2v __attribute__((ext_vector_type(2)));
__device__ __forceinline__ void p6_front(const Args& a, const bf16_t* mix, unsigned char* hb8, const LAS float* GT1, const LAS float* A2, const LAS float* B2, int row, int lane, f32x4 (&xv)[4]) {
    const u32x2* mr = (const u32x2*)(mix + (size_t)row * DM) + lane;
    const f32x4* xr = (const f32x4*)(a.x + (size_t)row * DM) + lane;
    f32x4 mv[4]; float ss = 0.f;
#pragma unroll
    for (int j = 0; j < 4; ++j) { const u32x2 q = __builtin_nontemporal_load(mr + 64 * j); mv[j] = (f32x4){bflo(q.x), bfhi(q.x), bflo(q.y), bfhi(q.y)}; xv[j] = __builtin_nontemporal_load(xr + 64 * j);
        ss += (mv[j][0] * mv[j][0] + mv[j][1] * mv[j][1]) + (mv[j][2] * mv[j][2] + mv[j][3] * mv[j][3]); }
    const float rstd1 = rsqrtf(wave_sum(ss) * (1.f / DM) + EPS);
    float ss2 = 0.f;
    f32x4* orow = (f32x4*)(a.out + (size_t)row * DM) + lane;
#pragma unroll
    for (int j = 0; j < 4; ++j) { const f32x4 g1 = *(const LAS f32x4*)(GT1 + 4 * lane + 256 * j);
        xv[j] = xv[j] + g1 * (mv[j] * rstd1); orow[64 * j] = xv[j];
        ss2 += (xv[j][0] * xv[j][0] + xv[j][1] * xv[j][1]) + (xv[j][2] * xv[j][2] + xv[j][3] * xv[j][3]); }
    const float rstd2 = rsqrtf(wave_sum(ss2) * (1.f / DM) + EPS);
    int* o4 = (int*)(hb8 + (size_t)row * DM) + lane;
#pragma unroll
    for (int j = 0; j < 4; ++j) { const f32x4 am = *(const LAS f32x4*)(A2 + 4 * lane + 256 * j), bd = *(const LAS f32x4*)(B2 + 4 * lane + 256 * j);
        xv[j] = xv[j] * rstd2 * am + bd;
        int w = 0; w = __builtin_amdgcn_cvt_pk_fp8_f32(xv[j][0], xv[j][1], w, false); w = __builtin_amdgcn_cvt_pk_fp8_f32(xv[j][2], xv[j][3], w, true);
        o4[64 * j] = w; }
}
__device__ __forceinline__ void p6_route(const Args& a, float (&pe)[32], LAS int* lcnt, LAS int* info, int r, int lane) {
    { const bool b5 = (lane & 32) != 0, b4 = (lane & 16) != 0, b3 = (lane & 8) != 0, b2 = (lane & 4) != 0, b1 = (lane & 2) != 0;
#pragma unroll
      for (int i = 0; i < 16; ++i) { float a_ = pe[i], b_ = pe[16 + i]; SWAP32(a_, b_); pe[i] = a_ + b_; }
#pragma unroll
      for (int i = 0; i < 8; ++i) { float a_ = pe[i], b_ = pe[8 + i]; SWAP16(a_, b_); pe[i] = a_ + b_; }
#pragma unroll
      for (int i = 0; i < 4; ++i) { const float keep = b3 ? pe[4 + i] : pe[i], send = b3 ? pe[i] : pe[4 + i]; pe[i] = keep + dppf<0x128>(send); }
#pragma unroll
      for (int i = 0; i < 2; ++i) { const float keep = b2 ? pe[2 + i] : pe[i], send = b2 ? pe[i] : pe[2 + i]; pe[i] = keep + dppf<0x141>(dppf<0x1B>(send)); }
      { const float keep = b1 ? pe[1] : pe[0], send = b1 ? pe[0] : pe[1]; pe[0] = keep + dppf<0x4E>(send); }
      pe[0] += dppf<0xB1>(pe[0]); }
    const int myexp = lane >> 1;
    const float mylg = pe[0] + a.b_router[myexp];
    unsigned key = sortable(mylg);
    float tv[4]; int ti[4];
#pragma unroll
    for (int p = 0; p < 4; ++p) { const unsigned mx = (unsigned)__builtin_amdgcn_readfirstlane((int)wave_max_u(key));
        const unsigned long long bm = __ballot(key == mx); const int bi = __builtin_ctzll(bm);
        ti[p] = bi >> 1; tv[p] = __builtin_bit_cast(float, __builtin_amdgcn_readlane(__builtin_bit_cast(int, mylg), bi));
        key = (myexp == ti[p]) ? 0u : key; }
    float ex[4], es = 0.f;
#pragma unroll
    for (int p = 0; p < 4; ++p) { ex[p] = __expf(tv[p] - tv[0]); es += ex[p]; }
    if (lane < 4) {
        const int e = lane == 0 ? ti[0] : lane == 1 ? ti[1] : lane == 2 ? ti[2] : ti[3];
        const float g = (lane == 0 ? ex[0] : lane == 1 ? ex[1] : lane == 2 ? ex[2] : ex[3]) / es;
        const int lr = __hip_atomic_fetch_add(&lcnt[e], 1, __ATOMIC_RELAXED, __HIP_MEMORY_SCOPE_WORKGROUP);
        info[(r * 4 + lane) * 3 + 0] = e; info[(r * 4 + lane) * 3 + 1] = lr; info[(r * 4 + lane) * 3 + 2] = __builtin_bit_cast(int, g);
    }
}

__device__ __forceinline__ void p6_stage(const Args& a, LAS unsigned char* lds, int tid, int b, bool weights) {
    constexpr int WTS = 1028;
    LAS float* WT = (LAS float*)lds; LAS float* GT1 = WT + 32 * WTS; LAS float* A2 = GT1 + DM; LAS float* B2 = A2 + DM; LAS int* lcnt = (LAS int*)(B2 + DM);
    if (weights) {
#pragma unroll 4
        for (int i = tid; i < DM * NE / 4; i += 512) { const f32x4 w4 = *(const f32x4*)(a.w_router + 4 * (size_t)i); const int k = i >> 3, e4 = (i & 7) * 4;
            WT[(e4 + 0) * WTS + k] = w4[0]; WT[(e4 + 1) * WTS + k] = w4[1]; WT[(e4 + 2) * WTS + k] = w4[2]; WT[(e4 + 3) * WTS + k] = w4[3]; }
        if (tid < 32) lcnt[tid] = 0; }
    const float* mods = (const float*)(a.ws + WS_MODS) + (size_t)b * 6144;
    for (int j = tid; j < DM; j += 512) { GT1[j] = mods[2048 + j] * a.g_post_mix[j]; A2[j] = a.g_pre_ffn[j] * (1.f + mods[4096 + j]); B2[j] = mods[3072 + j]; }
}
__device__ __forceinline__ void p6_rows(const Args& a, LAS unsigned char* lds, int tid, int wave, int lane, bool staged) {
    constexpr int WTS = 1028;
    LAS float* WT = (LAS float*)lds;
    LAS float* GT1 = WT + 32 * WTS; LAS float* A2 = GT1 + DM; LAS float* B2 = A2 + DM;
    LAS int* lcnt = (LAS int*)(B2 + DM); LAS int* lbase = lcnt + 32; LAS int* info = lbase + 32;
    unsigned char* ws = a.ws;
    const bf16_t* mix = (const bf16_t*)(ws + WS_MIX); unsigned char* hb8 = ws + WS_HB;
    int* cnt = (int*)(ws + WS_CTL) + CW_CNT; int* list = (int*)(ws + WS_LIST);
    int* route_e = (int*)(ws + WS_ROUTE); int* route_pos = route_e + MT * 4; float* gate = (float*)(route_pos + MT * 4);
    if (!staged) p6_stage(a, lds, tid, blockIdx.x / 32, true);
    for (int blk = blockIdx.x; blk < MT / 64; blk += gridDim.x) {
        const int b = blk / 32;
        __syncthreads();
        if (blk != (int)blockIdx.x) p6_stage(a, lds, tid, b, false);
        __syncthreads();
#pragma unroll 1
        for (int it = 0; it < 4; ++it) {
            const int rA = wave + 16 * it, rB = rA + 8;
            const int ln = fresh_lane();
            f32x4 xa[4], xb[4];
            p6_front(a, mix, hb8, GT1, A2, B2, blk * 64 + rA, ln, xa);
            p6_front(a, mix, hb8, GT1, A2, B2, blk * 64 + rB, ln, xb);
            float pa[32], pb[32];
#pragma unroll
            for (int e = 0; e < 32; ++e) { f32x2v accA = (f32x2v){0.f, 0.f}, accB = (f32x2v){0.f, 0.f};
#pragma unroll
                for (int j = 0; j < 4; ++j) { const f32x4 wv = *(const LAS f32x4*)(WT + e * WTS + 4 * ln + 256 * j);
                    const f32x2v w01 = (f32x2v){wv[0], wv[1]}, w23 = (f32x2v){wv[2], wv[3]};
                    accA = __builtin_elementwise_fma((f32x2v){xa[j][0], xa[j][1]}, w01, accA); accA = __builtin_elementwise_fma((f32x2v){xa[j][2], xa[j][3]}, w23, accA);
                    accB = __builtin_elementwise_fma((f32x2v){xb[j][0], xb[j][1]}, w01, accB); accB = __builtin_elementwise_fma((f32x2v){xb[j][2], xb[j][3]}, w23, accB); }
                pa[e] = accA.x + accA.y; pb[e] = accB.x + accB.y; if ((e & 3) == 3) __builtin_amdgcn_sched_barrier(0); }
#pragma unroll 1
            for (int rr = 0; rr < 2; ++rr) {
                const int ln2 = fresh_lane();
                p6_route(a, pa, lcnt, info, rr ? rB : rA, ln2);
#pragma unroll
                for (int e = 0; e < 32; ++e) pa[e] = pb[e];
            }
        }
        __syncthreads();
        if (tid < 32) lbase[tid] = atomicAdd(cnt + CNT_STRIDE * tid, lcnt[tid]);
        __syncthreads();
        if (tid < 256) { const int e = info[tid * 3 + 0], p = lbase[e] + info[tid * 3 + 1]; const int row = blk * 64 + (tid >> 2);
            list[e * MT + p] = row; route_e[row * 4 + (tid & 3)] = e; route_pos[row * 4 + (tid & 3)] = p; gate[row * 4 + (tid & 3)] = __builtin_bit_cast(float, info[tid * 3 + 2]); }
        __syncthreads();
        if (tid < 32) lcnt[tid] = 0;
    }
}

__device__ __forceinline__ void p9_stage(const Args& a, LAS unsigned char* lds, int tid, int b) {
    LAS float* GT2 = (LAS float*)lds; const float* mods = (const float*)(a.ws + WS_MODS) + (size_t)b * 6144;
    for (int j = tid; j < DM; j += 512) GT2[j] = mods[5120 + j] * a.g_post_ffn[j];
}
__device__ __forceinline__ void p9_rows(const Args& a, LAS unsigned char* lds, const LAS int* ts, int tid, int wave, int lane, bool staged) {
    LAS float* GT2 = (LAS float*)lds;
    unsigned char* ws = a.ws;
    const unsigned char* yb = ws + WS_YB;
    const int* route_e = (const int*)(ws + WS_ROUTE); const int* route_pos = route_e + MT * 4; const float* gate = (const float*)(route_pos + MT * 4);
    for (int blk = blockIdx.x; blk < MT / 64; blk += gridDim.x) {
        const int b = blk / 32;
        __syncthreads();
        if (!staged || blk != (int)blockIdx.x) p9_stage(a, lds, tid, b);
        __syncthreads();
#pragma unroll 1
        for (int r0 = wave; r0 < 64; r0 += 16) {
            i32x4 re[2], rp[2]; f32x4 gg[2];
#pragma unroll
            for (int q = 0; q < 2; ++q) { const int row = blk * 64 + r0 + 8 * q; re[q] = *(const i32x4*)(route_e + row * 4); rp[q] = *(const i32x4*)(route_pos + row * 4); gg[q] = *(const f32x4*)(gate + row * 4); }
            int yv[2][4][4]; f32x4 xo[2][4];
#pragma unroll
            for (int q = 0; q < 2; ++q) { const int row = blk * 64 + r0 + 8 * q;
#pragma unroll
                for (int k = 0; k < 4; ++k) { const int slot = ts[re[q][k]] * 256 + rp[q][k]; const int* yr = (const int*)(yb + (size_t)slot * FE) + lane;
#pragma unroll
                    for (int j = 0; j < 4; ++j) yv[q][k][j] = __builtin_nontemporal_load(yr + 64 * j); }
                const f32x4* orow = (const f32x4*)(a.out + (size_t)row * DM) + lane;
#pragma unroll
                for (int j = 0; j < 4; ++j) xo[q][j] = __builtin_nontemporal_load(orow + 64 * j); }
#pragma unroll
            for (int q = 0; q < 2; ++q) { const int row = blk * 64 + r0 + 8 * q;
                f32x4 f[4];
#pragma unroll
                for (int j = 0; j < 4; ++j) f[j] = (f32x4){0.f, 0.f, 0.f, 0.f};
#pragma unroll
                for (int k = 0; k < 4; ++k) { const float g = gg[q][k];
#pragma unroll
                    for (int j = 0; j < 4; ++j) { const int w = yv[q][k][j]; const f32x2v lo = __builtin_amdgcn_cvt_pk_f32_fp8(w, false), hi2 = __builtin_amdgcn_cvt_pk_f32_fp8(w, true); f[j] += (f32x4){lo.x, lo.y, hi2.x, hi2.y} * g; } }
                float ss = 0.f;
#pragma unroll
                for (int j = 0; j < 4; ++j) ss += (f[j][0] * f[j][0] + f[j][1] * f[j][1]) + (f[j][2] * f[j][2] + f[j][3] * f[j][3]);
                const float rstd = rsqrtf(wave_sum(ss) * (1.f / DM) + EPS);
                f32x4* orow = (f32x4*)(a.out + (size_t)row * DM) + lane;
#pragma unroll
                for (int j = 0; j < 4; ++j) { const f32x4 g2 = *(const LAS f32x4*)(GT2 + 4 * lane + 256 * j); __builtin_nontemporal_store(xo[q][j] + g2 * (f[j] * rstd), orow + 64 * j); }
            }
        }
    }
}

#define XB_TMO      128
#define XB_XCNT(j)  (256  + 64 * (j))
#define XB_XSUB(j)  (1280 + 64 * (j))
#define XB_XGEN(j)  (2304 + 64 * (j))
#define XB_TOP      3328
#define XB_TOPGEN   3392
#define XCD_BAR_WORDS 3456
#define XB_SPIN_CAP (1u << 22)
__device__ __forceinline__ unsigned xb_ld(unsigned* p)              { return __hip_atomic_load(p, __ATOMIC_RELAXED, __HIP_MEMORY_SCOPE_AGENT); }
__device__ __forceinline__ unsigned xb_add(unsigned* p, unsigned v) { return __hip_atomic_fetch_add(p, v, __ATOMIC_RELAXED, __HIP_MEMORY_SCOPE_AGENT); }
__device__ __forceinline__ unsigned xb_xcc_id() { return (unsigned)__builtin_amdgcn_s_getreg((3 << 11) | 20) & 0xFu; }
#define XB_SPIN(cond, bar) do { unsigned _sp = 0; while (cond) { __builtin_amdgcn_s_sleep(1); \
    if ((++_sp & 255u) == 0u) { if (xb_ld(&(bar)[XB_TMO])) break; if (_sp > XB_SPIN_CAP) { atomicAdd(&(bar)[XB_TMO], 1u); break; } } } } while (0)
struct XcdBarrier { unsigned* bar; unsigned x; volatile LAS unsigned* st; };
__device__ __forceinline__ void xcd_barrier_complete(unsigned* bar, unsigned x, unsigned& nloc, unsigned& nx) {
    const unsigned G = gridDim.x;
    unsigned sum, cnt, mine, sp = 0u;
    for (;;) {
        sum = 0u; cnt = 0u; mine = 0u;
#pragma unroll
        for (unsigned j = 0; j < 16; ++j) { const unsigned c = xb_ld(&bar[XB_XCNT(j)]); sum += c; cnt += (c > 0u) ? 1u : 0u; mine = (j == x) ? c : mine; }
        if (sum == G) break;
        __builtin_amdgcn_s_sleep(1);
        if ((++sp & 255u) == 0u) { if (xb_ld(&bar[XB_TMO])) break; if (sp > XB_SPIN_CAP) { atomicAdd(&bar[XB_TMO], 1u); break; } }
    }
    nloc = mine > 0u ? mine : 1u; nx = cnt > 0u ? cnt : 1u;
}
__device__ __forceinline__ void xcd_barrier(const XcdBarrier& b, bool leader_thread) {
    asm volatile("s_waitcnt vmcnt(0)" ::: "memory");
    __syncthreads();
    if (leader_thread) {
        unsigned* bar = b.bar;
        __builtin_amdgcn_s_waitcnt(0);
        unsigned nloc = b.st[0], nx = b.st[1];
        if (nloc == 0u) { xcd_barrier_complete(bar, b.x, nloc, nx); b.st[0] = nloc; b.st[1] = nx; }
        const unsigned old = xb_add(&bar[XB_XSUB(b.x)], 1u);
        const unsigned gen = old / nloc;
        if (old + 1u == (gen + 1u) * nloc) {
            __builtin_amdgcn_fence(__ATOMIC_RELEASE, "agent");
            asm volatile("s_waitcnt vmcnt(0)" ::: "memory");
            const unsigned og = xb_add(&bar[XB_TOP], 1u);
            const unsigned tg = og / nx;
            if (og + 1u == (tg + 1u) * nx) xb_add(&bar[XB_TOPGEN], 1u);
            else XB_SPIN(xb_ld(&bar[XB_TOPGEN]) == tg, bar);
            __builtin_amdgcn_fence(__ATOMIC_ACQUIRE, "agent");
            xb_add(&bar[XB_XGEN(b.x)], 1u);
            asm volatile("s_waitcnt vmcnt(0)" ::: "memory");
        } else {
            XB_SPIN(xb_ld(&bar[XB_XGEN(b.x)]) == gen, bar);
            __builtin_amdgcn_fence(__ATOMIC_ACQUIRE, "agent");
            asm volatile("s_waitcnt vmcnt(0)" ::: "memory");
        }
    }
    __syncthreads();
}

constexpr int N_PHASES = 10;
constexpr int CONV_EARLY = 5376;
__global__ void __launch_bounds__(512, 2) mk_fwd(Args a) {
    extern __shared__ __attribute__((aligned(16))) unsigned char lds_raw[];
    LAS unsigned char* lds = (LAS unsigned char*)lds_raw;
    const int wave = __builtin_amdgcn_readfirstlane(threadIdx.x >> 6);
    int lane, tid;
#define FRESH() do { lane = fresh_lane(); tid = wave * 64 + lane; } while (0)
    unsigned char* ws = a.ws;
    LAS int* ts = (LAS int*)(lds + LDS_CTRL);
    LAS int* cnts = ts + 40;
    const int lo = a.ph_lo, hi = a.ph_hi;
#ifndef PHASE_MASK
#define PHASE_MASK 0xFFFF
#endif
#define IN(k) (((PHASE_MASK >> (k)) & 1) && lo <= (k) && (k) < hi)
#define SEAM(k) do { if (IN(k) && IN((k) + 1)) { FRESH(); xcd_barrier(xb, tid == 0); } } while (0)
    XcdBarrier xb; xb.bar = (unsigned*)(ws + WS_CTL) + CW_BAR; xb.x = xb_xcc_id(); xb.st = (volatile LAS unsigned*)(lds + LDS_CTRL + 320);
    if (hi - lo > 1) {
        if (threadIdx.x == 0) { xb.st[0] = 0u; xb.st[1] = 0u; (void)xb_add(&xb.bar[XB_XCNT(xb.x)], 1u); }
        __syncthreads();
    }

    if (IN(0)) { FRESH(); p0_prologue(a, lds, tid, wave, lane); }
    SEAM(0);
    if (IN(1)) { FRESH(); p1_rows(a, lds, tid, wave, lane); }
    SEAM(1);
    if (IN(2)) {
        pg8::StaticOrder S; S.init(MT, NPROJ, gridDim.x, blockIdx.x, ws + WS_WIN, 2048);
        float* rcos = (float*)(ws + WS_ROPE);
        pg8::EpiInProj E{(bf16_t*)(ws + WS_PROJ), (float*)(ws + WS_SSQ), (float*)(ws + WS_SSQ) + MT * 4, (bf16_t*)(ws + WS_KM), (bf16_t*)(ws + WS_VTD), rcos, rcos + (size_t)MT * 16};
        __syncthreads();
        pg8::gemm_phase<pg8::EpiInProj, pg8::StaticOrder, true>(lds, ws + WS_HB, 2048, 2048, S, E, wave);
        if (gridDim.x == 256 && blockIdx.x >= 128) { __syncthreads(); FRESH(); small_weights_late(a, lds, wave, lane, (blockIdx.x - 128) * 8 + wave, 128 * 8); moe_weights_phase<2>(a, lane, 0, CONV_EARLY, (blockIdx.x - 128) * 8 + wave, 128 * 8); }
        else if (gridDim.x != 256 && blockIdx.x == 0) { __syncthreads(); FRESH(); small_weights_late(a, lds, wave, lane, wave, 8); moe_weights_phase<2>(a, lane, 0, CONV_EARLY, wave, 8); }
    }
    SEAM(2);
    if (IN(3)) {
        float* rcos = (float*)(ws + WS_ROPE);
        __syncthreads();
#ifndef SUB3
#define SUB3 7
#endif
        if (SUB3 & 3) { pg8::QbKvbOrder S; S.init(gridDim.x, blockIdx.x, ws + WS_WQB, ws + WS_WKVB, 512, PC_CQ * 2, PC_CKV * 2);
          pg8::EpiQbKvb E{pg8::EpiQb{(bf16_t*)(ws + WS_QM), (const float*)(ws + WS_SSQ), rcos, rcos + (size_t)MT * 16, 0.10206207261596575f * LOG2E},
                          pg8::EpiKvb{(bf16_t*)(ws + WS_KM), (bf16_t*)(ws + WS_VTM), (const float*)(ws + WS_SSQ) + MT * 4}};
          pg8::gemm_phase<pg8::EpiQbKvb, pg8::QbKvbOrder, true>(lds, (const bf16_t*)(ws + WS_PROJ), NPROJ * 2, 512, S, E, wave); }
        __syncthreads();
        FRESH();
        if (SUB3 & 4) for (int v = blockIdx.x; v < 256; v += gridDim.x) {
            const int b = v & 7, aa = v >> 3;
            const bf16_t* pj = (const bf16_t*)(ws + WS_PROJ); unsigned* bm = (unsigned*)(ws + WS_BITMAP);
            if (aa < 16) { idx_item<4>(lds, pj, bm, b, aa, wave, lane); FRESH(); idx_item<16>(lds, pj, bm, b, 63 - aa, wave, lane); FRESH(); idx_item<20>(lds, pj, bm, b, 64 + aa, wave, lane); FRESH(); idx_item<32>(lds, pj, bm, b, 127 - aa, wave, lane); }
            else { idx_item<8>(lds, pj, bm, b, aa, wave, lane); FRESH(); idx_item<12>(lds, pj, bm, b, 63 - aa, wave, lane); FRESH(); idx_item<24>(lds, pj, bm, b, 64 + aa, wave, lane); FRESH(); idx_item<28>(lds, pj, bm, b, 127 - aa, wave, lane); }
        }
    }
    SEAM(3);
    if (IN(4)) {
        __syncthreads(); FRESH();
        LAS unsigned* tc = (LAS unsigned*)(lds + LDS_CTRL + 336);
        if (tid < 2) tc[tid] = 0u;
        __syncthreads();
        const int team = wave >> 2, wt = wave & 3;
        if (team == 1) moe_weights_phase<1, 28>(a, lane, CONV_EARLY, 32 * 16 * 96, blockIdx.x * 4 + wt, gridDim.x * 4);
        {
            LAS unsigned char* tl = lds + team * (2 * 22272);
            LAS unsigned* slot = (LAS unsigned*)(lds + LDS_CTRL + 352) + 2 * team;
            unsigned* Q = (unsigned*)(ws + WS_CTL) + CW_ATTQ;
            unsigned tgen = 0u; int qs = (int)(xb.x & 7u), tried = 0;
            for (;;) {
                const int ln = fresh_lane(), tt = wt * 64 + ln;
                if (tt == 0) { unsigned j;
                    for (;;) { j = __hip_atomic_fetch_add(&Q[64 * qs], 1u, __ATOMIC_RELAXED, __HIP_MEMORY_SCOPE_AGENT); if (j < 256u) break; if (++tried >= 8) { j = 0xffffffffu; break; } qs = (qs + 1) & 7; }
                    slot[0] = j; slot[1] = (unsigned)qs; }
                {
                    asm volatile("s_waitcnt lgkmcnt(0)" ::: "memory"); tgen += 4u;
                    if (ln == 0) (void)__hip_atomic_fetch_add(tc + team, 1u, __ATOMIC_RELAXED, __HIP_MEMORY_SCOPE_WORKGROUP);
                    while ((unsigned)__builtin_amdgcn_readfirstlane((int)__hip_atomic_load(tc + team, __ATOMIC_RELAXED, __HIP_MEMORY_SCOPE_WORKGROUP)) < tgen) __builtin_amdgcn_s_sleep(0);
                    asm volatile("" ::: "memory"); }
                const unsigned j = (unsigned)__builtin_amdgcn_readfirstlane((int)slot[0]); const int b = __builtin_amdgcn_readfirstlane((int)slot[1]);
                if (j == 0xffffffffu) break;
                const int qt = 15 - (int)(j >> 4), h = (int)(j & 7u), kvh = h >> 2; const bool mla = ((j >> 3) & 1u) == 0u;
                if (mla) attn_unit<96, false>(tl, b, qt, (const bf16_t*)(ws + WS_QM) + h * 96, 768, (const bf16_t*)(ws + WS_KM) + h * 96, 768,
                                              (const bf16_t*)(ws + WS_VTM) + (size_t)(b * 8 + h) * 64 * SEQ, (unsigned char*)(ws + WS_Y) + h * 64, nullptr, nullptr, 0.f, 0.f, tt, wt, ln, tc + team, tgen, (const float*)(ws + WS_ROPE), (const float*)(ws + WS_ROPE) + (size_t)MT * 16);
                else attn_unit<64, true>(tl, b, qt, (const bf16_t*)(ws + WS_PROJ) + PC_QD + h * 64, NPROJ, (const bf16_t*)(ws + WS_PROJ) + PC_KD + kvh * 64, NPROJ,
                                         (const bf16_t*)(ws + WS_VTD) + (size_t)(b * 2 + kvh) * 64 * SEQ, (unsigned char*)(ws + WS_Y) + 512 + h * 64, (const unsigned*)(ws + WS_BITMAP), a.pos,
                                         0.125f * LOG2E, exp2f(-(float)(h + 1)) * LOG2E, tt, wt, ln, tc + team, tgen, nullptr, nullptr);
            }
        }
    }
    SEAM(4);
    if (IN(5)) {
        pg8::StaticOrder S; S.init(MT, DM, gridDim.x, blockIdx.x, ws + WS_WO, 1024);
        pg8::EpiPlain E{(bf16_t*)(ws + WS_MIX), DM, 1.f / 64.f};
        __syncthreads();
        pg8::gemm_phase<pg8::EpiPlain, pg8::StaticOrder, true, true>(lds, ws + WS_Y, 1024, 1024, S, E, wave);
        if (IN(6)) { __syncthreads(); FRESH(); p6_stage(a, lds, tid, blockIdx.x / 32, true); }
    }
    SEAM(5);
    if (IN(6)) { __syncthreads(); FRESH(); p6_rows(a, lds, tid, wave, lane, IN(5)); }
    SEAM(6);
    if (IN(7) || IN(8) || IN(9)) {
        __syncthreads(); FRESH();
        if (tid == 0) { const int* cnt = (const int*)(ws + WS_CTL) + CW_CNT; int acc = 0;
            for (int e = 0; e < 32; ++e) { const int c = cnt[CNT_STRIDE * e]; ts[e] = acc; cnts[e] = c; acc += (c + 255) >> 8; }
            ts[32] = acc; }
        __syncthreads();
    }
    if (IN(7)) {
        pg8::MoeOrder<true> S; S.init(ts, cnts, (const int*)(ws + WS_LIST), ws + WS_W1T, 2048, 1024, 8, gridDim.x, blockIdx.x);
        pg8::EpiMoe1 E{ws + WS_ACT, a.b_mlp1};
        {
            LAS int* rl = (LAS int*)(lds + MOE_RL_OFF); S.rl = rl;
            FRESH();
            const int th = tid >> 8, tr = tid & 255; int eh = 0;
#define RL_LOAD(k) int rv##k = -1; { pg8::Unit u_; if (S.next(base + 2 * (k) + th, u_, eh)) { eh = u_.e; const int p_ = u_.mt * 256 + tr; rv##k = (p_ < cnts[u_.e]) ? S.list[u_.e * MT + p_] : 0; } }
#define RL_STORE(k) if (rv##k >= 0) rl[(base + 2 * (k) + th) * 256 + tr] = rv##k;
#pragma unroll 1
            for (int base = 0; base < MOE_RL_UNITS; base += 10) {
                RL_LOAD(0) RL_LOAD(1) RL_LOAD(2) RL_LOAD(3) RL_LOAD(4)
                RL_STORE(0) RL_STORE(1) RL_STORE(2) RL_STORE(3) RL_STORE(4)
            }
#undef RL_LOAD
#undef RL_STORE
            __syncthreads();
        }
        pg8::gemm_phase<pg8::EpiMoe1, pg8::MoeOrder<true>, true, true>(lds, ws + WS_HB, 1024, 1024, S, E, wave);
    }
    SEAM(7);
    if (IN(8)) {
        pg8::MoeOrder<false> S; S.init(ts, cnts, (const int*)(ws + WS_LIST), ws + WS_W2T, 1024, 1024, 4, gridDim.x, blockIdx.x);
        pg8::EpiMoe2 E{ws + WS_YB, a.b_mlp2};
        __syncthreads();
        pg8::gemm_phase<pg8::EpiMoe2, pg8::MoeOrder<false>, true, true>(lds, ws + WS_ACT, 1024, 1024, S, E, wave);
        if (IN(9)) { __syncthreads(); FRESH(); p9_stage(a, lds, tid, blockIdx.x / 32); }
    }
    SEAM(8);
    if (IN(9)) { __syncthreads(); FRESH(); p9_rows(a, lds, ts, tid, wave, lane, IN(8)); }
#undef IN
#undef SEAM
}

extern "C" void kernel_launch(void* const* d_in, const int* in_sizes, int n_in, void* d_out, int out_size, void* d_ws, size_t ws_size, hipStream_t stream) {
    static int grid = 0;
    if (grid == 0) {
        if (n_in != 21 || out_size != MT * DM || ws_size < WS_END) { fprintf(stderr, "kernel_launch: unexpected shapes (n_in %d out %d ws %zu)\n", n_in, out_size, ws_size); grid = -1; return; }
        int dev = 0, cus = 0, per_cu = 0;
        hipGetDevice(&dev); hipDeviceGetAttribute(&cus, hipDeviceAttributeMultiprocessorCount, dev);
        if (hipFuncSetAttribute((const void*)mk_fwd, hipFuncAttributeMaxDynamicSharedMemorySize, LDS_BYTES) != hipSuccess) { fprintf(stderr, "kernel_launch: hipFuncSetAttribute failed\n"); grid = -1; return; }
        if (hipOccupancyMaxActiveBlocksPerMultiprocessor(&per_cu, (const void*)mk_fwd, 512, LDS_BYTES) != hipSuccess || per_cu < 1) { fprintf(stderr, "kernel_launch: occupancy query says %d\n", per_cu); per_cu = 1; }
        (void)hipGetLastError();
        grid = cus;
        if ((MAXTILES * 8 + grid - 1) / grid > MOE_RL_UNITS) { fprintf(stderr, "kernel_launch: %d CUs are too few for the LDS gather lists\n", cus); grid = -1; return; }
    }
    if (grid < 0) return;
    hipMemsetAsync((char*)d_ws + WS_CTL, 0, CTL_BYTES, stream);
    Args a{};
    a.x = (const float*)d_in[0]; a.c = (const float*)d_in[1]; a.pos = (const int*)d_in[2]; a.w_ada = (const float*)d_in[3]; a.b_ada = (const float*)d_in[4];
    a.g_pre_mix = (const float*)d_in[5]; a.g_post_mix = (const float*)d_in[6]; a.g_pre_ffn = (const float*)d_in[7]; a.g_post_ffn = (const float*)d_in[8];
    a.w_in = (const float*)d_in[9]; a.g_q_a = (const float*)d_in[10]; a.g_kv_a = (const float*)d_in[11]; a.w_q_b = (const float*)d_in[12]; a.w_kv_b = (const float*)d_in[13]; a.w_o = (const float*)d_in[14];
    a.w_router = (const float*)d_in[15]; a.b_router = (const float*)d_in[16]; a.w_mlp1 = (const float*)d_in[17]; a.b_mlp1 = (const float*)d_in[18]; a.w_mlp2 = (const float*)d_in[19]; a.b_mlp2 = (const float*)d_in[20];
    a.out = (float*)d_out; a.ws = (unsigned char*)d_ws;
#if MK_N_LAUNCHES == 1
    a.ph_lo = 0; a.ph_hi = N_PHASES;
    hipLaunchKernelGGL(mk_fwd, dim3(grid), dim3(512), LDS_BYTES, stream, a);
#else
    for (int p = 0; p < N_PHASES; ++p) { a.ph_lo = p; a.ph_hi = p + 1; hipLaunchKernelGGL(mk_fwd, dim3(grid), dim3(512), LDS_BYTES, stream, a); }
#endif
}
```
